# Optimizing an MI355X kernel written in HIP

```python
import math
import jax
import jax.numpy as jnp
from jax import lax
import numpy as np

D_MODEL = 1024
BATCH = 4
SEQ = 8192
DEPTH = 2

GRID_W = 64
CTX_LEN = 256
HEAD_DIM = 64
D_A = D_MODEL // 2
D_B = D_MODEL - D_A
D_C = D_MODEL // 2
D_D = D_MODEL - D_C
A_HEADS = D_A // HEAD_DIM
B_HEADS = D_B // HEAD_DIM
C_HEADS = D_C // HEAD_DIM
DECAY_LORA = 64
AAA_LORA = 64
GATE_LORA = 128
LN_X_EPS = 1e-5 * HEAD_DIM
A_SPLITS = [D_A, 2 * D_A, 3 * D_A, 3 * D_A + 2 * DECAY_LORA, 3 * D_A + 2 * DECAY_LORA + 2 * AAA_LORA]
A_COLS = 3 * D_A + 2 * DECAY_LORA + 2 * AAA_LORA + GATE_LORA
B_COLS = 5 * D_B
AB_COLS = A_COLS + B_COLS
GLA_CHUNK = 64
NA_ROWS = 8
NA_COLS = 16
NA_QROWS = 2
ROPE_THETA = 10000.0
C_COLS = 3 * D_C
CD_COLS = C_COLS + 3 * D_D
HYENA_ORDER = 2
HYENA_EMB = 33
HYENA_WIDTH = 64
HYENA_FAST_DECAY = 0.3
HYENA_SLOW_DECAY = 1.5
HYENA_TARGET = 1e-2
N_EXPERTS = 32
TOP_K = 4
D_EXPERT = D_MODEL
SWIGLU_ALPHA = 1.702
SWIGLU_LIMIT = 7.0
MOE_BLOCK = 256
RMS_EPS = 1e-6

kernel_name = 'hybrid_rwkv7_hgrn2_natten_hyena_moe_dit'


def _rms(x):
    xf = x.astype(jnp.float32)
    return (xf * lax.rsqrt(jnp.mean(xf * xf, axis=-1, keepdims=True) + RMS_EPS)).astype(x.dtype)


def _modulate(x, shift, scale):
    return _rms(x) * (1 + scale) + shift


def _conv3(u, w):
    up = jnp.pad(u, ((0, 0), (1, 1), (0, 0)))
    return up[:, :-2] * w[0] + up[:, 1:-1] * w[1] + up[:, 2:] * w[2]


def _rwkv7_streams(u, shift_w, w0, w2, a0, a2, g2, k_k, k_a):
    bsz, L, _ = u.shape
    u = _conv3(u, shift_w).astype(jnp.float32)
    r, k, v, wd, ad, gd = jnp.split(u, A_SPLITS, axis=-1)
    heads = lambda t: t.reshape(t.shape[:-1] + (A_HEADS, HEAD_DIM))
    lora_w = jnp.tanh(wd.reshape(bsz, L, 2, DECAY_LORA))
    w_log = -jax.nn.softplus(-(w0 + jnp.einsum('bldr,drc->bldc', lora_w, w2))) - 0.5
    decay = jnp.exp(-jnp.exp(w_log))
    a = jax.nn.sigmoid(a0 + jnp.einsum('bldr,drc->bldc', ad.reshape(bsz, L, 2, AAA_LORA), a2))
    kk = heads(k * k_k)
    kk = kk / jnp.maximum(jnp.linalg.norm(kk, axis=-1, keepdims=True), 1e-12)
    k_dir = k[:, :, None, :] * (1.0 + (a - 1.0) * k_a)
    g = jax.nn.sigmoid(gd) @ g2
    return heads(r), heads(v), kk, heads(decay), heads(a), heads(k_dir), g


def _rwkv7_scan(s0, r, w, k, v, kk, a, reverse):
    def step(s, inp):
        r_t, w_t, k_t, v_t, kk_t, a_t = inp
        sa = jnp.einsum('bhvk,bhk->bhv', s, kk_t)
        s = (s * w_t[:, :, None, :] - sa[..., None] * (kk_t * a_t)[:, :, None, :]
             + v_t[..., None] * k_t[:, :, None, :])
        return s, jnp.einsum('bhvk,bhk->bhv', s, r_t)
    xs = tuple(jnp.swapaxes(t, 0, 1) for t in (r, w, k, v, kk, a))
    s_fin, y = lax.scan(step, s0, xs, reverse=reverse)
    return jnp.swapaxes(y, 0, 1), s_fin


def _rwkv7_dir_args(streams, d):
    r, v, kk, decay, a, k_dir, _ = streams
    return r, decay[:, :, d], k_dir[:, :, d], v, kk, a[:, :, d]


def _rwkv7_readout(y, streams, r_k, ln_w, ln_b):
    r, v, _, _, _, k_dir, g = streams
    bsz, L = y.shape[:2]
    mu = jnp.mean(y, axis=-1, keepdims=True)
    var = jnp.mean(jnp.square(y - mu), axis=-1, keepdims=True)
    y = ((y - mu) * lax.rsqrt(var + LN_X_EPS)).reshape(bsz, L, D_A) * ln_w + ln_b
    bonus = jnp.sum(jnp.sum(r[:, :, None] * k_dir * r_k, axis=-1, keepdims=True) * v[:, :, None], axis=2)
    return (y + bonus.reshape(bsz, L, D_A)) * g


def _rwkv7_mix(u, uc, need_ctx, shift_w, w0, w2, a0, a2, g2, k_k, k_a, r_k, ln_w, ln_b):
    lat = _rwkv7_streams(u, shift_w, w0, w2, a0, a2, g2, k_k, k_a)
    ctx = _rwkv7_streams(uc, shift_w, w0, w2, a0, a2, g2, k_k, k_a)
    s0 = jnp.zeros((u.shape[0], A_HEADS, HEAD_DIM, HEAD_DIM), jnp.float32)
    y_dirs, yc_dirs = [], []
    for d in range(2):
        yc_d, s_ctx = _rwkv7_scan(s0, *_rwkv7_dir_args(ctx, d), reverse=(d == 1))
        y_d, _ = _rwkv7_scan(s_ctx, *_rwkv7_dir_args(lat, d), reverse=(d == 1))
        y_dirs.append(y_d)
        yc_dirs.append(yc_d)
    y = _rwkv7_readout(y_dirs[0] + y_dirs[1], lat, r_k, ln_w, ln_b)
    yc = _rwkv7_readout(yc_dirs[0] + yc_dirs[1], ctx, r_k, ln_w, ln_b) if need_ctx else None
    return y, yc


def _gla_chunked(q, k, v, logf, s0):
    bsz, L, H, _ = q.shape
    n = L // GLA_CHUNK
    def chunks(t):
        return t.reshape(bsz, n, GLA_CHUNK, H, t.shape[-1]).transpose(1, 0, 3, 2, 4)
    qc, kc, vc, gc = chunks(q), chunks(k), chunks(v), chunks(logf)
    b = jnp.cumsum(gc, axis=3)
    b_mid = b[:, :, :, GLA_CHUNK // 2 - 1:GLA_CHUNK // 2]
    att = jnp.einsum('nbhtd,nbhsd->nbhts', qc * jnp.exp(b - b_mid), kc * jnp.exp(b_mid - b))
    within = jnp.tril(jnp.ones((GLA_CHUNK, GLA_CHUNK), dtype=bool))
    o_intra = jnp.einsum('nbhts,nbhse->nbhte', jnp.where(within, att, 0.0), vc)
    q_in = qc * jnp.exp(b)
    k_out = kc * jnp.exp(b[:, :, :, -1:] - b)
    dec = jnp.exp(b[:, :, :, -1])
    def step(s, inp):
        q_t, k_t, v_t, d_t = inp
        o = jnp.einsum('bhtd,bhde->bhte', q_t, s)
        s = s * d_t[..., None] + jnp.einsum('bhsd,bhse->bhde', k_t, v_t)
        return s, o
    s_fin, o_inter = lax.scan(step, s0, (q_in, k_out, vc, dec))
    o = (o_intra + o_inter).transpose(1, 0, 3, 2, 4).reshape(bsz, L, H, v.shape[-1])
    return o, s_fin


def _gla_dir(q, k, v, logf, s0, reverse):
    if not reverse:
        return _gla_chunked(q, k, v, logf, s0)
    flip = lambda t: jnp.flip(t, axis=1)
    o, s_fin = _gla_chunked(flip(q), flip(k), flip(v), flip(logf), s0)
    return flip(o), s_fin


def _hgrn2_streams(u, lb):
    bsz, L, _ = u.shape
    q, f_fwd, f_bwd, i, og = jnp.split(u.astype(jnp.float32), 5, axis=-1)
    heads = lambda t: t.reshape(bsz, L, B_HEADS, HEAD_DIM)
    dirs = []
    for f in (f_fwd, f_bwd):
        fg = lb + (1.0 - lb) * jax.nn.sigmoid(f)
        dirs.append((heads(1.0 - fg), heads(jnp.log(fg))))
    return heads(jax.nn.silu(q)), heads(i), og, dirs


def _hgrn2_readout(o, og, norm_w):
    return (_rms(o) * norm_w).reshape(o.shape[:2] + (D_B,)) * jax.nn.silu(og)


def _hgrn2_mix(u, uc, need_ctx, lb, norm_w):
    q, i, og, dirs = _hgrn2_streams(u, lb)
    qc, ic, ogc, dirs_c = _hgrn2_streams(uc, lb)
    s0 = jnp.zeros((u.shape[0], B_HEADS, HEAD_DIM, HEAD_DIM), jnp.float32)
    o_dirs, oc_dirs = [], []
    for d in range(2):
        kc_d, lfc_d = dirs_c[d]
        k_d, lf_d = dirs[d]
        oc_d, s_ctx = _gla_dir(qc, kc_d, ic, lfc_d, s0, reverse=(d == 1))
        o_d, _ = _gla_dir(q, k_d, i, lf_d, s_ctx, reverse=(d == 1))
        o_dirs.append(o_d)
        oc_dirs.append(oc_d)
    y = _hgrn2_readout(o_dirs[0] + o_dirs[1], og, norm_w)
    yc = _hgrn2_readout(oc_dirs[0] + oc_dirs[1], ogc, norm_w) if need_ctx else None
    return y, yc


def _even_mixer(h, hc, need_ctx, w_in, w_out, shift_w, w0, w2, a0, a2, g2, k_k, k_a, r_k, ln_w, ln_b,
                lb, norm_w):
    u, uc = h @ w_in, hc @ w_in
    ya, yac = _rwkv7_mix(u[..., :A_COLS], uc[..., :A_COLS], need_ctx, shift_w, w0, w2, a0, a2, g2,
                         k_k, k_a, r_k, ln_w, ln_b)
    yb, ybc = _hgrn2_mix(u[..., A_COLS:], uc[..., A_COLS:], need_ctx, lb, norm_w)
    y = jnp.concatenate([ya, yb], axis=-1).astype(h.dtype) @ w_out
    if not need_ctx:
        return y, None
    yc = jnp.concatenate([yac, ybc], axis=-1).astype(h.dtype) @ w_out
    return y, yc


def _axial_rope(x):
    bsz, L, H, dh = x.shape
    t = jnp.arange(L)
    pos = jnp.stack([t // GRID_W, t % GRID_W], axis=-1).astype(jnp.float32)
    nf = dh // 4
    inv = ROPE_THETA ** (-jnp.arange(nf, dtype=jnp.float32) / nf)
    ang = pos[:, None, :, None] * inv
    cos, sin = jnp.cos(ang), jnp.sin(ang)
    xr = x.astype(jnp.float32).reshape(bsz, L, H, 2, 2, nf)
    x1, x2 = xr[..., 0, :], xr[..., 1, :]
    out = jnp.stack([x1 * cos - x2 * sin, x1 * sin + x2 * cos], axis=-2)
    return out.reshape(bsz, L, H, dh).astype(x.dtype)


def _na_latent(q, k, v, kc, vc, rpb):
    bsz, S, H, dh = q.shape
    rows = S // GRID_W
    wr = min(NA_ROWS, rows)
    r = np.arange(rows)
    row_idx = np.clip(r - wr // 2, 0, rows - wr)[:, None] + np.arange(wr)
    row_off = row_idx - r[:, None] + NA_ROWS - 1
    cc = np.arange(GRID_W)
    col_idx = np.clip(cc - NA_COLS // 2, 0, GRID_W - NA_COLS)[:, None] + np.arange(NA_COLS)
    col_off = col_idx - cc[:, None] + NA_COLS - 1
    n_blk = rows // NA_QROWS
    qg = q.reshape(bsz, n_blk, NA_QROWS, GRID_W, H, dh).transpose(1, 0, 2, 3, 4, 5)
    kg = k.reshape(bsz, rows, GRID_W, H, dh)
    vg = v.reshape(bsz, rows, GRID_W, H, dh)
    ridx = jnp.asarray(row_idx.reshape(n_blk, NA_QROWS, wr))
    roff = jnp.asarray(row_off.reshape(n_blk, NA_QROWS, wr))
    n_win = wr * NA_COLS

    def block(args):
        qb, ri, ro = args
        kw = kg[:, ri][:, :, :, col_idx]
        vw = vg[:, ri][:, :, :, col_idx]
        s_win = jnp.einsum('bqwhd,bqrwchd->bhqwrc', qb, kw)
        bias = rpb[:, ro[:, None, :, None], col_off[None, :, None, :]]
        s_win = (s_win + bias[None]).reshape(bsz, H, NA_QROWS, GRID_W, n_win)
        s_ctx = jnp.einsum('bqwhd,bkhd->bhqwk', qb, kc)
        p = jax.nn.softmax(jnp.concatenate([s_win, s_ctx], axis=-1).astype(jnp.float32), axis=-1)
        p_win = p[..., :n_win].reshape(bsz, H, NA_QROWS, GRID_W, wr, NA_COLS).astype(v.dtype)
        p_ctx = p[..., n_win:].astype(v.dtype)
        return (jnp.einsum('bhqwrc,bqrwchd->bqwhd', p_win, vw)
                + jnp.einsum('bhqwk,bkhd->bqwhd', p_ctx, vc))

    o = lax.map(block, (qg, ridx, roff))
    return o.transpose(1, 0, 2, 3, 4, 5).reshape(bsz, S, H * dh)


def _ctx_attention(q, k, v):
    s = jnp.einsum('bqhd,bkhd->bhqk', q, k).astype(jnp.float32)
    p = jax.nn.softmax(s, axis=-1).astype(v.dtype)
    o = jnp.einsum('bhqk,bkhd->bqhd', p, v)
    return o.reshape(o.shape[:2] + (-1,))


def _hyena_filters(L, w1, b1, fr1, w2, b2, fr2, w3):
    t = jnp.linspace(0.0, 1.0, L, dtype=jnp.float32)[:, None]
    bands = (HYENA_EMB - 1) // 2
    f = jnp.linspace(1e-4, bands - 1, bands, dtype=jnp.float32)
    ang = (2.0 * math.pi / L) * jnp.arange(L, dtype=jnp.float32)[:, None] * f
    z = jnp.concatenate([t, jnp.cos(ang), -jnp.sin(ang)], axis=-1)
    hid = jnp.sin(fr1 * (z @ w1 + b1))
    hid = jnp.sin(fr2 * (hid @ w2 + b2))
    h = (hid @ w3).reshape(L, HYENA_ORDER, 2, D_D)
    deltas = jnp.abs(jnp.linspace(math.log(HYENA_TARGET) / HYENA_SLOW_DECAY,
                                  math.log(HYENA_TARGET) / HYENA_FAST_DECAY, D_D, dtype=jnp.float32))
    return h * jnp.exp(-t * deltas)[:, None, None, :]


def _bidir_longconv(z, h_fwd, h_bwd, bias):
    L = z.shape[1]
    k2 = jnp.concatenate([h_fwd.at[0].add(h_bwd[0]), jnp.zeros_like(h_fwd[:1]), h_bwd[:0:-1]], axis=0)
    zf = jnp.fft.rfft(z.astype(jnp.float32), n=2 * L, axis=1)
    kf = jnp.fft.rfft(k2.astype(jnp.float32), n=2 * L, axis=0)
    y = jnp.fft.irfft(zf * kf, n=2 * L, axis=1)[:, :L]
    return (y + z * bias).astype(z.dtype)


def _hyena(u, short_w, w1, b1, fr1, w2, b2, fr2, w3, bias):
    L = u.shape[1]
    u = _conv3(u, short_w)
    v, x1, x2 = jnp.split(u, 3, axis=-1)
    h = _hyena_filters(L, w1, b1, fr1, w2, b2, fr2, w3)
    z = x1 * _bidir_longconv(v, h[:, 0, 0], h[:, 0, 1], bias[0])
    return x2 * _bidir_longconv(z, h[:, 1, 0], h[:, 1, 1], bias[1])


def _odd_mixer(h, hc, need_ctx, w_in, w_out, q_norm, k_norm, rpb, short_w, w1, b1, fr1, w2, b2, fr2, w3,
               bias):
    u, uc = h @ w_in, hc @ w_in

    def qkv(t):
        bsz, L, _ = t.shape
        q, k, v = jnp.split(t[..., :C_COLS], 3, axis=-1)
        heads = lambda a: a.reshape(bsz, L, C_HEADS, HEAD_DIM)
        return _rms(heads(q)) * q_norm, _rms(heads(k)) * k_norm, heads(v)

    q, k, v = qkv(u)
    qc, kc, vc = qkv(uc)
    scale = HEAD_DIM ** -0.5
    y_na = _na_latent(_axial_rope(q) * scale, _axial_rope(k), v, kc, vc, rpb)
    y_hy = _hyena(u[..., C_COLS:], short_w, w1, b1, fr1, w2, b2, fr2, w3, bias)
    y = jnp.concatenate([y_na, y_hy.astype(y_na.dtype)], axis=-1) @ w_out
    if not need_ctx:
        return y, None
    yc_na = _ctx_attention(qc * scale, kc, vc)
    yc_hy = _hyena(uc[..., C_COLS:], short_w, w1, b1, fr1, w2, b2, fr2, w3, bias)
    yc = jnp.concatenate([yc_na, yc_hy.astype(yc_na.dtype)], axis=-1) @ w_out
    return y, yc


def _clamped_swiglu(y):
    glu, lin = y[..., ::2], y[..., 1::2]
    glu = jnp.minimum(glu, SWIGLU_LIMIT)
    lin = jnp.clip(lin, -SWIGLU_LIMIT, SWIGLU_LIMIT)
    return glu * jax.nn.sigmoid(SWIGLU_ALPHA * glu) * (lin + 1.0)


def _moe(h, router_w, router_b, w1, b1, w2, b2):
    T, D = h.shape
    logits = (h @ router_w + router_b).astype(jnp.float32)
    top_logit, top_e = lax.top_k(logits, TOP_K)
    gate = jax.nn.softmax(top_logit, axis=-1)
    n_assign = T * TOP_K
    flat_e = top_e.reshape(-1)
    order = jnp.argsort(flat_e)
    e_sorted = flat_e[order]
    counts = jnp.bincount(flat_e, length=N_EXPERTS)
    padded = (counts + MOE_BLOCK - 1) // MOE_BLOCK * MOE_BLOCK
    start = jnp.cumsum(counts) - counts
    p_end = jnp.cumsum(padded)
    p_start = p_end - padded
    dest = p_start[e_sorted] + jnp.arange(n_assign) - start[e_sorted]
    n_blocks = -(-n_assign // MOE_BLOCK) + N_EXPERTS
    n_slots = n_blocks * MOE_BLOCK
    slot_tok = jnp.full((n_slots,), T, jnp.int32).at[dest].set((order // TOP_K).astype(jnp.int32))
    slot_gate = jnp.zeros((n_slots,), jnp.float32).at[dest].set(gate.reshape(-1)[order])
    blk_e = jnp.minimum(jnp.searchsorted(p_end, jnp.arange(n_blocks) * MOE_BLOCK, side='right'),
                        N_EXPERTS - 1)
    x_slots = jnp.concatenate([h, jnp.zeros((1, D), h.dtype)], axis=0)[slot_tok]
    x_slots = x_slots.reshape(n_blocks, MOE_BLOCK, D)

    def expert_block(args):
        xb, e = args
        y = _clamped_swiglu(xb @ w1[e] + b1[e])
        return y @ w2[e] + b2[e]

    y = lax.map(expert_block, (x_slots, blk_e)).reshape(n_slots, D)
    out = jnp.zeros((T + 1, D), jnp.float32).at[slot_tok].add(y.astype(jnp.float32) * slot_gate[:, None])
    return out[:T].astype(h.dtype)


def setup_inputs(seed: int = 0) -> dict:
    key = jax.random.key(seed)
    ks = iter(jax.random.split(key, 48))
    def nrm(shape, scale=1.0):
        return scale * jax.random.normal(next(ks), shape, jnp.float32)
    ne, no = (DEPTH + 1) // 2, DEPTH // 2
    taps = jnp.array([0.25, 0.5, 0.25], jnp.float32)[:, None]
    return {
        'x': nrm((BATCH, SEQ, D_MODEL)),
        'c': nrm((BATCH, D_MODEL)),
        'ctx': nrm((BATCH, CTX_LEN, D_MODEL)),
        'c_ctx': nrm((D_MODEL,)),
        'mod_w': nrm((DEPTH, D_MODEL, 6 * D_MODEL), D_MODEL ** -0.5),
        'mod_b': nrm((DEPTH, 6 * D_MODEL), 0.02),
        'router_w': nrm((DEPTH, D_MODEL, N_EXPERTS), D_MODEL ** -0.5),
        'router_b': nrm((DEPTH, N_EXPERTS), 0.01),
        'moe_w1': nrm((DEPTH, N_EXPERTS, D_MODEL, 2 * D_EXPERT), D_MODEL ** -0.5),
        'moe_b1': nrm((DEPTH, N_EXPERTS, 2 * D_EXPERT), 0.02),
        'moe_w2': nrm((DEPTH, N_EXPERTS, D_EXPERT, D_MODEL), D_EXPERT ** -0.5),
        'moe_b2': nrm((DEPTH, N_EXPERTS, D_MODEL), 0.02),
        'ab_w_in': nrm((ne, D_MODEL, AB_COLS), D_MODEL ** -0.5),
        'ab_w_out': nrm((ne, D_A + D_B, D_MODEL), (D_A + D_B) ** -0.5),
        'rwkv_shift': taps + nrm((ne, 3, A_COLS), 0.05),
        'rwkv_w0': jnp.linspace(-6.0, -1.0, D_A, dtype=jnp.float32) + nrm((ne, 2, D_A), 0.1),
        'rwkv_w2': nrm((ne, 2, DECAY_LORA, D_A), 0.1),
        'rwkv_a0': nrm((ne, 2, D_A), 0.1),
        'rwkv_a2': nrm((ne, 2, AAA_LORA, D_A), 0.1),
        'rwkv_g2': nrm((ne, GATE_LORA, D_A), GATE_LORA ** -0.5),
        'rwkv_k_k': 0.85 + nrm((ne, D_A), 0.05),
        'rwkv_k_a': 1.0 + nrm((ne, D_A), 0.05),
        'rwkv_r_k': nrm((ne, A_HEADS, HEAD_DIM), 0.1),
        'rwkv_ln_w': 1.0 + nrm((ne, D_A), 0.05),
        'rwkv_ln_b': nrm((ne, D_A), 0.02),
        'hgrn_lb_logits': nrm((ne + 1, D_B), 0.1),
        'hgrn_norm_w': 1.0 + nrm((ne, HEAD_DIM), 0.05),
        'cd_w_in': nrm((no, D_MODEL, CD_COLS), D_MODEL ** -0.5),
        'cd_w_out': nrm((no, D_C + D_D, D_MODEL), (D_C + D_D) ** -0.5),
        'na_q_norm': 1.0 + nrm((no, HEAD_DIM), 0.05),
        'na_k_norm': 1.0 + nrm((no, HEAD_DIM), 0.05),
        'na_rpb': nrm((no, C_HEADS, 2 * NA_ROWS - 1, 2 * NA_COLS - 1), 0.1),
        'hy_short': taps + nrm((no, 3, 3 * D_D), 0.05),
        'hy_w1': nrm((no, HYENA_EMB, HYENA_WIDTH), HYENA_EMB ** -0.5),
        'hy_b1': nrm((no, HYENA_WIDTH), 0.1),
        'hy_freq1': 1.0 + nrm((no, HYENA_WIDTH), 0.1),
        'hy_w2': nrm((no, HYENA_WIDTH, HYENA_WIDTH), HYENA_WIDTH ** -0.5),
        'hy_b2': nrm((no, HYENA_WIDTH), 0.1),
        'hy_freq2': 1.0 + nrm((no, HYENA_WIDTH), 0.1),
        'hy_w3': nrm((no, HYENA_WIDTH, HYENA_ORDER * 2 * D_D), 0.004),
        'hy_bias': nrm((no, HYENA_ORDER, D_D)),
    }


def reference(x, c, ctx, c_ctx, mod_w, mod_b, router_w, router_b, moe_w1, moe_b1, moe_w2, moe_b2,
              ab_w_in, ab_w_out, rwkv_shift, rwkv_w0, rwkv_w2, rwkv_a0, rwkv_a2, rwkv_g2, rwkv_k_k,
              rwkv_k_a, rwkv_r_k, rwkv_ln_w, rwkv_ln_b, hgrn_lb_logits, hgrn_norm_w, cd_w_in, cd_w_out,
              na_q_norm, na_k_norm, na_rpb, hy_short, hy_w1, hy_b1, hy_freq1, hy_w2, hy_b2, hy_freq2,
              hy_w3, hy_bias):
    xc = ctx
    lb_all = jnp.cumsum(jax.nn.softmax(hgrn_lb_logits.astype(jnp.float32), axis=0), axis=0)
    for l in range(DEPTH):
        need_ctx = l < DEPTH - 1
        j = l // 2
        mod = jax.nn.silu(c) @ mod_w[l] + mod_b[l]
        mod_c = jax.nn.silu(c_ctx) @ mod_w[l] + mod_b[l]
        sh1, sc1, g1, sh2, sc2, g2 = jnp.split(mod[:, None, :], 6, axis=-1)
        sh1c, sc1c, g1c, sh2c, sc2c, g2c = jnp.split(mod_c, 6)
        h = _modulate(x, sh1, sc1)
        hc = _modulate(xc, sh1c, sc1c)
        if l % 2 == 0:
            y, yc = _even_mixer(h, hc, need_ctx, ab_w_in[j], ab_w_out[j], rwkv_shift[j], rwkv_w0[j],
                                rwkv_w2[j], rwkv_a0[j], rwkv_a2[j], rwkv_g2[j], rwkv_k_k[j], rwkv_k_a[j],
                                rwkv_r_k[j], rwkv_ln_w[j], rwkv_ln_b[j], lb_all[j], hgrn_norm_w[j])
        else:
            y, yc = _odd_mixer(h, hc, need_ctx, cd_w_in[j], cd_w_out[j], na_q_norm[j], na_k_norm[j],
                               na_rpb[j], hy_short[j], hy_w1[j], hy_b1[j], hy_freq1[j], hy_w2[j], hy_b2[j],
                               hy_freq2[j], hy_w3[j], hy_bias[j])
        x = x + g1 * y.astype(x.dtype)
        h = _modulate(x, sh2, sc2)
        n_lat = h.shape[0] * h.shape[1]
        if need_ctx:
            xc = xc + g1c * yc.astype(xc.dtype)
            hc = _modulate(xc, sh2c, sc2c)
            tokens = jnp.concatenate([h.reshape(n_lat, -1), hc.reshape(-1, hc.shape[-1])], axis=0)
            out = _moe(tokens, router_w[l], router_b[l], moe_w1[l], moe_b1[l], moe_w2[l], moe_b2[l])
            x = x + g2 * out[:n_lat].reshape(x.shape)
            xc = xc + g2c * out[n_lat:].reshape(xc.shape)
        else:
            out = _moe(h.reshape(n_lat, -1), router_w[l], router_b[l], moe_w1[l], moe_b1[l], moe_w2[l],
                       moe_b2[l])
            x = x + g2 * out.reshape(x.shape)
    return x
```

```cpp
#include <hip/hip_runtime.h>
#include <cstdio>
#include <cstdint>

#define DI __device__ __forceinline__
#define LAS __attribute__((address_space(3)))
typedef unsigned short bf16_t;
typedef short bf16x8 __attribute__((ext_vector_type(8)));
typedef float f32x4 __attribute__((ext_vector_type(4)));
typedef float f32x2 __attribute__((ext_vector_type(2)));
typedef unsigned u32x4 __attribute__((ext_vector_type(4)));
typedef unsigned u32x2 __attribute__((ext_vector_type(2)));

constexpr int DM = 1024, NB = 4, SEQ = 8192, CL = 256;
constexpr int TL = NB * SEQ;
constexpr int TC = NB * CL;
constexpr int TT = TL + TC;
constexpr int ACOLS = 1920, ABCOLS = 4480, ABPAD = 4608, CDCOLS = 3072;
constexpr int NEXP = 32, TOPK = 4;
constexpr int NTHR = 512;

constexpr size_t al256(size_t x) { return (x + 255) & ~(size_t)255; }
constexpr size_t WS_CTL   = 0;
constexpr size_t CTL_BYTES = 32768;
constexpr size_t CW_CNT = 16384;
constexpr size_t CW_Q   = 16384 + 1024;
constexpr size_t WS_MOD   = WS_CTL + CTL_BYTES;
constexpr size_t WS_ROPE  = WS_MOD + al256(2 * 5 * 6144 * 4);
constexpr size_t WS_W2T   = WS_ROPE + 128 * 16 * 2 * 4;
constexpr size_t WS_A2T   = WS_W2T + 2 * 512 * 64 * 2;
constexpr size_t WS_G2T   = WS_A2T + 2 * 512 * 64 * 2;
constexpr size_t WS_WIN0  = WS_G2T + 512 * 128 * 2;
constexpr size_t WS_WOUT0 = WS_WIN0 + (size_t)ABPAD * DM * 2;
constexpr size_t WS_WIN1  = WS_WOUT0 + (size_t)DM * DM * 2;
constexpr size_t WS_WOUT1 = WS_WIN1 + (size_t)CDCOLS * DM * 2;
constexpr size_t WS_W1T   = WS_WOUT1 + (size_t)DM * DM * 2;
constexpr size_t WS_SGATE = WS_W1T + (size_t)2 * 32 * 2048 * 1024;
constexpr size_t WS_W2TM  = WS_W1T + (size_t)2 * 32 * 2048 * 1024 * 2;
constexpr size_t WS_HYF   = WS_W2TM + (size_t)2 * 32 * 1024 * 1024 * 2;
constexpr size_t WS_XRES  = WS_HYF + (size_t)4 * 512 * 8192 * 4;
constexpr size_t WS_HA    = WS_XRES + (size_t)TT * DM * 4;
constexpr size_t WS_MIX   = WS_HA + (size_t)TT * DM * 2;
constexpr size_t WS_GATE  = WS_MIX + (size_t)TT * DM * 2;
constexpr size_t WS_LIST  = WS_GATE + (size_t)TT * 4 * 4;
constexpr size_t WS_U     = WS_LIST + (size_t)32 * TT * 4;
constexpr size_t WS_R1    = WS_U + (size_t)TT * ABPAD * 2;
constexpr size_t R1_BYTES = (size_t)64 * 528 * (12288 + 7168) + (size_t)2 * TT * 512 * 2 + (size_t)2 * TT * 8 * 4;
constexpr size_t WS_R2    = WS_R1 + R1_BYTES;
constexpr size_t R2_BYTES = (size_t)4 * TT * 512 * 4;
constexpr size_t WS_END   = WS_R2 + R2_BYTES;
constexpr int HROWS = TT * 4 + 32 * 256;
static_assert((size_t)HROWS * 1024 * 2 <= R1_BYTES, "H fits region 1");
static_assert((size_t)TT * 4 * 1024 * 2 <= R2_BYTES, "Y fits region 2");
constexpr size_t STRB = (size_t)TT * 512 * 2;
constexpr size_t S_R = 0, S_V = 1, S_KK = 2, S_G = 3, S_LD0 = 4, S_LD1 = 5, S_B0 = 6, S_B1 = 7, S_KD0 = 8, S_KD1 = 9;
constexpr size_t L1_QN  = 0;
constexpr size_t L1_KN  = L1_QN + (size_t)TL * 512 * 2;
constexpr size_t L1_VT  = L1_KN + (size_t)TT * 512 * 2;
constexpr size_t L1_VCT = L1_VT + (size_t)4 * 512 * 8192 * 2;
constexpr size_t L1_HVT = L1_VCT + (size_t)4 * 512 * 256 * 2;
constexpr size_t L1_HYT = L1_HVT + (size_t)3 * 4 * 512 * 8192 * 2;
constexpr size_t L1_ZT  = L1_HYT + (size_t)4 * 512 * 8192 * 2;
static_assert(L1_ZT + (size_t)4 * 512 * 8192 * 4 <= R1_BYTES, "layer-1 buffers fit region 1");

constexpr int LDS_BYTES = 155648;
constexpr int LDS_MISC = 151552;

DI float bf2f(bf16_t b) { return __uint_as_float(((unsigned)b) << 16); }
typedef __bf16 bf16x2_t __attribute__((ext_vector_type(2)));
DI unsigned pack2(float lo, float hi) { const f32x2 v = (f32x2){lo, hi}; return __builtin_bit_cast(unsigned, __builtin_convertvector(v, bf16x2_t)); }
DI bf16_t f2bf(float f) { return (bf16_t)(pack2(f, 0.0f) & 0xFFFFu); }
DI float lo2f(unsigned w) { return __uint_as_float(w << 16); }
DI float hi2f(unsigned w) { return __uint_as_float(w & 0xFFFF0000u); }
DI float sigmoidf_(float x) { return 1.0f / (1.0f + __expf(-x)); }
DI float siluf_(float x) { return x / (1.0f + __expf(-x)); }
DI void load8bf(const bf16_t* p, float (&x)[8]) { const u32x4 w = *(const u32x4*)p; x[0] = lo2f(w.x); x[1] = hi2f(w.x); x[2] = lo2f(w.y); x[3] = hi2f(w.y); x[4] = lo2f(w.z); x[5] = hi2f(w.z); x[6] = lo2f(w.w); x[7] = hi2f(w.w); }
DI void store8bf(bf16_t* p, const float (&x)[8]) { u32x4 w; w.x = pack2(x[0], x[1]); w.y = pack2(x[2], x[3]); w.z = pack2(x[4], x[5]); w.w = pack2(x[6], x[7]); *(u32x4*)p = w; }
DI void load8f(const float* p, float (&x)[8]) { const f32x4 a = *(const f32x4*)p, b = *(const f32x4*)(p + 4); x[0] = a[0]; x[1] = a[1]; x[2] = a[2]; x[3] = a[3]; x[4] = b[0]; x[5] = b[1]; x[6] = b[2]; x[7] = b[3]; }
DI float wave_sum(float v) {
#pragma unroll
    for (int m = 32; m >= 1; m >>= 1) v += __shfl_xor(v, m, 64);
    return v;
}
template <int CTRL> DI float dppmov(float x) { return __builtin_bit_cast(float, __builtin_amdgcn_update_dpp(0, __builtin_bit_cast(int, x), CTRL, 0xF, 0xF, true)); }
DI float rowsum16(float x) { x += dppmov<0xB1>(x); x += dppmov<0x4E>(x); x += dppmov<0x141>(x); x += dppmov<0x140>(x); return x; }
DI float rowmax16(float x) { x = fmaxf(x, dppmov<0xB1>(x)); x = fmaxf(x, dppmov<0x4E>(x)); x = fmaxf(x, dppmov<0x141>(x)); x = fmaxf(x, dppmov<0x140>(x)); return x; }
DI float sum8(float x) { x += dppmov<0xB1>(x); x += dppmov<0x4E>(x); x += dppmov<0x141>(x); return x; }

#define XB_TMO      128
#define XB_XCNT(j)  (256  + 64 * (j))
#define XB_XSUB(j)  (1280 + 64 * (j))
#define XB_XGEN(j)  (2304 + 64 * (j))
#define XB_TOP      3328
#define XB_TOPGEN   3392
#define XCD_BAR_WORDS 3456
#define XB_SPIN_CAP (1u << 18)
DI unsigned xb_ld(unsigned* p)              { return __hip_atomic_load(p, __ATOMIC_RELAXED, __HIP_MEMORY_SCOPE_AGENT); }
DI unsigned xb_add(unsigned* p, unsigned v) { return __hip_atomic_fetch_add(p, v, __ATOMIC_RELAXED, __HIP_MEMORY_SCOPE_AGENT); }
DI unsigned xb_xcc_id() { return (unsigned)__builtin_amdgcn_s_getreg((3 << 11) | 20) & 0xFu; }
#define XB_SPIN(cond, bar) do { unsigned _sp = 0; while (cond) { __builtin_amdgcn_s_sleep(1); \
    if ((++_sp & 255u) == 0u) { if (xb_ld(&(bar)[XB_TMO])) break; if (_sp > XB_SPIN_CAP) { atomicAdd(&(bar)[XB_TMO], 1u); break; } } } } while (0)
struct XcdBarrier { unsigned* bar; unsigned x; volatile LAS unsigned* st; };
DI XcdBarrier xcd_barrier_post(unsigned* bar, volatile LAS unsigned* st) {
    XcdBarrier b; b.bar = bar; b.x = xb_xcc_id(); b.st = st;
    if (threadIdx.x == 0) (void)xb_add(&bar[XB_XCNT(b.x)], 1u);
    return b;
}
DI void xcd_barrier_complete(unsigned* bar, unsigned x, unsigned& nloc, unsigned& nx) {
    const unsigned G = gridDim.x * gridDim.y * gridDim.z;
    unsigned sum, cnt, mine, sp = 0u;
    for (;;) {
        sum = 0u; cnt = 0u; mine = 0u;
#pragma unroll
        for (unsigned j = 0; j < 16; ++j) { const unsigned c = xb_ld(&bar[XB_XCNT(j)]); sum += c; cnt += (c > 0u) ? 1u : 0u; mine = (j == x) ? c : mine; }
        if (sum == G) break;
        __builtin_amdgcn_s_sleep(1);
        if ((++sp & 255u) == 0u) { if (xb_ld(&bar[XB_TMO])) break; if (sp > XB_SPIN_CAP) { atomicAdd(&bar[XB_TMO], 1u); break; } }
    }
    nloc = mine > 0u ? mine : 1u; nx = cnt > 0u ? cnt : 1u;
}
DI void xcd_barrier(const XcdBarrier& b) {
    asm volatile("s_waitcnt vmcnt(0)" ::: "memory");
    __syncthreads();
    if (threadIdx.x == 0) {
        unsigned* bar = b.bar;
        __builtin_amdgcn_s_waitcnt(0);
        unsigned nloc = b.st[0], nx = b.st[1];
        if (nloc == 0u) { xcd_barrier_complete(bar, b.x, nloc, nx); b.st[0] = nloc; b.st[1] = nx; }
        const unsigned old = xb_add(&bar[XB_XSUB(b.x)], 1u);
        const unsigned gen = old / nloc;
        if (old + 1u == (gen + 1u) * nloc) {
            __builtin_amdgcn_fence(__ATOMIC_RELEASE, "agent");
            asm volatile("s_waitcnt vmcnt(0)" ::: "memory");
            const unsigned og = xb_add(&bar[XB_TOP], 1u);
            const unsigned tg = og / nx;
            if (og + 1u == (tg + 1u) * nx) xb_add(&bar[XB_TOPGEN], 1u);
            else XB_SPIN(xb_ld(&bar[XB_TOPGEN]) == tg, bar);
            __builtin_amdgcn_fence(__ATOMIC_ACQUIRE, "agent");
            xb_add(&bar[XB_XGEN(b.x)], 1u);
            asm volatile("s_waitcnt vmcnt(0)" ::: "memory");
        } else {
            XB_SPIN(xb_ld(&bar[XB_XGEN(b.x)]) == gen, bar);
            __builtin_amdgcn_fence(__ATOMIC_ACQUIRE, "agent");
            asm volatile("s_waitcnt vmcnt(0)" ::: "memory");
        }
    }
    __syncthreads();
}

DI void lds_barrier() { asm volatile("s_waitcnt lgkmcnt(0)" ::: "memory"); __builtin_amdgcn_s_barrier(); asm volatile("" ::: "memory"); }

struct Args {
    const float* in[41];
    float* out; unsigned char* ws;
    int ph_lo, ph_hi;
};
struct Frame {
    LAS unsigned char* lds;
    unsigned char* ws;
    int tid, lane, wave, G, bid;
};
struct KArgs { unsigned long long kp; unsigned char* ws; float* out; };
template <int OFF> DI unsigned long long kload(unsigned long long kp) { unsigned long long v; asm("s_load_dwordx2 %0, %1, %2\n\ts_waitcnt lgkmcnt(0)" : "=s"(v) : "s"(kp), "n"(OFF)); return v; }
#define GAS __attribute__((address_space(1)))
#define KIN(a, N) ((const float*)(GAS const float*)kload<(N) * 8>((a).kp))
typedef int i32x8 __attribute__((ext_vector_type(8)));
typedef int i32x4v __attribute__((ext_vector_type(4)));
DI unsigned pack4_fp8(float a, float b, float c, float d) { int w = __builtin_amdgcn_cvt_pk_fp8_f32(a, b, 0, false); w = __builtin_amdgcn_cvt_pk_fp8_f32(c, d, w, true); return (unsigned)w; }
DI float clamp8(float x) { return __builtin_fminf(__builtin_fmaxf(x, -448.f), 448.f); }
constexpr float Q8_W = 64.f, Q8_H = 4.f, Q8_Y = 16.f;
namespace pg8 {
constexpr int BM = 256, BK = 64, HALF = 128, HTB = HALF * BK * 2, STAGE_BYTES = 8 * HTB, NXCD = 8, WGM = 8, KD = 1024;
DI int lds_byte(int r, int c) { const int st = (r >> 4) * 2 + (c >> 5), rr = r & 15, cc = c & 31, ob = rr * 64 + cc * 2; return st * 1024 + (ob ^ (((ob >> 9) & 1) << 5)); }
DI void stage_rc(int b, int& R, int& C) { const int st = b / 1024, sb = b % 1024, swz = sb ^ (((sb >> 9) & 1) << 5); R = (st >> 1) * 16 + swz / 64; C = (st & 1) * 32 + (swz % 64) / 2; }
DI int perm32(int rho) { const int n = rho >> 4, i = rho & 15; return 8 * (i >> 2) + 4 * n + (i & 3); }
DI unsigned cvt_pk_bf16(float lo, float hi) { return pack2(lo, hi); }

struct Unit { int pm, pn, e, nvalid, slot0; };
template <bool PERM, bool FP8> DI void lane_rc(int (&Rr)[2], int (&Rb)[2], int (&Cc)[2]) {
    int tid = threadIdx.x; asm volatile("" : "+v"(tid));
#pragma unroll
    for (int i = 0; i < 2; ++i) { int R, C; stage_rc(tid * 16 + i * 8192, R, C); Rr[i] = R; Cc[i] = C * 2; Rb[i] = PERM ? ((R & ~31) + perm32(R & 31)) : R; }
}
template <int CM> DI int brow(int h, int rb) { return CM == 0 ? h * HALF + rb : (rb >> 5) * 64 + ((rb & 31) >> 3) * 16 + h * 8 + (rb & 7); }
constexpr int PRM_BASE = STAGE_BYTES, PRM_BYTES = 4096, PRM_VEC = 0, PRM_AID = 1024, PRM_GATE = 2048, PRM_NIDX = 3072;
DI void dma1k(const void* base, unsigned byte_off, unsigned lds_addr) {
    GAS const char* g = (GAS const char*)base + __builtin_amdgcn_readfirstlane(byte_off);
    const unsigned lo = ((unsigned)threadIdx.x & 63u) * 16u;
    asm volatile("s_mov_b32 m0, %2\n\ts_nop 0\n\tglobal_load_lds_dwordx4 %0, %1" :: "v"(lo), "s"(g), "s"(__builtin_amdgcn_readfirstlane(lds_addr)) : "memory", "m0");
}
struct PlainOrder {
    int nM, nN, nwg, G, c;
    DI void init(int M, int N, int G_, int c_) { nM = M / BM; nN = N / BM; nwg = nM * nN; G = G_; c = c_; }
    DI bool next(int i, Unit& u) const {
        const long L = (long)i * G + c; if (L >= nwg) return false;
        int wgid = (int)L; { const int q = nwg / NXCD, r = nwg % NXCD, xcd = wgid % NXCD, off = wgid / NXCD; wgid = (xcd < r ? xcd * (q + 1) : r * (q + 1) + (xcd - r) * q) + off; }
        const int nig = WGM * nN, gid = wgid / nig, fm = gid * WGM, gsz = (nM - fm) < WGM ? (nM - fm) : WGM;
        u.pm = fm + ((wgid % nig) % gsz); u.pn = (wgid % nig) / gsz; u.e = 0; u.nvalid = 256; u.slot0 = 0; return true;
    }
    DI void prefetch(const Unit&, unsigned, int) const {}
    template <bool PERM, bool FP8, int CM> DI void finish(const Unit& u, const LAS int*, unsigned (&va)[2][2], unsigned (&vb)[2][2]) const { offsets<PERM, FP8, CM>(u, va, vb); }
    template <bool PERM, bool FP8, int CM> DI void offsets(const Unit& u, unsigned (&va)[2][2], unsigned (&vb)[2][2]) const {
        int R[2], Rb[2], C[2]; lane_rc<PERM, FP8>(R, Rb, C);
        constexpr int ROWB = FP8 ? KD : KD * 2;
#pragma unroll
        for (int h = 0; h < 2; ++h)
#pragma unroll
            for (int i = 0; i < 2; ++i) {
                va[h][i] = (unsigned)((u.pm * BM + h * HALF + R[i]) * ROWB + C[i]);
                vb[h][i] = (unsigned)((u.pn * BM + brow<CM>(h, Rb[i])) * ROWB + C[i]);
            }
    }
};

struct MoeOrder {
    const LAS int* tstart; const LAS int* cnt; const LAS int* tile_e; const int* list;
    int NT, G, c; bool gather;
    DI bool next(int i, Unit& u) const {
        const int total = tstart[32] * NT;
        long L = (long)i * G + c;
        if (G == 256) L = ((long)i * 8 + (c & 7)) * 32 + (c >> 3);
        if (L >= total) return false;
        const int mt = (int)(L / NT); u.pn = (int)(L % NT);
        const int e = tile_e[mt];
        u.e = e; u.pm = mt - tstart[e]; const int rem = cnt[e] - u.pm * BM; u.nvalid = rem < BM ? rem : BM; u.slot0 = mt * BM; return true;
    }
    DI void prefetch(const Unit& n, unsigned prm, int wid) const {
        if (gather && wid == 3) dma1k(list, (unsigned)(((size_t)n.e * TT + n.pm * BM) * 4), prm + PRM_NIDX);
    }
    template <bool PERM, bool FP8, int CM> DI void finish(const Unit& u, const LAS int* nidx, unsigned (&va)[2][2], unsigned (&vb)[2][2]) const {
        int R[2], Rb[2], C[2]; lane_rc<PERM, FP8>(R, Rb, C);
        const int ncols = NT * BM;
        constexpr int ROWB = FP8 ? KD : KD * 2;
#pragma unroll
        for (int h = 0; h < 2; ++h)
#pragma unroll
            for (int i = 0; i < 2; ++i) {
                const int rl = h * HALF + R[i];
                int arow;
                if (gather) { const int idx = rl < u.nvalid ? rl : 0; arow = nidx[idx] >> 2; }
                else arow = u.slot0 + rl;
                va[h][i] = (unsigned)(arow * ROWB + C[i]);
                vb[h][i] = (unsigned)(((u.e * ncols) + u.pn * BM + brow<CM>(h, Rb[i])) * ROWB + C[i]);
            }
    }
    template <bool PERM, bool FP8, int CM> DI void offsets(const Unit& u, unsigned (&va)[2][2], unsigned (&vb)[2][2]) const {
        int R[2], Rb[2], C[2]; lane_rc<PERM, FP8>(R, Rb, C);
        const int ncols = NT * BM;
        constexpr int ROWB = FP8 ? KD : KD * 2;
#pragma unroll
        for (int h = 0; h < 2; ++h)
#pragma unroll
            for (int i = 0; i < 2; ++i) {
                const int rl = h * HALF + R[i];
                int arow;
                if (gather) { const int idx = rl < u.nvalid ? rl : 0; arow = list[(size_t)u.e * TT + u.pm * BM + idx] >> 2; }
                else arow = u.slot0 + rl;
                va[h][i] = (unsigned)(arow * ROWB + C[i]);
                vb[h][i] = (unsigned)(((u.e * ncols) + u.pn * BM + brow<CM>(h, Rb[i])) * ROWB + C[i]);
            }
    }
};
DI i32x8 cat8(bf16x8 lo, bf16x8 hi) { const i32x4v a = __builtin_bit_cast(i32x4v, lo), b = __builtin_bit_cast(i32x4v, hi); return __builtin_shufflevector(a, b, 0, 1, 2, 3, 4, 5, 6, 7); }

template <int SLP = 0, class Epi, class Sched>
DI void gemm_phase(LAS unsigned char* lds, const bf16_t* Abase, const bf16_t* Bbase, const Sched& S, const Epi& E) {
    const int tid = threadIdx.x, wid = __builtin_amdgcn_readfirstlane(tid >> 6), lane = tid & 63, wr = wid >> 2, wc = wid & 3, fr = lane & 15, fq = lane >> 4;
    constexpr bool FP8 = Epi::FP8;
    constexpr int nt = FP8 ? KD / (2 * BK) : KD / BK;
    constexpr size_t kstep = (size_t)(BK * 2);
    const unsigned ldsw = (unsigned)wid * 1024u;
    const unsigned ldsb = (unsigned)(size_t)lds + ldsw;
    const int aoff = lds_byte(wr * 64 + fr, fq * 8), boff = lds_byte(wc * 32 + fr, fq * 8);
    const char* const Ab = (const char*)Abase; const char* const Bb = (const char*)Bbase;
#define PG8_SA(b, h) (((b) * 2 + (h)) * HTB)
#define PG8_SB(b, h) ((4 + (b) * 2 + (h)) * HTB)
#define PG8_STAGE(bufoff, gbase, voff) do { GAS const char* g_ = (GAS const char*)(gbase); _Pragma("unroll") for (int _i = 0; _i < 2; ++_i) \
        asm volatile("s_mov_b32 m0, %2\n\ts_nop 0\n\tglobal_load_lds_dwordx4 %0, %1" :: "v"((voff)[_i]), "s"(g_), "s"(ldsb + (unsigned)((bufoff) + _i * 8192)) : "memory", "m0"); } while (0)
#define PG8_LDA(dst, b, h) do { _Pragma("unroll") for (int m = 0; m < 4; ++m) _Pragma("unroll") for (int k = 0; k < 2; ++k) dst[m][k] = *(const LAS bf16x8*)(lds + PG8_SA(b, h) + aoff + m * 2048 + k * 1024); } while (0)
#define PG8_LDB(dst, b, h) do { _Pragma("unroll") for (int n = 0; n < 2; ++n) _Pragma("unroll") for (int k = 0; k < 2; ++k) dst[n][k] = *(const LAS bf16x8*)(lds + PG8_SB(b, h) + boff + n * 2048 + k * 1024); } while (0)
#define PG8_LDA8(dst, b, h) do { _Pragma("unroll") for (int m = 0; m < 4; ++m) { const i32x4v lo_ = *(const LAS i32x4v*)(lds + PG8_SA(b, h) + aoff + m * 2048), hi_ = *(const LAS i32x4v*)(lds + PG8_SA(b, h) + aoff + m * 2048 + 1024); \
        dst[m] = __builtin_shufflevector(lo_, hi_, 0, 1, 2, 3, 4, 5, 6, 7); } } while (0)
#define PG8_LDB8(dst, b, h) do { _Pragma("unroll") for (int n = 0; n < 2; ++n) { const i32x4v lo_ = *(const LAS i32x4v*)(lds + PG8_SB(b, h) + boff + n * 2048), hi_ = *(const LAS i32x4v*)(lds + PG8_SB(b, h) + boff + n * 2048 + 1024); \
        dst[n] = __builtin_shufflevector(lo_, hi_, 0, 1, 2, 3, 4, 5, 6, 7); } } while (0)
#define PG8_MMA(ai, bj, At, Bt) do { __builtin_amdgcn_s_setprio(1); _Pragma("unroll") for (int k = 0; k < 2; ++k) _Pragma("unroll") for (int m = 0; m < 4; ++m) _Pragma("unroll") for (int n = 0; n < 2; ++n) \
        asm volatile("v_mfma_f32_16x16x32_bf16 %0, %1, %2, %0" : "+v"(acc[ai][bj][m][n]) : "v"(Bt[n][k]), "v"(At[m][k])); __builtin_amdgcn_s_setprio(0); } while (0)
#define PG8_MMA8(ai, bj, At, Bt) do { __builtin_amdgcn_s_setprio(1); _Pragma("unroll") for (int m = 0; m < 4; ++m) _Pragma("unroll") for (int n = 0; n < 2; ++n) \
        asm volatile("v_mfma_f32_16x16x128_f8f6f4 %0, %1, %2, %0" : "+v"(acc[ai][bj][m][n]) : "v"(Bt[n]), "v"(At[m])); __builtin_amdgcn_s_setprio(0); } while (0)
#define PG8_MMA_I(ai, bj, At, Bt) do { __builtin_amdgcn_s_setprio(1); _Pragma("unroll") for (int m = 0; m < 4; ++m) _Pragma("unroll") for (int n = 0; n < 2; ++n) \
        asm volatile("v_mfma_f32_16x16x32_bf16 %0, %1, %2, 0" : "=v"(acc[ai][bj][m][n]) : "v"(Bt[n][0]), "v"(At[m][0])); \
        _Pragma("unroll") for (int m = 0; m < 4; ++m) _Pragma("unroll") for (int n = 0; n < 2; ++n) \
        asm volatile("v_mfma_f32_16x16x32_bf16 %0, %1, %2, %0" : "+v"(acc[ai][bj][m][n]) : "v"(Bt[n][1]), "v"(At[m][1])); __builtin_amdgcn_s_setprio(0); } while (0)
#define PG8_MMA8_I(ai, bj, At, Bt) do { __builtin_amdgcn_s_setprio(1); _Pragma("unroll") for (int m = 0; m < 4; ++m) _Pragma("unroll") for (int n = 0; n < 2; ++n) \
        asm volatile("v_mfma_f32_16x16x128_f8f6f4 %0, %1, %2, 0" : "=v"(acc[ai][bj][m][n]) : "v"(Bt[n]), "v"(At[m])); __builtin_amdgcn_s_setprio(0); } while (0)
#define PG8_MM_I(ai, bj, AtX, BtX) do { if constexpr (FP8) PG8_MMA8_I(ai, bj, AtX##8, BtX##8); else PG8_MMA_I(ai, bj, AtX, BtX); } while (0)
#define PG8_MM(ai, bj, AtX, BtX) do { if constexpr (FP8) PG8_MMA8(ai, bj, AtX##8, BtX##8); else PG8_MMA(ai, bj, AtX, BtX); } while (0)
#define PG8_LA(AtX, b, h) do { if constexpr (FP8) PG8_LDA8(AtX##8, b, h); else PG8_LDA(AtX, b, h); } while (0)
#define PG8_LB(BtX, b, h) do { if constexpr (FP8) PG8_LDB8(BtX##8, b, h); else PG8_LDB(BtX, b, h); } while (0)
#define PG8_WAIT_V(n) asm volatile("s_waitcnt vmcnt(" #n ")" ::: "memory")
#define PG8_WAIT_L(n) asm volatile("s_waitcnt lgkmcnt(" #n ")" ::: "memory")
#define PG8_BAR __builtin_amdgcn_s_barrier()
#define PG8_SCHED __builtin_amdgcn_sched_barrier(0)
    Unit cur, nxt; int ui = 0;
    if (!S.next(0, cur)) return;
    if constexpr (SLP > 0) { const int slot = (blockIdx.x >> 3) & 31;
#pragma unroll 1
        for (int i = 0; i < slot; ++i) __builtin_amdgcn_s_sleep(SLP); }
    f32x4 acc[2][2][4][2];
    bf16x8 At[4][2], B0[2][2], B1[2][2];
    i32x8 At8[4], B08[2], B18[2];
    unsigned vaC[2][2], vbC[2][2], vaN[2][2], vbN[2][2];
    S.template offsets<Epi::PERM, FP8, Epi::CM>(cur, vaC, vbC);
    PG8_STAGE(PG8_SB(0, 0), Bb, vbC[0]); PG8_STAGE(PG8_SA(0, 0), Ab, vaC[0]); PG8_STAGE(PG8_SB(0, 1), Bb, vbC[1]); PG8_STAGE(PG8_SA(0, 1), Ab, vaC[1]);
    if (wr == 1) PG8_BAR;
    PG8_WAIT_V(4); PG8_BAR;
    PG8_STAGE(PG8_SB(1, 0), Bb + kstep, vbC[0]); PG8_STAGE(PG8_SA(1, 0), Ab + kstep, vaC[0]); PG8_STAGE(PG8_SB(1, 1), Bb + kstep, vbC[1]);
    PG8_WAIT_V(6); PG8_BAR;
    for (;;) {
        const bool has_next = S.next(ui + 1, nxt);
        const unsigned prm = (unsigned)(size_t)lds + (unsigned)(PRM_BASE + (ui & 1) * PRM_BYTES);
        const LAS unsigned char* const prmp = lds + PRM_BASE + (ui & 1) * PRM_BYTES;
        E.prefetch(cur, prm, wid);
        if (has_next) S.prefetch(nxt, prm, wid);
#define PG8_KBODY(K1, K2, K3, VA2, VB2, MMF) do { \
              \
            PG8_LB(B0, 0, 0); PG8_SCHED; PG8_LA(At, 0, 0); PG8_STAGE(PG8_SA(1, 1), Ab + (K1), vaC[1]); \
            PG8_WAIT_L(8); PG8_BAR; PG8_WAIT_L(0); MMF(0, 0, At, B0); PG8_BAR; PG8_SCHED; \
              \
            PG8_LB(B1, 0, 1); PG8_STAGE(PG8_SB(0, 0), Bb + (K2), VB2[0]); \
            PG8_BAR; PG8_WAIT_L(0); MMF(0, 1, At, B1); PG8_BAR; \
              \
            PG8_LA(At, 0, 1); PG8_STAGE(PG8_SA(0, 0), Ab + (K2), VA2[0]); \
            PG8_BAR; PG8_WAIT_L(0); MMF(1, 0, At, B0); PG8_BAR; PG8_SCHED; \
              \
            PG8_STAGE(PG8_SB(0, 1), Bb + (K2), VB2[1]); \
            PG8_WAIT_V(6); PG8_BAR; MMF(1, 1, At, B1); PG8_BAR; \
              \
            PG8_LB(B0, 1, 0); PG8_SCHED; PG8_LA(At, 1, 0); PG8_STAGE(PG8_SA(0, 1), Ab + (K2), VA2[1]); \
            PG8_WAIT_L(8); PG8_BAR; PG8_WAIT_L(0); PG8_MM(0, 0, At, B0); PG8_BAR; PG8_SCHED; \
              \
            PG8_LB(B1, 1, 1); PG8_STAGE(PG8_SB(1, 0), Bb + (K3), VB2[0]); \
            PG8_BAR; PG8_WAIT_L(0); PG8_MM(0, 1, At, B1); PG8_BAR; \
              \
            PG8_LA(At, 1, 1); PG8_STAGE(PG8_SA(1, 0), Ab + (K3), VA2[0]); \
            PG8_BAR; PG8_WAIT_L(0); PG8_MM(1, 0, At, B0); PG8_BAR; PG8_SCHED; \
              \
            PG8_STAGE(PG8_SB(1, 1), Bb + (K3), VB2[1]); \
            PG8_WAIT_V(6); PG8_BAR; PG8_MM(1, 1, At, B1); PG8_BAR; } while (0)
        PG8_KBODY(kstep, 2 * kstep, 3 * kstep, vaC, vbC, PG8_MM_I);
#pragma unroll 1
        for (int t = 2; t < nt - 2; t += 2) {
            const size_t k1 = (size_t)(t + 1) * kstep, k2 = (size_t)(t + 2) * kstep, k3 = k2 + kstep;
            PG8_KBODY(k1, k2, k3, vaC, vbC, PG8_MM);
        }
        if (has_next) S.template finish<Epi::PERM, FP8, Epi::CM>(nxt, (const LAS int*)(prmp + PRM_NIDX), vaN, vbN);
        else {
#pragma unroll
            for (int h = 0; h < 2; ++h)
#pragma unroll
                for (int i = 0; i < 2; ++i) { vaN[h][i] = vaC[h][i]; vbN[h][i] = vbC[h][i]; }
        }
        PG8_KBODY((size_t)(nt - 1) * kstep, (size_t)0, kstep, vaN, vbN, PG8_MM);
        asm volatile("s_nop 15\n\ts_nop 15" ::: "memory");
        E(acc, cur, wr, wc, fr, fq, prmp);
        if (!has_next) break;
        cur = nxt; ++ui;
#pragma unroll
        for (int h = 0; h < 2; ++h)
#pragma unroll
            for (int i = 0; i < 2; ++i) { vaC[h][i] = vaN[h][i]; vbC[h][i] = vbN[h][i]; }
    }
    PG8_WAIT_V(0);
    if (wr == 0) PG8_BAR;
    PG8_BAR;
#undef PG8_KBODY
#undef PG8_SA
#undef PG8_SB
#undef PG8_STAGE
#undef PG8_LDA
#undef PG8_LDB
#undef PG8_MMA
#undef PG8_MMA8
#undef PG8_LDA8
#undef PG8_LDB8
#undef PG8_LA
#undef PG8_LB
#undef PG8_MM
#undef PG8_MM_I
#undef PG8_MMA_I
#undef PG8_MMA8_I
#undef PG8_WAIT_V
#undef PG8_WAIT_L
#undef PG8_BAR
#undef PG8_SCHED
}

struct EpiBf16 {
    static constexpr bool PERM = true, FP8 = false; static constexpr int CM = 0;
    bf16_t* O; int ldc;
    DI void prefetch(const Unit&, unsigned, int) const {}
    DI void operator()(const f32x4 (&acc)[2][2][4][2], const Unit& u, int wr, int wc, int fr, int fq, const LAS unsigned char*) const {
        const int row0 = u.pm * BM + wr * 64 + fr, col0 = u.pn * BM + wc * 32 + 8 * fq;
#pragma unroll
        for (int ai = 0; ai < 2; ++ai)
#pragma unroll
            for (int m = 0; m < 4; ++m) { bf16_t* rowp = O + (size_t)(row0 + ai * HALF + m * 16) * ldc + col0;
#pragma unroll
                for (int bj = 0; bj < 2; ++bj) { const f32x4 v0 = acc[ai][bj][m][0], v1 = acc[ai][bj][m][1];
                    u32x4 w; w.x = cvt_pk_bf16(v0[0], v0[1]); w.y = cvt_pk_bf16(v0[2], v0[3]); w.z = cvt_pk_bf16(v1[0], v1[1]); w.w = cvt_pk_bf16(v1[2], v1[3]);
                    *(u32x4*)(rowp + bj * HALF) = w; } }
    }
};
template <bool SRCBF> struct EpiResid {
    static constexpr bool PERM = true, FP8 = false; static constexpr int CM = 0;
    const void* src0; const void* src1; bf16_t* dst; const float* gate;
    DI void prefetch(const Unit& u, unsigned prm, int wid) const {
        const int tile_row = u.pm * BM, sel = tile_row < TL ? tile_row / SEQ : 4;
        if (wid == 0) dma1k(gate, (unsigned)((sel * 6144 + u.pn * BM) * 4), prm + PRM_VEC);
    }
    DI void operator()(const f32x4 (&acc)[2][2][4][2], const Unit& u, int wr, int wc, int fr, int fq, const LAS unsigned char* prmp) const {
        const int row0 = u.pm * BM + wr * 64 + fr, cl0 = wc * 32 + 8 * fq, col0 = u.pn * BM + cl0;
        const int tile_row = u.pm * BM;
        const size_t soff = tile_row < TL ? (size_t)0 : (size_t)TL * DM;
        const void* sbase = tile_row < TL ? src0 : src1;
        f32x4 gv[2][2];
#pragma unroll
        for (int bj = 0; bj < 2; ++bj)
#pragma unroll
            for (int n = 0; n < 2; ++n) gv[bj][n] = *(const LAS f32x4*)(prmp + PRM_VEC + (cl0 + bj * HALF + 4 * n) * 4);
#pragma unroll
        for (int ai = 0; ai < 2; ++ai)
#pragma unroll
            for (int m = 0; m < 4; ++m) { const size_t ro = (size_t)(row0 + ai * HALF + m * 16) * DM + col0;
#pragma unroll
                for (int bj = 0; bj < 2; ++bj) { f32x4 x0, x1;
                    if constexpr (SRCBF) { const u32x4 q = *(const u32x4*)((const bf16_t*)sbase + (ro - soff) + bj * HALF);
                        x0 = (f32x4){lo2f(q.x), hi2f(q.x), lo2f(q.y), hi2f(q.y)}; x1 = (f32x4){lo2f(q.z), hi2f(q.z), lo2f(q.w), hi2f(q.w)}; }
                    else { const float* sp = (const float*)sbase + (ro - soff) + bj * HALF; x0 = *(const f32x4*)sp; x1 = *(const f32x4*)(sp + 4); }
                    const f32x4 r0 = x0 + gv[bj][0] * acc[ai][bj][m][0], r1 = x1 + gv[bj][1] * acc[ai][bj][m][1];
                    u32x4 w; w.x = cvt_pk_bf16(r0[0], r0[1]); w.y = cvt_pk_bf16(r0[2], r0[3]); w.z = cvt_pk_bf16(r1[0], r1[1]); w.w = cvt_pk_bf16(r1[2], r1[3]);
                    *(u32x4*)(dst + ro + bj * HALF) = w; } }
    }
};
DI float swiglu1(float glu, float lin) {
    glu = fminf(glu, 7.0f); lin = fminf(fmaxf(lin, -7.0f), 7.0f);
    return glu * __builtin_amdgcn_rcpf(1.0f + __builtin_amdgcn_exp2f(-1.702f * 1.44269504f * glu)) * (lin + 1.0f);
}
struct EpiSwiglu {
    static constexpr bool PERM = true, FP8 = true; static constexpr int CM = 0;
    unsigned char* H; const float* b1;
    DI void prefetch(const Unit& u, unsigned prm, int wid) const { if (wid == 0) dma1k(b1, (unsigned)((u.e * 2048 + u.pn * BM) * 4), prm + PRM_VEC); }
    DI void operator()(const f32x4 (&acc)[2][2][4][2], const Unit& u, int wr, int wc, int fr, int fq, const LAS unsigned char* prmp) const {
        const int row0 = u.slot0 + wr * 64 + fr, colh = u.pn * 128 + wc * 32 + 8 * fq;
        f32x4 bv[2][2];
#pragma unroll
        for (int bj = 0; bj < 2; ++bj)
#pragma unroll
            for (int n = 0; n < 2; ++n) bv[bj][n] = *(const LAS f32x4*)(prmp + PRM_VEC + (wc * 64 + 16 * fq + 8 * bj + 4 * n) * 4);
        constexpr float ds = 1.0f / Q8_W;
#pragma unroll
        for (int ai = 0; ai < 2; ++ai)
#pragma unroll
            for (int m = 0; m < 4; ++m) { unsigned char* rowp = H + (size_t)(row0 + ai * HALF + m * 16) * 1024 + colh;
                u32x2 w;
#pragma unroll
                for (int bj = 0; bj < 2; ++bj) { const f32x4 v0 = acc[ai][bj][m][0] * ds + bv[bj][0], v1 = acc[ai][bj][m][1] * ds + bv[bj][1];
                    const unsigned p = pack4_fp8(swiglu1(v0[0], v0[1]) * Q8_H, swiglu1(v0[2], v0[3]) * Q8_H, swiglu1(v1[0], v1[1]) * Q8_H, swiglu1(v1[2], v1[3]) * Q8_H);
                    if (bj == 0) w.x = p; else w.y = p; }
                *(u32x2*)rowp = w; }
    }
};
struct EpiMoeOut {
    static constexpr bool PERM = true, FP8 = true; static constexpr int CM = 2;
    unsigned char* Y; const float* b2; const int* list; const float* sgate;
    DI void prefetch(const Unit& u, unsigned prm, int wid) const {
        const unsigned lo = (unsigned)(((size_t)u.e * TT + u.pm * BM) * 4);
        if (wid == 0) dma1k(b2, (unsigned)((u.e * 1024 + u.pn * BM) * 4), prm + PRM_VEC);
        if (wid == 1) dma1k(list, lo, prm + PRM_AID);
        if (wid == 2) dma1k(sgate, lo, prm + PRM_GATE);
    }
    DI void operator()(const f32x4 (&acc)[2][2][4][2], const Unit& u, int wr, int wc, int fr, int fq, const LAS unsigned char* prmp) const {
        const int rl0 = wr * 64 + fr, cl0 = wc * 64 + 16 * fq;
        constexpr float ds = 1.0f / (Q8_W * Q8_H);
        f32x4 bv[2][2];
#pragma unroll
        for (int bj = 0; bj < 2; ++bj)
#pragma unroll
            for (int n = 0; n < 2; ++n) bv[bj][n] = *(const LAS f32x4*)(prmp + PRM_VEC + (cl0 + bj * 8 + 4 * n) * 4);
#pragma unroll
        for (int ai = 0; ai < 2; ++ai)
#pragma unroll
            for (int m = 0; m < 4; ++m) { const int rl = rl0 + ai * HALF + m * 16;
                if (rl < u.nvalid) {
                    const int aid = *(const LAS int*)(prmp + PRM_AID + rl * 4); const float gt = *(const LAS float*)(prmp + PRM_GATE + rl * 4) * Q8_Y;
                    u32x4 w;
#pragma unroll
                    for (int bj = 0; bj < 2; ++bj) { const f32x4 v0 = (acc[ai][bj][m][0] * ds + bv[bj][0]) * gt, v1 = (acc[ai][bj][m][1] * ds + bv[bj][1]) * gt;
                        const unsigned p0 = pack4_fp8(clamp8(v0[0]), clamp8(v0[1]), clamp8(v0[2]), clamp8(v0[3])), p1 = pack4_fp8(clamp8(v1[0]), clamp8(v1[1]), clamp8(v1[2]), clamp8(v1[3]));
                        if (bj == 0) { w.x = p0; w.y = p1; } else { w.z = p0; w.w = p1; } }
                    *(u32x4*)(Y + (size_t)aid * 1024 + u.pn * BM + cl0) = w; } }
    }
};
}
constexpr int TR_W1 = 0, TR_W2 = 8192, TR_WIN0 = 12288, TR_WOUT0 = 12576, TR_WIN1 = 12640, TR_WOUT1 = 12832, TR_SW2 = 12896, TR_SA2 = 12900, TR_SG2 = 12904, NTR = 12908;
constexpr int P0_MOD = NTR, P0_FIL = NTR + 384, P0_ROPE = P0_FIL + 256, P0_UNITS = P0_ROPE + 1;

struct TrJob { const float* src; bf16_t* dst; int K, N, Npad, kt, nt, q8; };
DI TrJob tr_job(const KArgs& a, int u) {
    TrJob j; unsigned char* ws = a.ws; j.q8 = 0;
    if (u < TR_W2) { const int m = u / 128, r = u % 128; j.src = KIN(a, 8) + (size_t)m * 1024 * 2048; j.dst = (bf16_t*)(ws + WS_W1T + (size_t)m * 2048 * 1024); j.q8 = 2; j.K = 1024; j.N = 2048; j.Npad = 2048; j.kt = r / 8; j.nt = r % 8; }
    else if (u < TR_WIN0) { const int v = u - TR_W2, m = v / 64, r = v % 64; j.src = KIN(a, 10) + (size_t)m * 1024 * 1024; j.dst = (bf16_t*)(ws + WS_W2TM + (size_t)m * 1024 * 1024); j.q8 = 1; j.K = 1024; j.N = 1024; j.Npad = 1024; j.kt = r / 4; j.nt = r % 4; }
    else if (u < TR_WOUT0) { const int r = u - TR_WIN0; j.src = KIN(a, 12); j.dst = (bf16_t*)(ws + WS_WIN0); j.K = 1024; j.N = ABCOLS; j.Npad = ABPAD; j.kt = r / 18; j.nt = r % 18; }
    else if (u < TR_WIN1) { const int r = u - TR_WOUT0; j.src = KIN(a, 13); j.dst = (bf16_t*)(ws + WS_WOUT0); j.K = 1024; j.N = 1024; j.Npad = 1024; j.kt = r / 4; j.nt = r % 4; }
    else if (u < TR_WOUT1) { const int r = u - TR_WIN1; j.src = KIN(a, 27); j.dst = (bf16_t*)(ws + WS_WIN1); j.K = 1024; j.N = CDCOLS; j.Npad = CDCOLS; j.kt = r / 12; j.nt = r % 12; }
    else if (u < TR_SW2) { const int r = u - TR_WOUT1; j.src = KIN(a, 28); j.dst = (bf16_t*)(ws + WS_WOUT1); j.K = 1024; j.N = 1024; j.Npad = 1024; j.kt = r / 4; j.nt = r % 4; }
    else if (u < TR_SA2) { const int r = u - TR_SW2, m = r / 2; j.src = KIN(a, 16) + (size_t)m * 64 * 512; j.dst = (bf16_t*)(ws + WS_W2T) + (size_t)m * 512 * 64; j.K = 64; j.N = 512; j.Npad = 512; j.kt = 0; j.nt = r % 2; }
    else if (u < TR_SG2) { const int r = u - TR_SA2, m = r / 2; j.src = KIN(a, 18) + (size_t)m * 64 * 512; j.dst = (bf16_t*)(ws + WS_A2T) + (size_t)m * 512 * 64; j.K = 64; j.N = 512; j.Npad = 512; j.kt = 0; j.nt = r % 2; }
    else { const int r = u - TR_SG2; j.src = KIN(a, 19); j.dst = (bf16_t*)(ws + WS_G2T); j.K = 128; j.N = 512; j.Npad = 512; j.kt = r / 2; j.nt = r % 2; }
    return j;
}
DI void tr_load(const TrJob& j, int tid, f32x4 (&v)[8]) {
    const int c4 = tid & 63, r0 = tid >> 6, n = j.nt * 256 + c4 * 4;
#pragma unroll
    for (int p = 0; p < 8; ++p) {
        const int k = j.kt * 64 + p * 8 + r0;
        v[p] = (n < j.N) ? *(const f32x4*)(j.src + (size_t)k * j.N + n) : (f32x4){0.f, 0.f, 0.f, 0.f};
    }
}
DI void tr_step(LAS float* sT, const KArgs& a, TrJob& j, f32x4 (&v)[8], int tid, int un, int uend) {
    const int c4 = tid & 63, r0 = tid >> 6;
#pragma unroll
    for (int p = 0; p < 8; ++p) { LAS float* d = sT + (p * 8 + r0) * 257 + c4 * 4; d[0] = v[p][0]; d[1] = v[p][1]; d[2] = v[p][2]; d[3] = v[p][3]; }
    __syncthreads();
    const TrJob jo = j;
    if (un < uend) { j = tr_job(a, un); tr_load(j, tid, v); }
    const int k8 = tid & 7;
#pragma unroll
    for (int q = 0; q < 4; ++q) {
        const int nl = q * 64 + (tid >> 3), n = jo.nt * 256 + nl;
        float x[8];
#pragma unroll
        for (int e = 0; e < 8; ++e) x[e] = sT[(k8 * 8 + e) * 257 + nl];
        if (jo.q8) {
            const int g = jo.q8 == 2 ? ((((nl >> 3) & 1) << 7) | (((nl >> 6) & 3) << 5) | (((nl >> 4) & 3) << 3) | (nl & 7)) : nl;
            u32x2 w; w.x = pack4_fp8(clamp8(x[0] * Q8_W), clamp8(x[1] * Q8_W), clamp8(x[2] * Q8_W), clamp8(x[3] * Q8_W)); w.y = pack4_fp8(clamp8(x[4] * Q8_W), clamp8(x[5] * Q8_W), clamp8(x[6] * Q8_W), clamp8(x[7] * Q8_W));
            *(u32x2*)((unsigned char*)jo.dst + (size_t)(jo.nt * 256 + g) * 1024 + jo.kt * 64 + k8 * 8) = w;
        } else if (n < jo.Npad) { u32x4 w; w.x = pack2(x[0], x[1]); w.y = pack2(x[2], x[3]); w.z = pack2(x[4], x[5]); w.w = pack2(x[6], x[7]);
            *(u32x4*)(jo.dst + (size_t)n * jo.K + jo.kt * 64 + k8 * 8) = w; }
    }
    __syncthreads();
}
struct Tr8Job { const float* src; unsigned char* dst; int N, kt, nt, w1; };
DI Tr8Job tr8_job(const KArgs& a, int u) {
    Tr8Job j; unsigned char* ws = a.ws;
    if (u < TR_W2) { const int m = u / 128, r = u % 128; j.src = KIN(a, 8) + (size_t)m * 1024 * 2048; j.dst = ws + WS_W1T + (size_t)m * 2048 * 1024; j.N = 2048; j.kt = r / 16; j.nt = r % 16; j.w1 = 1; }
    else { const int v = u - TR_W2, m = v / 64, r = v % 64; j.src = KIN(a, 10) + (size_t)m * 1024 * 1024; j.dst = ws + WS_W2TM + (size_t)m * 1024 * 1024; j.N = 1024; j.kt = r / 8; j.nt = r % 8; j.w1 = 0; }
    return j;
}
DI void tr8_load(const Tr8Job& j, int tid, f32x4 (&v)[8]) {
    const int c4 = tid & 31, r0 = tid >> 5;
    const float* p = j.src + (size_t)(j.kt * 128 + r0 * 8) * j.N + j.nt * 128 + c4 * 4;
#pragma unroll
    for (int q = 0; q < 8; ++q) v[q] = *(const f32x4*)(p + (size_t)q * j.N);
}
DI void tr8_step(LAS unsigned char* img, const KArgs& a, Tr8Job& j, f32x4 (&v)[8], int tid, int un, int uend) {
    const int c4 = tid & 31, r0 = tid >> 5;
#pragma unroll
    for (int e = 0; e < 4; ++e) { const int n = c4 * 4 + e;
        u32x2 w; w.x = pack4_fp8(clamp8(v[0][e] * Q8_W), clamp8(v[1][e] * Q8_W), clamp8(v[2][e] * Q8_W), clamp8(v[3][e] * Q8_W)); w.y = pack4_fp8(clamp8(v[4][e] * Q8_W), clamp8(v[5][e] * Q8_W), clamp8(v[6][e] * Q8_W), clamp8(v[7][e] * Q8_W));
        *(LAS u32x2*)(img + n * 128 + ((r0 ^ (c4 & 15)) * 8)) = w; }
    __syncthreads();
    const Tr8Job jo = j;
    if (un < uend) { j = tr8_job(a, un); tr8_load(j, tid, v); }
#pragma unroll
    for (int q = 0; q < 2; ++q) { const int idx = tid + q * NTHR, n = idx >> 3, g = idx & 7, s = (n >> 2) & 15;
        u32x4 w = *(const LAS u32x4*)(img + n * 128 + ((g ^ (s >> 1)) * 16));
        if (s & 1) { const unsigned t0 = w.x, t1 = w.y; w.x = w.z; w.y = w.w; w.z = t0; w.w = t1; }
        const int nn = jo.nt * 128 + n;
        const int nl = nn & 255, row = jo.w1 ? ((nn & ~255) | (((nl >> 3) & 1) << 7) | (((nl >> 6) & 3) << 5) | (((nl >> 4) & 3) << 3) | (nl & 7)) : nn;
        *(u32x4*)(jo.dst + (size_t)row * 1024 + jo.kt * 128 + g * 16) = w; }
}
DI void tr8_range(LAS unsigned char* lds, const KArgs& a, int tid, int u0, int uend, int stride) {
    int u = u0, par = 0; f32x4 vA[8], vB[8]; Tr8Job jA{}, jB{};
    if (u < uend) { jA = tr8_job(a, u); tr8_load(jA, tid, vA); }
    if (u + stride < uend) { jB = tr8_job(a, u + stride); tr8_load(jB, tid, vB); }
    while (u < uend) {
        tr8_step(lds + par * 16384, a, jA, vA, tid, u + 2 * stride, uend); par ^= 1;
        u += stride; if (u >= uend) break;
        tr8_step(lds + par * 16384, a, jB, vB, tid, u + 2 * stride, uend); par ^= 1;
        u += stride;
    }
    __syncthreads();
}
DI void tr_range(LAS float* sT, const KArgs& a, int tid, int u0, int uend, int stride) {
    int u = u0; f32x4 vA[8], vB[8]; TrJob jA{}, jB{};
    if (u < uend) { jA = tr_job(a, u); tr_load(jA, tid, vA); }
    if (u + stride < uend) { jB = tr_job(a, u + stride); tr_load(jB, tid, vB); }
    while (u < uend) {
        tr_step(sT, a, jA, vA, tid, u + 2 * stride, uend);
        u += stride; if (u >= uend) break;
        tr_step(sT, a, jB, vB, tid, u + 2 * stride, uend);
        u += stride;
    }
}
DI void p0_prologue(const Frame& F, const KArgs& a) {
    LAS float* sT = (LAS float*)F.lds;
    const int tid = F.tid;
    tr8_range(F.lds, a, tid, F.bid, TR_WIN0, F.G);
    tr_range(sT, a, tid, TR_WIN0 + F.bid, NTR, F.G);
    {
        LAS float* sc = (LAS float*)F.lds;
        LAS float* red = sc + 5 * 1024;
        bool staged = false;
        for (int u = P0_MOD + F.bid; u < P0_FIL; u += F.G) {
            if (!staged) {
                for (int i = tid; i < 5 * 1024; i += NTHR) { const float cv = (i < 4096) ? KIN(a, 1)[i] : KIN(a, 3)[i - 4096]; sc[i] = siluf_(cv); }
                staged = true; __syncthreads();
            }
            const int v = u - P0_MOD, l = v / 192, n0 = (v % 192) * 32;
            const int cg = tid & 7, ks = tid >> 3;
            const float* W = KIN(a, 4) + (size_t)l * 1024 * 6144 + n0 + cg * 4;
            f32x4 wv4[16];
#pragma unroll
            for (int kk = 0; kk < 16; ++kk) wv4[kk] = *(const f32x4*)(W + (size_t)(kk * 64 + ks) * 6144);
            f32x4 acc[5];
#pragma unroll
            for (int b = 0; b < 5; ++b) acc[b] = (f32x4){0.f, 0.f, 0.f, 0.f};
#pragma unroll
            for (int kk = 0; kk < 16; ++kk)
#pragma unroll
                for (int b = 0; b < 5; ++b) acc[b] += wv4[kk] * sc[b * 1024 + kk * 64 + ks];
#pragma unroll
            for (int b = 0; b < 5; ++b) *(LAS f32x4*)(red + (ks * 5 + b) * 32 + cg * 4) = acc[b];
            __syncthreads();
            if (tid < 160) { const int b = tid >> 5, c = tid & 31; float s = KIN(a, 5)[(size_t)l * 6144 + n0 + c];
#pragma unroll 8
                for (int k2 = 0; k2 < 64; ++k2) s += red[(k2 * 5 + b) * 32 + c];
                ((float*)(a.ws + WS_MOD))[((size_t)l * 5 + b) * 6144 + n0 + c] = s; }
            __syncthreads();
        }
    }
    {
        LAS float* z = (LAS float*)F.lds;
        LAS float* h1 = z + 32 * 36;
        LAS float* h2T = h1 + 32 * 64;
        LAS float* w1s = h2T + 64 * 32;
        LAS float* w2s = w1s + 33 * 64;
        const float* w1 = KIN(a, 33); const float* b1 = KIN(a, 34); const float* fr1 = KIN(a, 35);
        const float* w2 = KIN(a, 36); const float* b2 = KIN(a, 37); const float* fr2 = KIN(a, 38); const float* w3 = KIN(a, 39);
        bool wst = false;
        for (int u = P0_FIL + F.bid; u < P0_ROPE; u += F.G) {
            const int p0 = (u - P0_FIL) * 32;
            if (!wst) { for (int i = tid; i < 33 * 64; i += NTHR) w1s[i] = w1[i];
                for (int i = tid; i < 64 * 64; i += NTHR) w2s[i] = w2[i];
                wst = true; }
            { const int p = tid >> 4, f = tid & 15; const int pos = p0 + p;
              const float freq = 1e-4f + (float)f * ((15.0f - 1e-4f) / 15.0f);
              const float ang = (6.283185307179586f / 8192.0f) * (float)pos * freq;
              float sn, cs; __sincosf(ang, &sn, &cs);
              z[p * 36 + 1 + f] = cs; z[p * 36 + 17 + f] = -sn;
              if (f == 0) z[p * 36] = (float)pos * (1.0f / 8191.0f); }
            __syncthreads();
#pragma unroll
            for (int q = 0; q < 4; ++q) { const int o = tid + q * NTHR, p = o >> 6, jn = o & 63; float s = b1[jn];
#pragma unroll
                for (int i = 0; i < 33; ++i) s += z[p * 36 + i] * w1s[i * 64 + jn];
                h1[p * 64 + jn] = __sinf(fr1[jn] * s); }
            __syncthreads();
#pragma unroll
            for (int q = 0; q < 4; ++q) { const int o = tid + q * NTHR, p = o >> 6, jn = o & 63; float s = b2[jn];
#pragma unroll
                for (int i = 0; i < 64; ++i) s += h1[p * 64 + i] * w2s[i * 64 + jn];
                h2T[jn * 32 + p] = __sinf(fr2[jn] * s); }
            __syncthreads();
#pragma unroll 1
            for (int q = 0; q < 4; ++q) {
                const int n = tid + q * NTHR;
                f32x4 acc[8];
#pragma unroll
                for (int p = 0; p < 8; ++p) acc[p] = (f32x4){0.f, 0.f, 0.f, 0.f};
#pragma unroll 1
                for (int i0 = 0; i0 < 64; i0 += 16) { float w[16];
#pragma unroll
                    for (int i = 0; i < 16; ++i) w[i] = w3[(i0 + i) * 2048 + n];
#pragma unroll
                    for (int i = 0; i < 16; ++i)
#pragma unroll
                        for (int p4 = 0; p4 < 8; ++p4) { const f32x4 hv = *(const LAS f32x4*)(h2T + (i0 + i) * 32 + p4 * 4); acc[p4] += hv * w[i]; } }
                const int c = n & 511;
                const float dlo = -3.0701134573253946f, dhi = -15.350567286626973f;
                const float delta = fabsf(dlo + (dhi - dlo) * ((float)c / 511.0f));
                float* dst = (float*)(a.ws + WS_HYF) + (size_t)n * 8192 + p0;
#pragma unroll
                for (int p4 = 0; p4 < 8; ++p4) { f32x4 o4;
#pragma unroll
                    for (int e = 0; e < 4; ++e) { const float tn = (float)(p0 + p4 * 4 + e) * (1.0f / 8191.0f); o4[e] = acc[p4][e] * __expf(-tn * delta); }
                    *(f32x4*)(dst + p4 * 4) = o4; }
            }
            __syncthreads();
        }
    }
    for (int u = P0_ROPE + F.bid; u < P0_UNITS; u += F.G) {
        for (int i = tid; i < 2048; i += NTHR) { const int pos = i >> 4, k = i & 15; const float inv = powf(10000.0f, -(float)k / 16.0f);
            float sn, cs; sincosf((float)pos * inv, &sn, &cs); ((f32x2*)(a.ws + WS_ROPE))[i] = (f32x2){cs, sn}; }
    }
}

DI void row_load16_bf(const bf16_t* src, int lane, f32x4 (&v)[4]) {
#pragma unroll
    for (int i = 0; i < 4; ++i) { const u32x2 q = *(const u32x2*)(src + i * 256 + lane * 4); v[i] = (f32x4){lo2f(q.x), hi2f(q.x), lo2f(q.y), hi2f(q.y)}; }
}
DI void row_load16(const float* src, int lane, f32x4 (&v)[4]) {
#pragma unroll
    for (int i = 0; i < 4; ++i) v[i] = *(const f32x4*)(src + i * 256 + lane * 4);
}
DI void row_modulate(f32x4 (&v)[4], const float* sh, const float* scl, int lane) {
    float ss = 0.f;
#pragma unroll
    for (int i = 0; i < 4; ++i) ss += v[i][0] * v[i][0] + v[i][1] * v[i][1] + v[i][2] * v[i][2] + v[i][3] * v[i][3];
    ss = wave_sum(ss);
    const float inv = rsqrtf(ss * (1.0f / 1024.0f) + 1e-6f);
#pragma unroll
    for (int i = 0; i < 4; ++i) { const f32x4 s4 = *(const f32x4*)(sh + i * 256 + lane * 4), c4 = *(const f32x4*)(scl + i * 256 + lane * 4);
        v[i] = v[i] * inv * (c4 + 1.0f) + s4; }
}
DI void row_store_bf16(bf16_t* dst, int lane, const f32x4 (&v)[4]) {
#pragma unroll
    for (int i = 0; i < 4; ++i) { u32x2 w; w.x = pack2(v[i][0], v[i][1]); w.y = pack2(v[i][2], v[i][3]); *(u32x2*)(dst + i * 256 + lane * 4) = w; }
}
DI int row_sel(int row) { return row < TL ? row / SEQ : 4; }
DI void p_modulate_in(const Frame& F, const KArgs& a) {
    const float* mod = (const float*)(a.ws + WS_MOD);
    bf16_t* hA = (bf16_t*)(a.ws + WS_HA);
    for (int row = F.bid * 8 + F.wave; row < TT; row += F.G * 8) {
        const float* src = row < TL ? KIN(a, 0) + (size_t)row * DM : KIN(a, 2) + (size_t)(row - TL) * DM;
        f32x4 v[4]; row_load16(src, F.lane, v);
        const float* m = mod + (size_t)row_sel(row) * 6144;
        row_modulate(v, m, m + 1024, F.lane);
        row_store_bf16(hA + (size_t)row * DM, F.lane, v);
    }
}
constexpr int ST_TOK = 32, ST_UNITS = TL / 32 + TC / 16, APITCH = 136, NSTEP = CL + SEQ;
constexpr int NCHUNK = NSTEP / 16, CBR = 12288, CBH = 7168;
constexpr size_t RW_OFF = 0, RW_BYTES = (size_t)64 * NCHUNK * CBR, HG_OFF = RW_OFF + RW_BYTES, HG_BYTES = (size_t)64 * NCHUNK * CBH, G_OFF = HG_OFF + HG_BYTES,
                 VTOK_OFF = G_OFF + (size_t)TT * 512 * 2, CBON_OFF = VTOK_OFF + (size_t)TT * 512 * 2;
static_assert(CBON_OFF + (size_t)2 * TT * 8 * 4 <= R1_BYTES, "layer-0 streams fit region 1");
DI size_t hg_elem(int chain, int s) { return ((size_t)chain * NCHUNK + (s >> 4)) * (CBH / 2) + (s & 15) * 192; }
DI float fast_rcp(float x) { return __builtin_amdgcn_rcpf(x); }
DI float fsigmoid(float x) { return fast_rcp(1.0f + __expf(-x)); }
DI float fsilu(float x) { return x * fast_rcp(1.0f + __expf(-x)); }
DI float ftanh(float x) { return 1.0f - 2.0f * fast_rcp(1.0f + __expf(2.0f * x)); }
DI int step_of(int row, int d) {
    if (row < TL) { const int t = row & (SEQ - 1); return CL + (d ? SEQ - 1 - t : t); }
    const int t = (row - TL) & (CL - 1); return d ? CL - 1 - t : t;
}
DI int batch_of(int row) { return row < TL ? row / SEQ : (row - TL) / CL; }
DI int scan_row(int b, int d, int s) {
    if (s < CL) return TL + b * CL + (d ? CL - 1 - s : s);
    const int t = s - CL; return b * SEQ + (d ? SEQ - 1 - t : t);
}
DI void p_streams(const Frame& F, const KArgs& a) {
    const bf16_t* U = (const bf16_t*)(a.ws + WS_U);
    bf16_t* RW = (bf16_t*)(a.ws + WS_R1 + RW_OFF); bf16_t* HG = (bf16_t*)(a.ws + WS_R1 + HG_OFF); bf16_t* G = (bf16_t*)(a.ws + WS_R1 + G_OFF); bf16_t* VTOK = (bf16_t*)(a.ws + WS_R1 + VTOK_OFF);
    LAS bf16_t* Ks  = (LAS bf16_t*)F.lds;
    LAS bf16_t* KKs = Ks + 32 * 512;
    LAS bf16_t* Alw = KKs + 32 * 512;
    LAS bf16_t* Aad = Alw + 32 * APITCH;
    LAS bf16_t* Asg = Aad + 32 * APITCH;
    const float* shiftw = KIN(a, 14);
    const bf16_t* w2t = (const bf16_t*)(a.ws + WS_W2T);
    const bf16_t* a2t = (const bf16_t*)(a.ws + WS_A2T);
    const bf16_t* g2t = (const bf16_t*)(a.ws + WS_G2T);
    const float* w0p = KIN(a, 15); const float* a0p = KIN(a, 17); const float* kap = KIN(a, 21); const float* kkp = KIN(a, 20); const float* lbl = KIN(a, 25);
    const int tid = F.tid, lane = F.lane, wv = F.wave;
    for (int u = F.bid; u < ST_UNITS; u += F.G) {
        const int row0 = u < TL / 32 ? u * 32 : TL + (u - TL / 32) * 16, ntok = u < TL / 32 ? 32 : 16;
        const int seq_start = row0 < TL ? (row0 / SEQ) * SEQ : TL + ((row0 - TL) / CL) * CL;
        const int seq_end = row0 < TL ? seq_start + SEQ : seq_start + CL;
        const int bb = batch_of(row0);
        const int s0f = step_of(row0, 0), s0b = step_of(row0, 1);
        if (tid < 480) {
            const int col = tid * 4;
            float t0[4], t1[4], t2[4];
#pragma unroll
            for (int e = 0; e < 4; ++e) { t0[e] = shiftw[col + e]; t1[e] = shiftw[1920 + col + e]; t2[e] = shiftw[3840 + col + e]; }
            float kk_k[4] = {0.f, 0.f, 0.f, 0.f};
            if (col >= 512 && col < 1024) {
#pragma unroll
                for (int e = 0; e < 4; ++e) kk_k[e] = kkp[col - 512 + e];
            }
            const int vsel = col < 512 ? 0 : (col < 1024 ? 2 : 1), hcol = col & 511, hh = hcol >> 6, hc = hcol & 63;
            bf16_t* dF = RW + ((size_t)((bb * 8 + hh) * 2 + 0) * NSTEP + s0f) * 384 + vsel * 64 + hc;
            bf16_t* dB = RW + ((size_t)((bb * 8 + hh) * 2 + 1) * NSTEP + s0b) * 384 + vsel * 64 + hc;
            const u32x2 zero2 = (u32x2){0u, 0u};
            const bool odd = (tid & 1) != 0;
            bf16_t* dF8 = dF - (odd ? 4 : 0); bf16_t* dB8 = dB - (odd ? 4 : 0);
            u32x2 wsv = zero2;
#pragma unroll 1
            for (int hf = 0; hf < ntok / 16; ++hf) {
            u32x2 rws[18];
#pragma unroll
            for (int i = 0; i < 18; ++i) { const int rr_ = row0 + hf * 16 - 1 + i; rws[i] = (rr_ >= seq_start && rr_ < seq_end) ? *(const u32x2*)(U + (size_t)rr_ * ABPAD + col) : zero2; }
#pragma unroll
            for (int tt = 0; tt < 16; ++tt) {
                const int t = hf * 16 + tt, row = row0 + t;
                const u32x2 prv = rws[tt], cur = rws[tt + 1], nxt = rws[tt + 2];
                float x[4];
                x[0] = lo2f(prv.x) * t0[0] + lo2f(cur.x) * t1[0] + lo2f(nxt.x) * t2[0];
                x[1] = hi2f(prv.x) * t0[1] + hi2f(cur.x) * t1[1] + hi2f(nxt.x) * t2[1];
                x[2] = lo2f(prv.y) * t0[2] + lo2f(cur.y) * t1[2] + lo2f(nxt.y) * t2[2];
                x[3] = hi2f(prv.y) * t0[3] + hi2f(cur.y) * t1[3] + hi2f(nxt.y) * t2[3];
                if (col < 512 || (col >= 1024 && col < 1536)) {
                    u32x2 w; w.x = pack2(x[0], x[1]); w.y = pack2(x[2], x[3]);
                    if (!(tt & 1)) wsv = w;
                    else { const u32x2 snd = odd ? wsv : w; u32x2 rcv; rcv.x = (unsigned)__builtin_amdgcn_update_dpp(0, (int)snd.x, 0xB1, 0xF, 0xF, true); rcv.y = (unsigned)__builtin_amdgcn_update_dpp(0, (int)snd.y, 0xB1, 0xF, 0xF, true);
                        const u32x4 o = odd ? (u32x4){rcv.x, rcv.y, w.x, w.y} : (u32x4){wsv.x, wsv.y, rcv.x, rcv.y};
                        const int ts = t - 1 + (odd ? 1 : 0);
                        *(u32x4*)(dF8 + (size_t)ts * 384) = o; *(u32x4*)(dB8 - (size_t)ts * 384) = o;
                        if (col >= 1024) *(u32x4*)(VTOK + (size_t)(row0 + ts) * 512 + ((col - 1024) & ~7)) = o; }
                } else if (col < 1024) {
                    const int kc = col - 512;
                    u32x2 w; w.x = pack2(x[0], x[1]); w.y = pack2(x[2], x[3]);
                    *(LAS u32x2*)(Ks + t * 512 + kc) = w;
                    float q[4]; float ss = 0.f;
#pragma unroll
                    for (int e = 0; e < 4; ++e) { q[e] = x[e] * kk_k[e]; ss += q[e] * q[e]; }
                    ss = rowsum16(ss);
                    const float inv = 1.0f / fmaxf(sqrtf(ss), 1e-12f);
                    u32x2 w2; w2.x = pack2(q[0] * inv, q[1] * inv); w2.y = pack2(q[2] * inv, q[3] * inv);
                    *(LAS u32x2*)(KKs + t * 512 + kc) = w2;
                    if (!(tt & 1)) wsv = w2;
                    else { const u32x2 snd = odd ? wsv : w2; u32x2 rcv; rcv.x = (unsigned)__builtin_amdgcn_update_dpp(0, (int)snd.x, 0xB1, 0xF, 0xF, true); rcv.y = (unsigned)__builtin_amdgcn_update_dpp(0, (int)snd.y, 0xB1, 0xF, 0xF, true);
                        const u32x4 o = odd ? (u32x4){rcv.x, rcv.y, w2.x, w2.y} : (u32x4){wsv.x, wsv.y, rcv.x, rcv.y};
                        const int ts = t - 1 + (odd ? 1 : 0);
                        *(u32x4*)(dF8 + (size_t)ts * 384) = o; *(u32x4*)(dB8 - (size_t)ts * 384) = o; }
                } else if (col < 1664) {
                    u32x2 w; w.x = pack2(ftanh(x[0]), ftanh(x[1])); w.y = pack2(ftanh(x[2]), ftanh(x[3]));
                    *(LAS u32x2*)(Alw + t * APITCH + (col - 1536)) = w;
                } else if (col < 1792) {
                    u32x2 w; w.x = pack2(x[0], x[1]); w.y = pack2(x[2], x[3]);
                    *(LAS u32x2*)(Aad + t * APITCH + (col - 1664)) = w;
                } else {
                    u32x2 w; w.x = pack2(fsigmoid(x[0]), fsigmoid(x[1])); w.y = pack2(fsigmoid(x[2]), fsigmoid(x[3]));
                    *(LAS u32x2*)(Asg + t * APITCH + (col - 1792)) = w;
                }
            }
            }
        }
        {
#pragma unroll 4
            for (int it = 0; it < ntok / 2; ++it) {
                const int idx = tid + it * NTHR, t = idx >> 8, rem = idx & 255, vec = rem >> 6, pc = rem & 63, hh = pc >> 3, hc = (pc & 7) * 8;
                float x[8]; load8bf(U + (size_t)(row0 + t) * ABPAD + ACOLS + vec * 512 + pc * 8, x);
                bf16_t* cF = HG + hg_elem((bb * 8 + hh) * 2 + 0, s0f + t) + hc;
                bf16_t* cB = HG + hg_elem((bb * 8 + hh) * 2 + 1, s0b - t) + hc;
                if (vec == 0) {
#pragma unroll
                    for (int e = 0; e < 8; ++e) x[e] = fsilu(x[e]);
                    store8bf(cF, x); store8bf(cB, x);
                } else if (vec == 3) { store8bf(cF + 128, x); store8bf(cB + 128, x); }
                else {
                    float l0[8], l1[8]; load8f(lbl + pc * 8, l0); load8f(lbl + 512 + pc * 8, l1);
#pragma unroll
                    for (int e = 0; e < 8; ++e) { const float lb = fast_rcp(1.0f + __expf(l1[e] - l0[e])); x[e] = (1.0f - lb) * (1.0f - fsigmoid(x[e])); }
                    store8bf((vec == 1 ? cF : cB) + 64, x);
                }
            }
        }
        __syncthreads();
        {
            const int fr = lane & 15, fq = lane >> 4;
            bf16_t* eF = RW + ((size_t)((bb * 8 + wv) * 2 + 0) * NSTEP + s0f) * 384;
            bf16_t* eB = RW + ((size_t)((bb * 8 + wv) * 2 + 1) * NSTEP + s0b) * 384;
#pragma unroll 1
            for (int nt = 0; nt < 2; ++nt) {
                const int cb = wv * 64 + nt * 32;
                f32x4 accW[2][2][2], accA[2][2][2], accG[2][2];
#pragma unroll
                for (int m = 0; m < 2; ++m)
#pragma unroll
                    for (int n = 0; n < 2; ++n) { accG[m][n] = (f32x4){0.f, 0.f, 0.f, 0.f};
#pragma unroll
                        for (int d = 0; d < 2; ++d) { accW[d][m][n] = (f32x4){0.f, 0.f, 0.f, 0.f}; accA[d][m][n] = (f32x4){0.f, 0.f, 0.f, 0.f}; } }
#pragma unroll
                for (int n = 0; n < 2; ++n) {
                    const int c = cb + 8 * (fr >> 2) + 4 * n + (fr & 3);
#pragma unroll
                    for (int d = 0; d < 2; ++d)
#pragma unroll
                        for (int ks = 0; ks < 2; ++ks) {
                            const bf16x8 bw = *(const bf16x8*)(w2t + ((size_t)d * 512 + c) * 64 + ks * 32 + fq * 8);
                            const bf16x8 ba = *(const bf16x8*)(a2t + ((size_t)d * 512 + c) * 64 + ks * 32 + fq * 8);
#pragma unroll
                            for (int m = 0; m < 2; ++m) {
                                const bf16x8 aw = *(const LAS bf16x8*)(Alw + (m * 16 + fr) * APITCH + d * 64 + ks * 32 + fq * 8);
                                const bf16x8 aa = *(const LAS bf16x8*)(Aad + (m * 16 + fr) * APITCH + d * 64 + ks * 32 + fq * 8);
                                accW[d][m][n] = __builtin_amdgcn_mfma_f32_16x16x32_bf16(bw, aw, accW[d][m][n], 0, 0, 0);
                                accA[d][m][n] = __builtin_amdgcn_mfma_f32_16x16x32_bf16(ba, aa, accA[d][m][n], 0, 0, 0);
                            }
                        }
#pragma unroll
                    for (int ks = 0; ks < 4; ++ks) {
                        const bf16x8 bg = *(const bf16x8*)(g2t + (size_t)c * 128 + ks * 32 + fq * 8);
#pragma unroll
                        for (int m = 0; m < 2; ++m) {
                            const bf16x8 ag = *(const LAS bf16x8*)(Asg + (m * 16 + fr) * APITCH + ks * 32 + fq * 8);
                            accG[m][n] = __builtin_amdgcn_mfma_f32_16x16x32_bf16(bg, ag, accG[m][n], 0, 0, 0);
                        }
                    }
                }
                const int c8 = cb + fq * 8, hc8 = nt * 32 + fq * 8;
                f32x4 ka[2];
#pragma unroll
                for (int n = 0; n < 2; ++n) ka[n] = *(const f32x4*)(kap + c8 + 4 * n);
#pragma unroll
                for (int m = 0; m < 2; ++m) {
                    __builtin_amdgcn_sched_barrier(0);
                    const int tt = m * 16 + fr;
                    if (tt >= ntok) continue;
                    const u32x4 kw = *(const LAS u32x4*)(Ks + tt * 512 + c8), kkw = *(const LAS u32x4*)(KKs + tt * 512 + c8);
                    float kv[8], kkv[8];
                    kv[0] = lo2f(kw.x); kv[1] = hi2f(kw.x); kv[2] = lo2f(kw.y); kv[3] = hi2f(kw.y); kv[4] = lo2f(kw.z); kv[5] = hi2f(kw.z); kv[6] = lo2f(kw.w); kv[7] = hi2f(kw.w);
                    kkv[0] = lo2f(kkw.x); kkv[1] = hi2f(kkw.x); kkv[2] = lo2f(kkw.y); kkv[3] = hi2f(kkw.y); kkv[4] = lo2f(kkw.z); kkv[5] = hi2f(kkw.z); kkv[6] = lo2f(kkw.w); kkv[7] = hi2f(kkw.w);
#pragma unroll
                    for (int d = 0; d < 2; ++d) {
                        float mm[8], bq[8], kq[8];
                        f32x4 w0d[2], a0d[2];
#pragma unroll
                        for (int n = 0; n < 2; ++n) { w0d[n] = *(const f32x4*)(w0p + d * 512 + c8 + 4 * n); a0d[n] = *(const f32x4*)(a0p + d * 512 + c8 + 4 * n); }
#pragma unroll
                        for (int n = 0; n < 2; ++n)
#pragma unroll
                            for (int j = 0; j < 4; ++j) { const int e = n * 4 + j;
                                const float xw = -(w0d[n][j] + accW[d][m][n][j]);
                                const float sp = xw > 20.f ? xw : __logf(1.0f + __expf(xw));
                                mm[e] = 1.0f - __expf(-__expf(-sp - 0.5f));
                                const float av = fsigmoid(a0d[n][j] + accA[d][m][n][j]);
                                bq[e] = kkv[e] * av; kq[e] = kv[e] * (1.0f + (av - 1.0f) * ka[n][j]); }
                        bf16_t* dp = (d ? eB - (size_t)tt * 384 : eF + (size_t)tt * 384) + hc8;
                        store8bf(dp + 192, mm); store8bf(dp + 256, bq); store8bf(dp + 320, kq);
                    }
                    { float gg8[8];
#pragma unroll
                      for (int n = 0; n < 2; ++n)
#pragma unroll
                          for (int j = 0; j < 4; ++j) gg8[n * 4 + j] = accG[m][n][j];
                      store8bf(G + (size_t)(row0 + tt) * 512 + c8, gg8); }
                }
            }
        }
        __syncthreads();
    }
}
constexpr int RB_KT = 0, RB_RT = 2048, RB_KO = 4096, RB_BO = 6144, RB_VT = 8192, RB_NKT = 10240, RB_MK = 10752, RB_MB = 11264, RB_G = 11776;
constexpr int HB_QT = 0, HB_KO = 2048, HB_VT = 4096, HB_MK = 6144, HB_G = 6656;
constexpr int GP = 72;
DI int kperm(int k) { const int kk = k & 31, hi = kk >> 4, q = (kk & 15) >> 2, e = kk & 3; return (k & 32) + q * 8 + hi * 4 + e; }
DI f32x4 gram16(const LAS bf16_t* X, const LAS bf16_t* Y, int fr, int fq) {
    f32x4 acc = (f32x4){0.f, 0.f, 0.f, 0.f};
#pragma unroll
    for (int ks = 0; ks < 2; ++ks) { const bf16x8 af = *(const LAS bf16x8*)(X + fr * GP + ks * 32 + fq * 8), bfr = *(const LAS bf16x8*)(Y + fr * GP + ks * 32 + fq * 8);
        acc = __builtin_amdgcn_mfma_f32_16x16x32_bf16(af, bfr, acc, 0, 0, 0); }
    return acc;
}
DI void store16bf(bf16_t* p, const float (&x)[16]) {
    u32x4 w0, w1; w0.x = pack2(x[0], x[1]); w0.y = pack2(x[2], x[3]); w0.z = pack2(x[4], x[5]); w0.w = pack2(x[6], x[7]);
    w1.x = pack2(x[8], x[9]); w1.y = pack2(x[10], x[11]); w1.z = pack2(x[12], x[13]); w1.w = pack2(x[14], x[15]);
    *(u32x4*)p = w0; *(u32x4*)(p + 8) = w1;
}
DI void tri_solve16(float (&x)[16], const LAS float* NBc) {
#pragma unroll
    for (int tp = 1; tp < 16; ++tp) {
        float acc = x[tp];
#pragma unroll
        for (int t4 = 0; t4 < (tp + 3) / 4; ++t4) { const f32x4 nb = *(const LAS f32x4*)(NBc + tp * 16 + t4 * 4);
#pragma unroll
            for (int e = 0; e < 4; ++e) if (t4 * 4 + e < tp) acc -= x[t4 * 4 + e] * nb[e]; }
        x[tp] = acc;
    }
}
DI void p_prep(const Frame& F, const KArgs& a) {
    unsigned char* RWB = a.ws + WS_R1 + RW_OFF; unsigned char* HGB = a.ws + WS_R1 + HG_OFF;
    float* CBON = (float*)(a.ws + WS_R1 + CBON_OFF);
    const float* rkp = KIN(a, 22);
    const int lane = F.lane, wv = F.wave, fr = lane & 15, fq = lane >> 4;
    LAS unsigned char* wl = F.lds + wv * 16384;
    LAS bf16_t* M0 = (LAS bf16_t*)wl; LAS bf16_t* M1 = M0 + 16 * GP; LAS bf16_t* M2 = M1 + 16 * GP; LAS bf16_t* M3 = M2 + 16 * GP;
    LAS float* NBc = (LAS float*)(wl + 9216); LAS float* NKr = NBc + 256;
    const int pk = kperm(lane);
    const int NU = 64 * NCHUNK;
    for (int u = F.bid * 8 + wv; u < 2 * NU; u += F.G * 8) {
        if (u < NU) {
            const int chain = u / NCHUNK, chunk = u - chain * NCHUNK, b = chain >> 4, h = (chain >> 1) & 7, d = chain & 1;
            bf16_t* blk = (bf16_t*)(RWB + (size_t)u * CBR);
            const float rkv = rkp[h * 64 + lane];
            float kt[16], rt[16], kh[16], bh[16], vv[16], cbp[16];
            float g = 1.0f;
#pragma unroll
            for (int t = 0; t < 16; ++t) {
                const bf16_t* sp = blk + t * 384 + lane;
                const float rr = bf2f(sp[0]), v_ = bf2f(sp[64]), kk = bf2f(sp[128]), mm = bf2f(sp[192]), bb = bf2f(sp[256]), kd = bf2f(sp[320]);
                kt[t] = g * kk; g *= (1.0f - mm); rt[t] = g * rr;
                const float ig = fast_rcp(g); kh[t] = kd * ig; bh[t] = bb * ig; vv[t] = v_; cbp[t] = rr * kd * rkv;
            }
            const float g15 = g;
#pragma unroll
            for (int t = 0; t < 16; ++t) { M0[t * GP + lane] = f2bf(kt[t]); M1[t * GP + lane] = f2bf(rt[t]); M2[t * GP + lane] = f2bf(kh[t]); M3[t * GP + lane] = f2bf(bh[t]); }
#pragma unroll
            for (int t = 0; t < 16; ++t) { const float s = wave_sum(cbp[t]); if (lane == t) CBON[((size_t)d * TT + scan_row(b, d, chunk * 16 + t)) * 8 + h] = s; }
            asm volatile("s_waitcnt vmcnt(0) lgkmcnt(0)" ::: "memory");
            __builtin_amdgcn_wave_barrier();
            f32x4 nk = gram16(M2, M0, fr, fq), nb = gram16(M3, M0, fr, fq), mk = gram16(M2, M1, fr, fq), mb = gram16(M3, M1, fr, fq);
#pragma unroll
            for (int j = 0; j < 4; ++j) { const int i = fq * 4 + j;
                nk[j] = i < fr ? nk[j] : 0.f; nb[j] = i < fr ? nb[j] : 0.f; mk[j] = i <= fr ? mk[j] : 0.f; mb[j] = i <= fr ? mb[j] : 0.f;
                NBc[fr * 16 + i] = nb[j]; NKr[i * 16 + fr] = nk[j]; }
            { u32x2 w; w.x = pack2(mk[0], mk[1]); w.y = pack2(mk[2], mk[3]); *(u32x2*)((unsigned char*)blk + RB_MK + (fr * 16 + fq * 4) * 2) = w;
              w.x = pack2(mb[0], mb[1]); w.y = pack2(mb[2], mb[3]); *(u32x2*)((unsigned char*)blk + RB_MB + (fr * 16 + fq * 4) * 2) = w; }
            asm volatile("s_waitcnt lgkmcnt(0)" ::: "memory");
            __builtin_amdgcn_wave_barrier();
            tri_solve16(kt, NBc);
            bf16_t* kto = (bf16_t*)((unsigned char*)blk + RB_KT) + pk; bf16_t* rto = (bf16_t*)((unsigned char*)blk + RB_RT) + pk;
#pragma unroll
            for (int t = 0; t < 16; ++t) { kto[t * 64] = f2bf(kt[t]); rto[t * 64] = f2bf(rt[t]); }
            { float x2[16];
#pragma unroll
              for (int t4 = 0; t4 < 4; ++t4) { const f32x4 q = *(const LAS f32x4*)(NKr + fr * 16 + t4 * 4); x2[t4 * 4] = q[0]; x2[t4 * 4 + 1] = q[1]; x2[t4 * 4 + 2] = q[2]; x2[t4 * 4 + 3] = q[3]; }
              tri_solve16(x2, NBc);
              if (lane < 16) { bf16_t* no = (bf16_t*)((unsigned char*)blk + RB_NKT) + lane;
#pragma unroll
                  for (int t = 0; t < 16; ++t) no[t * 16] = f2bf(x2[t]); } }
#pragma unroll
            for (int t = 0; t < 16; ++t) { kh[t] *= g15; bh[t] *= g15; }
            store16bf((bf16_t*)((unsigned char*)blk + RB_KO) + lane * 16, kh);
            store16bf((bf16_t*)((unsigned char*)blk + RB_BO) + lane * 16, bh);
            store16bf((bf16_t*)((unsigned char*)blk + RB_VT) + lane * 16, vv);
            ((float*)((unsigned char*)blk + RB_G))[lane] = g15;
            __builtin_amdgcn_wave_barrier();
        } else {
            const int uu = u - NU;
            bf16_t* blk = (bf16_t*)(HGB + (size_t)uu * CBH);
            float qt[16], kh[16], vv[16];
            float g = 1.0f;
#pragma unroll
            for (int t = 0; t < 16; ++t) {
                const bf16_t* sp = blk + t * 192 + lane;
                const float qq = bf2f(sp[0]), kk = bf2f(sp[64]), ii = bf2f(sp[128]);
                g *= (1.0f - kk); qt[t] = g * qq; kh[t] = kk * fast_rcp(g); vv[t] = ii;
            }
            const float g15 = g;
#pragma unroll
            for (int t = 0; t < 16; ++t) { M0[t * GP + lane] = f2bf(qt[t]); M2[t * GP + lane] = f2bf(kh[t]); }
            asm volatile("s_waitcnt vmcnt(0) lgkmcnt(0)" ::: "memory");
            __builtin_amdgcn_wave_barrier();
            f32x4 mk = gram16(M2, M0, fr, fq);
#pragma unroll
            for (int j = 0; j < 4; ++j) mk[j] = (fq * 4 + j) <= fr ? mk[j] : 0.f;
            { u32x2 w; w.x = pack2(mk[0], mk[1]); w.y = pack2(mk[2], mk[3]); *(u32x2*)((unsigned char*)blk + HB_MK + (fr * 16 + fq * 4) * 2) = w; }
            bf16_t* qto = (bf16_t*)((unsigned char*)blk + HB_QT) + pk;
#pragma unroll
            for (int t = 0; t < 16; ++t) { qto[t * 64] = f2bf(qt[t]); kh[t] *= g15; }
            store16bf((bf16_t*)((unsigned char*)blk + HB_KO) + lane * 16, kh);
            store16bf((bf16_t*)((unsigned char*)blk + HB_VT) + lane * 16, vv);
            ((float*)((unsigned char*)blk + HB_G))[lane] = g15;
            asm volatile("s_waitcnt lgkmcnt(0)" ::: "memory");
            __builtin_amdgcn_wave_barrier();
        }
    }
}
constexpr int SCD = 11;
DI bf16x8 pk8(const f32x4 lo, const f32x4 hi) {
    u32x4 w; w.x = pg8::cvt_pk_bf16(lo[0], lo[1]); w.y = pg8::cvt_pk_bf16(lo[2], lo[3]); w.z = pg8::cvt_pk_bf16(hi[0], hi[1]); w.w = pg8::cvt_pk_bf16(hi[2], hi[3]);
    return __builtin_bit_cast(bf16x8, w);
}
DI bf16x8 ld_tok(const LAS unsigned char* p) { const u32x2 w = *(const LAS u32x2*)p; u32x4 q; q.x = w.x; q.y = w.y; q.z = 0u; q.w = 0u; return __builtin_bit_cast(bf16x8, q); }
DI void p_scan(const Frame& F, const KArgs& a) {
    bf16_t* YO = (bf16_t*)(a.ws + WS_R2);
    const int lane = F.lane, wv = F.wave, fr = lane & 15, fq = lane >> 4;
    LAS unsigned char* ring = F.lds;
    LAS unsigned char* dummy = F.lds + SCD * CBR;
    LAS unsigned char* xb = dummy + 1024;
    for (int su = F.bid; su < 256; su += F.G) {
        const bool is_rw = su < 128;
        const int cu = su & 127, chain = cu >> 1, half = cu & 1, b = chain >> 4, d = chain & 1, h = (chain >> 1) & 7;
        const int bsz = is_rw ? CBR : CBH, nkb = is_rw ? 12 : 7;
        const unsigned char* src = a.ws + WS_R1 + (is_rw ? RW_OFF : HG_OFF) + (size_t)chain * NCHUNK * bsz;
        const bool stager = wv >= 4;
        const int d0 = (wv - 4) * 3;
#define SC_DMA(c_) do { if (stager) { const int cc_ = (c_) < NCHUNK ? (c_) : NCHUNK - 1; const unsigned char* bs_ = src + (size_t)cc_ * bsz; LAS unsigned char* sl_ = ring + ((c_) % SCD) * CBR; \
        _Pragma("unroll") for (int i_ = 0; i_ < 3; ++i_) { const int dd_ = d0 + i_; const bool ok_ = dd_ < nkb; \
            __builtin_amdgcn_global_load_lds((const unsigned*)(bs_ + (ok_ ? dd_ * 1024 : 0) + lane * 16), (LAS unsigned*)(ok_ ? sl_ + dd_ * 1024 : dummy), 16, 0, 16); } } } while (0)
#pragma unroll 1
        for (int c = 0; c < SCD - 2; ++c) SC_DMA(c);
        if (stager) asm volatile("s_waitcnt vmcnt(24)" ::: "memory");
        asm volatile("" ::: "memory"); __builtin_amdgcn_s_barrier(); asm volatile("" ::: "memory");
        f32x4 ST[4];
#pragma unroll
        for (int n = 0; n < 4; ++n) ST[n] = (f32x4){0.f, 0.f, 0.f, 0.f};
        const int qw = wv & 1;
        const int vbase = (half * 2 + qw) * 16;
        bf16_t* yout = YO + ((size_t)(is_rw ? 0 : 2) + d) * TT * 512 + h * 64 + vbase + (fr & ~1);
        int yoff[4];
#pragma unroll
        for (int j = 0; j < 4; ++j) yoff[j] = (d ? -(fq * 4 + j) : (fq * 4 + j)) * 512;
        const f32x4 z4 = (f32x4){0.f, 0.f, 0.f, 0.f};
#pragma unroll 1
        for (int c = 0; c <= NCHUNK; ++c) {
            SC_DMA(c + SCD - 2);
            if (wv < 2 && c < NCHUNK) {
                const LAS unsigned char* blk = ring + (c % SCD) * CBR;
                const bf16x8 Sb0 = pk8(ST[0], ST[1]), Sb1 = pk8(ST[2], ST[3]);
                LAS unsigned char* xo = xb + (((c & 1) * 2 + qw) * 64 + lane) * 48;
                if (is_rw) {
                    const bf16x8 kt0 = *(const LAS bf16x8*)(blk + RB_KT + (fr * 64 + fq * 8) * 2), kt1 = *(const LAS bf16x8*)(blk + RB_KT + (fr * 64 + 32 + fq * 8) * 2);
                    const bf16x8 nkt = ld_tok(blk + RB_NKT + (fr * 16 + fq * 4) * 2);
                    const bf16x8 Vb = ld_tok(blk + RB_VT + ((vbase + fr) * 16 + fq * 4) * 2);
                    f32x4 gg[4]; bf16x8 ko[4], bo[4];
#pragma unroll
                    for (int n = 0; n < 4; ++n) { gg[n] = *(const LAS f32x4*)(blk + RB_G + (n * 16 + fq * 4) * 4);
                        ko[n] = ld_tok(blk + RB_KO + ((n * 16 + fr) * 16 + fq * 4) * 2); bo[n] = ld_tok(blk + RB_BO + ((n * 16 + fr) * 16 + fq * 4) * 2); }
                    __builtin_amdgcn_sched_barrier(0);
                    f32x4 UTa = __builtin_amdgcn_mfma_f32_16x16x32_bf16(kt0, Sb0, z4, 0, 0, 0);
                    f32x4 UTb = __builtin_amdgcn_mfma_f32_16x16x32_bf16(kt1, Sb1, z4, 0, 0, 0);
                    UTb = __builtin_amdgcn_mfma_f32_16x16x32_bf16(nkt, Vb, UTb, 0, 0, 0);
#pragma unroll
                    for (int n = 0; n < 4; ++n) ST[n] = __builtin_amdgcn_mfma_f32_16x16x32_bf16(ko[n], Vb, ST[n] * gg[n], 0, 0, 0);
                    const f32x4 UT = UTa + UTb;
                    u32x4 un; un.x = pack2(UT[0], UT[1]) ^ 0x80008000u; un.y = pack2(UT[2], UT[3]) ^ 0x80008000u; un.z = 0u; un.w = 0u;
                    const bf16x8 Un = __builtin_bit_cast(bf16x8, un);
                    *(LAS bf16x8*)xo = Sb0; *(LAS bf16x8*)(xo + 16) = Sb1; *(LAS u32x2*)(xo + 32) = (u32x2){un.x, un.y};
#pragma unroll
                    for (int n = 0; n < 4; ++n) ST[n] = __builtin_amdgcn_mfma_f32_16x16x32_bf16(bo[n], Un, ST[n], 0, 0, 0);
                } else {
                    const bf16x8 Vb = ld_tok(blk + HB_VT + ((vbase + fr) * 16 + fq * 4) * 2);
                    f32x4 gg[4]; bf16x8 ko[4];
#pragma unroll
                    for (int n = 0; n < 4; ++n) { gg[n] = *(const LAS f32x4*)(blk + HB_G + (n * 16 + fq * 4) * 4); ko[n] = ld_tok(blk + HB_KO + ((n * 16 + fr) * 16 + fq * 4) * 2); }
                    *(LAS bf16x8*)xo = Sb0; *(LAS bf16x8*)(xo + 16) = Sb1;
#pragma unroll
                    for (int n = 0; n < 4; ++n) ST[n] = __builtin_amdgcn_mfma_f32_16x16x32_bf16(ko[n], Vb, ST[n] * gg[n], 0, 0, 0);
                }
            } else if (wv >= 2 && wv < 4 && c > 0) {
                const int cp = c - 1;
                const LAS unsigned char* blk = ring + (cp % SCD) * CBR;
                const LAS unsigned char* xi = xb + (((cp & 1) * 2 + qw) * 64 + lane) * 48;
                const bf16x8 Sb0 = *(const LAS bf16x8*)xi, Sb1 = *(const LAS bf16x8*)(xi + 16);
                f32x4 YT, YTa;
                if (is_rw) {
                    const bf16x8 rt0 = *(const LAS bf16x8*)(blk + RB_RT + (fr * 64 + fq * 8) * 2), rt1 = *(const LAS bf16x8*)(blk + RB_RT + (fr * 64 + 32 + fq * 8) * 2);
                    const bf16x8 mkt = ld_tok(blk + RB_MK + (fr * 16 + fq * 4) * 2), mbt = ld_tok(blk + RB_MB + (fr * 16 + fq * 4) * 2);
                    const bf16x8 Vb = ld_tok(blk + RB_VT + ((vbase + fr) * 16 + fq * 4) * 2);
                    const bf16x8 Un = ld_tok(xi + 32);
                    YTa = __builtin_amdgcn_mfma_f32_16x16x32_bf16(rt0, Sb0, z4, 0, 0, 0);
                    YT = __builtin_amdgcn_mfma_f32_16x16x32_bf16(rt1, Sb1, z4, 0, 0, 0);
                    YTa = __builtin_amdgcn_mfma_f32_16x16x32_bf16(mkt, Vb, YTa, 0, 0, 0);
                    YT = __builtin_amdgcn_mfma_f32_16x16x32_bf16(mbt, Un, YT, 0, 0, 0);
                } else {
                    const bf16x8 qt0 = *(const LAS bf16x8*)(blk + HB_QT + (fr * 64 + fq * 8) * 2), qt1 = *(const LAS bf16x8*)(blk + HB_QT + (fr * 64 + 32 + fq * 8) * 2);
                    const bf16x8 mkt = ld_tok(blk + HB_MK + (fr * 16 + fq * 4) * 2);
                    const bf16x8 Vb = ld_tok(blk + HB_VT + ((vbase + fr) * 16 + fq * 4) * 2);
                    YTa = __builtin_amdgcn_mfma_f32_16x16x32_bf16(qt0, Sb0, z4, 0, 0, 0);
                    YT = __builtin_amdgcn_mfma_f32_16x16x32_bf16(qt1, Sb1, z4, 0, 0, 0);
                    YTa = __builtin_amdgcn_mfma_f32_16x16x32_bf16(mkt, Vb, YTa, 0, 0, 0);
                }
                YT = YT + YTa;
                { const int r0 = __builtin_amdgcn_readfirstlane(scan_row(b, d, cp * 16)); bf16_t* yb = yout + (size_t)r0 * 512;
                  f32x4 YP;
#pragma unroll
                  for (int j = 0; j < 4; ++j) YP[j] = dppmov<0xB1>(YT[j]);
                  if (!(fr & 1)) {
#pragma unroll
                      for (int j = 0; j < 4; ++j) *(unsigned*)(yb + yoff[j]) = pack2(YT[j], YP[j]); } }
            }
            if (stager) asm volatile("s_waitcnt vmcnt(24)" ::: "memory");
            asm volatile("s_waitcnt lgkmcnt(0)" ::: "memory"); __builtin_amdgcn_s_barrier(); asm volatile("" ::: "memory");
        }
        asm volatile("s_waitcnt vmcnt(0)" ::: "memory");
        __syncthreads();
#undef SC_DMA
    }
}

DI void p_readout(const Frame& F, const KArgs& a) {
    const bf16_t* U = (const bf16_t*)(a.ws + WS_U);
    const bf16_t* G = (const bf16_t*)(a.ws + WS_R1 + G_OFF); const bf16_t* VTOK = (const bf16_t*)(a.ws + WS_R1 + VTOK_OFF);
    const float* CBON = (const float*)(a.ws + WS_R1 + CBON_OFF);
    const bf16_t* YO = (const bf16_t*)(a.ws + WS_R2);
    bf16_t* MIX = (bf16_t*)(a.ws + WS_MIX);
    const int lane = F.lane, c0 = lane * 8, hh = lane >> 3;
    float lnw[8], lnb[8], nw[8];
    load8f(KIN(a, 23) + c0, lnw); load8f(KIN(a, 24) + c0, lnb); load8f(KIN(a, 26) + (c0 & 63), nw);
    for (int row = F.bid * 8 + F.wave; row < TT; row += F.G * 8) {
        const size_t o = (size_t)row * 512 + c0;
        float y0[8], y1[8], y[8], v[8], g[8], out[8];
        load8bf(YO + o, y0); load8bf(YO + (size_t)TT * 512 + o, y1);
        load8bf(VTOK + o, v); load8bf(G + o, g);
        const float cb = CBON[(size_t)row * 8 + hh] + CBON[((size_t)TT + row) * 8 + hh];
        float s = 0.f;
#pragma unroll
        for (int e = 0; e < 8; ++e) { y[e] = y0[e] + y1[e]; s += y[e]; }
        s = sum8(s);
        const float mu = s * (1.0f / 64.0f);
        float vs = 0.f;
#pragma unroll
        for (int e = 0; e < 8; ++e) { const float dlt = y[e] - mu; vs += dlt * dlt; }
        vs = sum8(vs);
        const float inv = rsqrtf(vs * (1.0f / 64.0f) + 64e-5f);
#pragma unroll
        for (int e = 0; e < 8; ++e) out[e] = ((y[e] - mu) * inv * lnw[e] + lnb[e] + cb * v[e]) * g[e];
        store8bf(MIX + (size_t)row * DM + c0, out);
        float og[8];
        load8bf(YO + (size_t)2 * TT * 512 + o, y0); load8bf(YO + (size_t)3 * TT * 512 + o, y1);
        load8bf(U + (size_t)row * ABPAD + ACOLS + 2048 + c0, og);
        float ms = 0.f;
#pragma unroll
        for (int e = 0; e < 8; ++e) { y[e] = y0[e] + y1[e]; ms += y[e] * y[e]; }
        ms = sum8(ms);
        const float inv2 = rsqrtf(ms * (1.0f / 64.0f) + 1e-6f);
#pragma unroll
        for (int e = 0; e < 8; ++e) out[e] = y[e] * inv2 * nw[e] * fsilu(og[e]);
        store8bf(MIX + (size_t)row * DM + 512 + c0, out);
    }
}
constexpr int RT_TOK = 16;
DI void p_route(const Frame& F, const KArgs& a, int layer, int nrows) {
    const float* mod = (const float*)(a.ws + WS_MOD) + (size_t)layer * 5 * 6144;
    const bf16_t* X = (const bf16_t*)(a.ws + WS_XRES);
    bf16_t* hA = (bf16_t*)(a.ws + WS_HA);
    const float* rw = KIN(a, 6) + (size_t)layer * 1024 * 32; const float* rb = KIN(a, 7) + layer * 32;
    int* cnt = (int*)(a.ws + WS_CTL + CW_CNT) + layer * 32;
    int* list = (int*)(a.ws + WS_LIST); float* sgate = (float*)(a.ws + WS_SGATE);
    constexpr int HP = 1026;
    LAS float* h2 = (LAS float*)F.lds;
    LAS float* part = h2 + 16 * HP;
    LAS float* lg = part + 8 * 512;
    LAS int* lcnt = (LAS int*)(lg + 16 * 32);
    LAS int* lbase = lcnt + 32;
    LAS float* selv = (LAS float*)(lbase + 32);
    const int tid = F.tid, lane = F.lane, wv = F.wave;
    const int fr = lane & 15, kq = lane >> 4;
    float bw[32][2];
#pragma unroll
    for (int s = 0; s < 32; ++s)
#pragma unroll
        for (int n = 0; n < 2; ++n) bw[s][n] = rw[(size_t)(wv * 128 + s * 4 + kq) * 32 + n * 16 + fr];
    const int nun = nrows / RT_TOK;
    u32x2 pre[2][4];
    if (F.bid < nun) {
#pragma unroll
        for (int k = 0; k < 2; ++k)
#pragma unroll
            for (int i = 0; i < 4; ++i) pre[k][i] = *(const u32x2*)(X + (size_t)(F.bid * RT_TOK + wv * 2 + k) * DM + i * 256 + lane * 4);
    }
    const int tk = tid >> 5, ex = tid & 31;
    int prank = 4, ptrk = 0, prow0 = -1, pend = 0; float pgt = 0.f;
    for (int u = F.bid; u < nun; u += F.G) {
        const int row0 = u * RT_TOK;
        if (tid < 32) lcnt[tid] = 0;
#pragma unroll
        for (int k = 0; k < 2; ++k) {
            const int ti = wv * 2 + k, row = row0 + ti;
            f32x4 v[4];
#pragma unroll
            for (int i = 0; i < 4; ++i) { const u32x2 q = pre[k][i]; v[i] = (f32x4){lo2f(q.x), hi2f(q.x), lo2f(q.y), hi2f(q.y)}; }
            const float* m = mod + (size_t)row_sel(row) * 6144;
            row_modulate(v, m + 3072, m + 4096, lane);
#pragma unroll
            for (int i = 0; i < 4; ++i) *(unsigned*)((unsigned char*)hA + (size_t)row * DM + i * 256 + lane * 4) = pack4_fp8(clamp8(v[i][0]), clamp8(v[i][1]), clamp8(v[i][2]), clamp8(v[i][3]));
#pragma unroll
            for (int i = 0; i < 4; ++i) { LAS float* d = h2 + ti * HP + i * 256 + lane * 4; *(LAS f32x2*)d = (f32x2){v[i][0], v[i][1]}; *(LAS f32x2*)(d + 2) = (f32x2){v[i][2], v[i][3]}; }
        }
        if (u + F.G < nun) {
#pragma unroll
            for (int k = 0; k < 2; ++k)
#pragma unroll
                for (int i = 0; i < 4; ++i) pre[k][i] = *(const u32x2*)(X + (size_t)((u + F.G) * RT_TOK + wv * 2 + k) * DM + i * 256 + lane * 4);
        }
        lds_barrier();
        {
            f32x4 acc0 = (f32x4){0.f, 0.f, 0.f, 0.f}, acc1 = acc0;
            const LAS float* hp = h2 + fr * HP + wv * 128 + kq;
#pragma unroll
            for (int s = 0; s < 32; ++s) { const float av = hp[s * 4];
                acc0 = __builtin_amdgcn_mfma_f32_16x16x4f32(av, bw[s][0], acc0, 0, 0, 0);
                acc1 = __builtin_amdgcn_mfma_f32_16x16x4f32(av, bw[s][1], acc1, 0, 0, 0); }
#pragma unroll
            for (int j = 0; j < 4; ++j) { part[wv * 512 + (kq * 4 + j) * 32 + fr] = acc0[j]; part[wv * 512 + (kq * 4 + j) * 32 + 16 + fr] = acc1[j]; }
        }
        lds_barrier();
        float myl;
        {
            float s = rb[tid & 31];
#pragma unroll
            for (int w = 0; w < 8; ++w) s += part[w * 512 + tid];
            lg[tid] = s; myl = s;
        }
        lds_barrier();
        int rank = 0;
#pragma unroll 2
        for (int e4 = 0; e4 < 8; ++e4) { const f32x4 q = *(const LAS f32x4*)(lg + tk * 32 + e4 * 4);
#pragma unroll
            for (int j = 0; j < 4; ++j) { const int e2 = e4 * 4 + j; rank += (q[j] > myl || (q[j] == myl && e2 < ex)) ? 1 : 0; } }
        const bool sel = rank < 4;
        int trk = 0;
        if (sel) { selv[tk * 4 + rank] = myl; trk = atomicAdd((int*)&lcnt[ex], 1); }
        if (tid < 32 && prow0 >= 0) lbase[tid] = pend;
        lds_barrier();
        float gt = 0.f;
        if (sel) { const f32x4 sv = *(const LAS f32x4*)(selv + tk * 4);
            const float den = 1.0f + __expf(sv[1] - sv[0]) + __expf(sv[2] - sv[0]) + __expf(sv[3] - sv[0]);
            gt = __expf(myl - sv[0]) / den; }
        if (tid < 32) { const int n = lcnt[tid]; pend = n > 0 ? atomicAdd(&cnt[tid], n) : 0; }
        if (prow0 >= 0 && prank < 4) { const int pos = lbase[ex] + ptrk; list[(size_t)ex * TT + pos] = (prow0 + tk) * 4 + prank; sgate[(size_t)ex * TT + pos] = pgt; }
        prank = rank; ptrk = trk; pgt = gt; prow0 = row0;
        lds_barrier();
    }
    if (prow0 >= 0) {
        if (tid < 32) lbase[tid] = pend;
        lds_barrier();
        if (prank < 4) { const int pos = lbase[ex] + ptrk; list[(size_t)ex * TT + pos] = (prow0 + tk) * 4 + prank; sgate[(size_t)ex * TT + pos] = pgt; }
    }
    lds_barrier();
}
DI void moe_tables(const Frame& F, const KArgs& a, int layer, LAS int* tstart, LAS int* lc) {
    const int* cnt = (const int*)(a.ws + WS_CTL + CW_CNT) + layer * 32;
    if (F.tid == 0) { int acc = 0;
        for (int e = 0; e < 32; ++e) { const int n = cnt[e]; lc[e] = n; tstart[e] = acc; acc += (n + 255) >> 8; }
        tstart[32] = acc; }
    __syncthreads();
    LAS int* tile_e = tstart + 224;
    for (int mt = F.tid; mt < tstart[32]; mt += NTHR) { int e = 0;
        for (int k = 1; k < 32; ++k) e = (tstart[k] <= mt) ? k : e;
        tile_e[mt] = e; }
    __syncthreads();
}
DI void comb_load(const bf16_t* X, const unsigned char* Y, int row, int lane, f32x4 (&v)[4], unsigned (&y)[4][4]) {
    row_load16_bf(X + (size_t)row * DM, lane, v);
#pragma unroll
    for (int k = 0; k < 4; ++k)
#pragma unroll
        for (int i = 0; i < 4; ++i) y[k][i] = *(const unsigned*)(Y + (size_t)(row * 4 + k) * DM + i * 256 + lane * 4);
}
DI void comb_finish(const KArgs& a, const float* mod, bf16_t* X, bf16_t* hA, int layer, int row, int lane, f32x4 (&v)[4], const unsigned (&y)[4][4]) {
    const float* m = mod + (size_t)row_sel(row) * 6144;
#pragma unroll
    for (int i = 0; i < 4; ++i) { f32x4 acc = (f32x4){0.f, 0.f, 0.f, 0.f};
#pragma unroll
        for (int k = 0; k < 4; ++k) { const f32x2 lo = __builtin_amdgcn_cvt_pk_f32_fp8((int)y[k][i], false), hi = __builtin_amdgcn_cvt_pk_f32_fp8((int)y[k][i], true);
            acc[0] += lo[0]; acc[1] += lo[1]; acc[2] += hi[0]; acc[3] += hi[1]; }
        const f32x4 g4 = *(const f32x4*)(m + 5120 + i * 256 + lane * 4); v[i] = v[i] + g4 * acc * (1.0f / Q8_Y); }
    if (layer == 0) {
        row_store_bf16(X + (size_t)row * DM, lane, v);
        const float* m1 = mod + (size_t)5 * 6144 + (size_t)row_sel(row) * 6144;
        row_modulate(v, m1, m1 + 1024, lane);
        row_store_bf16(hA + (size_t)row * DM, lane, v);
    } else {
#pragma unroll
        for (int i = 0; i < 4; ++i) *(f32x4*)(a.out + (size_t)row * DM + i * 256 + lane * 4) = v[i];
    }
}
DI void p_combine(const Frame& F, const KArgs& a, int layer, int nrows) {
    const float* mod = (const float*)(a.ws + WS_MOD) + (size_t)layer * 5 * 6144;
    bf16_t* X = (bf16_t*)(a.ws + WS_XRES);
    const unsigned char* Y = a.ws + WS_R2;
    bf16_t* hA = (bf16_t*)(a.ws + WS_HA);
    const int lane = F.lane, stride = F.G * 8;
    int row = F.bid * 8 + F.wave;
    f32x4 vA[4], vB[4]; unsigned yA[4][4], yB[4][4];
    if (row < nrows) comb_load(X, Y, row, lane, vA, yA);
    while (row < nrows) {
        int r2 = row + stride;
        if (r2 < nrows) comb_load(X, Y, r2, lane, vB, yB);
        comb_finish(a, mod, X, hA, layer, row, lane, vA, yA);
        row = r2; if (row >= nrows) break;
        r2 = row + stride;
        if (r2 < nrows) comb_load(X, Y, r2, lane, vA, yA);
        comb_finish(a, mod, X, hA, layer, row, lane, vB, yB);
        row = r2;
    }
}
DI void p_prep1(const Frame& F, const KArgs& a) {
    const bf16_t* U = (const bf16_t*)(a.ws + WS_U);
    unsigned char* R1 = a.ws + WS_R1;
    bf16_t* QN = (bf16_t*)(R1 + L1_QN); bf16_t* KN = (bf16_t*)(R1 + L1_KN);
    const f32x2* rope = (const f32x2*)(a.ws + WS_ROPE);
    const int lane = F.lane, tid = F.tid;
    {
        const int d0 = (lane & 7) * 8;
        float qn[8], kn[8]; load8f(KIN(a, 29) + d0, qn); load8f(KIN(a, 30) + d0, kn);
        const int l8 = lane & 7, ax = l8 >> 2, ph = (l8 >> 1) & 1, i0 = (l8 & 1) * 8;
        for (int row = F.bid * 8 + F.wave; row < TT; row += F.G * 8) {
            const bool lat = row < TL;
            const int t = row & (SEQ - 1), pos = ax ? (t & 63) : (t >> 6);
#pragma unroll
            for (int which = 0; which < 2; ++which) {
                if (which == 0 && !lat) continue;
                float x[8]; load8bf(U + (size_t)row * CDCOLS + which * 512 + lane * 8, x);
                float ss = 0.f;
#pragma unroll
                for (int e = 0; e < 8; ++e) ss += x[e] * x[e];
                ss = sum8(ss);
                const float inv = rsqrtf(ss * (1.0f / 64.0f) + 1e-6f);
#pragma unroll
                for (int e = 0; e < 8; ++e) x[e] = x[e] * inv * (which ? kn[e] : qn[e]);
                float o[8];
#pragma unroll
                for (int e = 0; e < 8; ++e) {
                    const float xp = dppmov<0x4E>(x[e]);
                    const f32x2 cs = rope[pos * 16 + i0 + e];
                    const float rot = ph ? (xp * cs[1] + x[e] * cs[0]) : (x[e] * cs[0] - xp * cs[1]);
                    o[e] = lat ? rot : x[e];
                }
                if (which == 0) {
#pragma unroll
                    for (int e = 0; e < 8; ++e) o[e] *= 0.125f;
                    store8bf(QN + (size_t)row * 512 + lane * 8, o);
                } else store8bf(KN + (size_t)row * 512 + lane * 8, o);
            }
        }
    }
    {
        LAS unsigned char* Tb = F.lds;
        bf16_t* VT = (bf16_t*)(R1 + L1_VT); bf16_t* VCT = (bf16_t*)(R1 + L1_VCT); bf16_t* HVT = (bf16_t*)(R1 + L1_HVT);
        const float* hs = KIN(a, 32);
        int par = 0;
        for (int u = F.bid; u < (TT / 64) * 8; u += F.G) {
            const int tile = u >> 3, ch = u & 7, row0 = tile * 64;
            const bool lat = row0 < TL;
            if (!lat && ch >= 2) continue;
            const int seq_start = lat ? (row0 / SEQ) * SEQ : TL + ((row0 - TL) / CL) * CL;
            const int seq_end = lat ? seq_start + SEQ : seq_start + CL;
            const int col8 = tid & 31, tr = tid >> 5;
            const int scol = 1024 + ch * 256 + col8 * 8;
            const int r0 = row0 + tr * 4;
            LAS unsigned char* img = Tb + par * 32768; par ^= 1;
            float y[4][8];
            if (ch >= 2) {
                float w0[8], w1[8], w2[8];
                load8f(hs + (scol - 1536), w0); load8f(hs + 1536 + (scol - 1536), w1); load8f(hs + 3072 + (scol - 1536), w2);
                float x[6][8];
#pragma unroll
                for (int r = 0; r < 6; ++r) { const int row = r0 - 1 + r;
                    if (row >= seq_start && row < seq_end) load8bf(U + (size_t)row * CDCOLS + scol, x[r]); else {
#pragma unroll
                        for (int e = 0; e < 8; ++e) x[r][e] = 0.f; } }
#pragma unroll
                for (int t = 0; t < 4; ++t)
#pragma unroll
                    for (int e = 0; e < 8; ++e) y[t][e] = x[t][e] * w0[e] + x[t + 1][e] * w1[e] + x[t + 2][e] * w2[e];
            } else {
#pragma unroll
                for (int t = 0; t < 4; ++t) load8bf(U + (size_t)(r0 + t) * CDCOLS + scol, y[t]);
            }
#pragma unroll
            for (int e = 0; e < 8; ++e) { u32x2 w; w.x = pack2(y[0][e], y[1][e]); w.y = pack2(y[2][e], y[3][e]);
                *(LAS u32x2*)(img + (col8 * 8 + e) * 128 + ((tr ^ (col8 & 15)) * 8)) = w; }
            __syncthreads();
#pragma unroll
            for (int q = 0; q < 4; ++q) {
                const int idx = tid + q * NTHR, cl = idx >> 3, pc = idx & 7, sw = (cl >> 3) & 15;
                u32x4 w = *(const LAS u32x4*)(img + cl * 128 + ((pc ^ (sw >> 1)) * 16));
                if (sw & 1) { const unsigned t0 = w.x, t1 = w.y; w.x = w.z; w.y = w.w; w.z = t0; w.w = t1; }
                const int cg = ch * 256 + cl;
                bf16_t* dst;
                if (cg < 512) {
                    if (lat) { const int b = row0 / SEQ, t0 = row0 - b * SEQ; dst = VT + ((size_t)b * 512 + cg) * SEQ + t0 + pc * 8; }
                    else { const int b = (row0 - TL) / CL, t0 = (row0 - TL) - b * CL; dst = VCT + ((size_t)b * 512 + cg) * CL + t0 + pc * 8; }
                } else { const int hc = cg - 512, st = hc >> 9, c = hc & 511, b = row0 / SEQ, t0 = row0 - b * SEQ;
                    dst = HVT + (((size_t)st * 4 + b) * 512 + c) * SEQ + t0 + pc * 8; }
                *(u32x4*)dst = w;
            }
        }
        __syncthreads();
    }
}
DI void p_hy_back(const Frame& F, const KArgs& a) {
    const bf16_t* HYT = (const bf16_t*)(a.ws + WS_R1 + L1_HYT);
    bf16_t* MIX = (bf16_t*)(a.ws + WS_MIX);
    const int tid = F.tid, pc = tid & 7, c4 = tid >> 3;
    int par = 0;
    for (int u = F.bid; u < (TL / 64) * 2; u += F.G) {
        const int tile = u >> 1, ch = u & 1, row0 = tile * 64, b = row0 / SEQ, t0 = row0 - b * SEQ;
        LAS unsigned char* img = F.lds + par * 32768; par ^= 1;
        u32x4 x[4];
#pragma unroll
        for (int i = 0; i < 4; ++i) x[i] = *(const u32x4*)(HYT + ((size_t)b * 512 + ch * 256 + c4 * 4 + i) * SEQ + t0 + pc * 8);
#pragma unroll
        for (int e = 0; e < 8; ++e) {
            const int sh = (e & 1) * 16; unsigned v[4];
#pragma unroll
            for (int i = 0; i < 4; ++i) v[i] = (x[i][e >> 1] >> sh) & 0xFFFFu;
            u32x2 w; w.x = v[0] | (v[1] << 16); w.y = v[2] | (v[3] << 16);
            *(LAS u32x2*)(img + (pc * 8 + e) * 512 + ((c4 ^ (pc << 3)) * 8)) = w;
        }
        __syncthreads();
#pragma unroll
        for (int q = 0; q < 4; ++q) {
            const int idx = tid + q * NTHR, tt = idx >> 5, c8 = idx & 31;
            const u32x4 w = *(const LAS u32x4*)(img + tt * 512 + ((c8 ^ ((tt >> 3) << 2)) * 16));
            *(u32x4*)(MIX + (size_t)(row0 + tt) * DM + 512 + ch * 256 + c8 * 8) = w;
        }
    }
    __syncthreads();
}
constexpr int NA_UNITS = NB * 8 * 64, KPB = 144, NA_KROWS = 9 * 64 + 256, VPB = NA_KROWS * 2 + 16;
DI void na_unit(const Frame& F, const KArgs& a, int u) {
    unsigned char* R1 = a.ws + WS_R1;
    const bf16_t* QN = (const bf16_t*)(R1 + L1_QN); const bf16_t* KN = (const bf16_t*)(R1 + L1_KN);
    const bf16_t* VT = (const bf16_t*)(R1 + L1_VT); const bf16_t* VCT = (const bf16_t*)(R1 + L1_VCT);
    bf16_t* MIX = (bf16_t*)(a.ws + WS_MIX);
    const int tid = F.tid, lane = F.lane, wv = F.wave, fr = lane & 15, fq = lane >> 4;
    const int b = u >> 9, h = (u >> 6) & 7, rb = u & 63;
    const int rsA = min(max(2 * rb - 4, 0), 120);
    LAS unsigned char* Ksm = F.lds;
    LAS float* Bsm = (LAS float*)(F.lds + NA_KROWS * KPB);
#pragma unroll
    for (int i = 0; i < 13; ++i) {
        const int p = tid + i * NTHR, kx = p >> 3, pc = p & 7;
        const size_t tok = kx < 576 ? (size_t)b * SEQ + min(rsA + (kx >> 6), 127) * 64 + (kx & 63) : (size_t)TL + b * CL + (kx - 576);
        *(LAS u32x4*)(Ksm + kx * KPB + pc * 16) = *(const u32x4*)(KN + tok * 512 + h * 64 + pc * 8);
    }
    if (tid < 465) Bsm[tid] = KIN(a, 31)[h * 465 + tid];
    const int r = 2 * rb + (wv >> 2), c0 = 16 * (wv & 3);
    const int rs = min(max(r - 4, 0), 120), kc0 = min(max(c0 - 8, 0), 32);
    const int cq = c0 + fr, cs = min(max(cq - 8, 0), 48);
    bf16x8 qf[2];
    { const bf16_t* qp = QN + ((size_t)b * SEQ + r * 64 + cq) * 512 + h * 64 + fq * 8; qf[0] = *(const bf16x8*)qp; qf[1] = *(const bf16x8*)(qp + 32); }
    __syncthreads();
    float lsum = 0.f;
    const int prow = (fr >> 2) * 8 + (fr & 3);
    u32x4 PF[16];
#pragma unroll
    for (int g = 0; g < 4; ++g) {
#pragma unroll
        for (int s4 = 0; s4 < 4; ++s4) {
            const int kx0 = (g < 2) ? (rs - rsA + g * 4 + s4) * 64 + kc0 : 576 + (g - 2) * 128 + s4 * 32;
            f32x4 P2[2];
#pragma unroll
            for (int hh = 0; hh < 2; ++hh) {
                const LAS unsigned char* kp = Ksm + (kx0 + prow + hh * 4) * KPB + fq * 16;
                const bf16x8 k0 = *(const LAS bf16x8*)kp, k1 = *(const LAS bf16x8*)(kp + 64);
                f32x4 acc = (f32x4){0.f, 0.f, 0.f, 0.f};
                acc = __builtin_amdgcn_mfma_f32_16x16x32_bf16(k0, qf[0], acc, 0, 0, 0);
                acc = __builtin_amdgcn_mfma_f32_16x16x32_bf16(k1, qf[1], acc, 0, 0, 0);
#pragma unroll
                for (int j = 0; j < 4; ++j) {
                    float sv = acc[j];
                    if (g < 2) { const int kr = rs + g * 4 + s4, kc = kc0 + fq * 8 + hh * 4 + j; const bool ok = kc >= cs && kc < cs + 16;
                        sv = ok ? sv + Bsm[(kr - r + 7) * 31 + (kc - cq + 15)] : -1.0e30f; }
                    const float pv = __expf(fminf(sv, 80.0f)); acc[j] = pv; lsum += pv;
                }
                P2[hh] = acc;
            }
            u32x4 pw; pw.x = pack2(P2[0][0], P2[0][1]); pw.y = pack2(P2[0][2], P2[0][3]); pw.z = pack2(P2[1][0], P2[1][1]); pw.w = pack2(P2[1][2], P2[1][3]);
            PF[g * 4 + s4] = pw;
        }
    }
    __syncthreads();
#pragma unroll
    for (int i = 0; i < 13; ++i) {
        const int p = tid + i * NTHR;
        int dim, kx; const bf16_t* src;
        if (p < 4608) { dim = p / 72; const int rem = p - dim * 72, rw_ = rem >> 3, pc = rem & 7; kx = rw_ * 64 + pc * 8;
            src = VT + ((size_t)b * 512 + h * 64 + dim) * SEQ + min(rsA + rw_, 127) * 64 + pc * 8; }
        else { const int q = p - 4608; dim = q >> 5; const int pc = q & 31; kx = 576 + pc * 8; src = VCT + ((size_t)b * 512 + h * 64 + dim) * CL + pc * 8; }
        *(LAS u32x4*)(Ksm + dim * VPB + kx * 2) = *(const u32x4*)src;
    }
    __syncthreads();
    f32x4 O[4];
#pragma unroll
    for (int n = 0; n < 4; ++n) O[n] = (f32x4){0.f, 0.f, 0.f, 0.f};
#pragma unroll
    for (int ks = 0; ks < 16; ++ks) {
        const int g = ks >> 2, s4 = ks & 3;
        const int kx0 = (g < 2) ? (rs - rsA + g * 4 + s4) * 64 + kc0 : 576 + (g - 2) * 128 + s4 * 32;
        const bf16x8 pf = __builtin_bit_cast(bf16x8, PF[ks]);
#pragma unroll
        for (int n = 0; n < 4; ++n) { const bf16x8 vf = *(const LAS bf16x8*)(Ksm + ((n >> 1) * 32 + 8 * (fr >> 2) + 4 * (n & 1) + (fr & 3)) * VPB + (kx0 + fq * 8) * 2);
            O[n] = __builtin_amdgcn_mfma_f32_16x16x32_bf16(vf, pf, O[n], 0, 0, 0); }
    }
    lsum += __builtin_bit_cast(float, __builtin_amdgcn_ds_bpermute((lane ^ 16) << 2, __builtin_bit_cast(int, lsum)));
    lsum += __builtin_bit_cast(float, __builtin_amdgcn_ds_bpermute((lane ^ 32) << 2, __builtin_bit_cast(int, lsum)));
    const float rl = 1.0f / lsum;
    bf16_t* orow = MIX + ((size_t)b * SEQ + r * 64 + c0 + fr) * DM + h * 64 + 8 * fq;
#pragma unroll
    for (int np = 0; np < 2; ++np) { u32x4 w; w.x = pack2(O[2 * np][0] * rl, O[2 * np][1] * rl); w.y = pack2(O[2 * np][2] * rl, O[2 * np][3] * rl); w.z = pack2(O[2 * np + 1][0] * rl, O[2 * np + 1][1] * rl); w.w = pack2(O[2 * np + 1][2] * rl, O[2 * np + 1][3] * rl);
        *(u32x4*)(orow + np * 32) = w; }
}

constexpr int FN = 16384;
DI f32x2 cmul(f32x2 a, f32x2 b) {
    f32x2 t, r;
    asm("v_pk_mul_f32 %0, %1, %2 op_sel:[0,0] op_sel_hi:[0,1]" : "=v"(t) : "v"(a), "v"(b));
    asm("v_pk_fma_f32 %0, %1, %2, %3 op_sel:[1,1,0] op_sel_hi:[1,0,1] neg_lo:[0,1,0]" : "=v"(r) : "v"(a), "v"(b), "v"(t));
    return r;
}
DI f32x2 cmulc(f32x2 a, f32x2 b) {
    f32x2 t, r;
    asm("v_pk_mul_f32 %0, %1, %2 op_sel:[0,0] op_sel_hi:[1,0]" : "=v"(t) : "v"(a), "v"(b));
    asm("v_pk_fma_f32 %0, %1, %2, %3 op_sel:[1,1,0] op_sel_hi:[0,1,1] neg_hi:[0,1,0]" : "=v"(r) : "v"(a), "v"(b), "v"(t));
    return r;
}
DI f32x2 add_mi(f32x2 a, f32x2 d) { f32x2 r; asm("v_pk_add_f32 %0, %1, %2 op_sel:[0,1] op_sel_hi:[1,0] neg_hi:[0,1]" : "=v"(r) : "v"(a), "v"(d)); return r; }
DI f32x2 add_pi(f32x2 a, f32x2 d) { f32x2 r; asm("v_pk_add_f32 %0, %1, %2 op_sel:[0,1] op_sel_hi:[1,0] neg_lo:[0,1]" : "=v"(r) : "v"(a), "v"(d)); return r; }
DI f32x2 tw_get(const LAS f32x2* Thi, const LAS f32x2* Tlo, int e) { return cmul(Thi[e >> 7], Tlo[e & 127]); }
DI int PX(int i) { return i + ((i >> 4) << 1); }
DI void r4_fwd(f32x2& x0, f32x2& x1, f32x2& x2, f32x2& x3) {
    const f32x2 a0 = x0 + x2, a1 = x0 - x2, a2 = x1 + x3, d = x1 - x3;
    x0 = a0 + a2; x1 = add_mi(a1, d); x2 = a0 - a2; x3 = add_pi(a1, d);
}
DI void r4_inv(f32x2& z0, f32x2& z1, f32x2& z2, f32x2& z3) {
    const f32x2 a0 = z0 + z2, a1 = z0 - z2, a2 = z1 + z3, d = z1 - z3;
    z0 = a0 + a2; z1 = add_pi(a1, d); z2 = a0 - a2; z3 = add_mi(a1, d);
}
template <int LS>
DI void sp_fwd_compute(const LAS f32x2* Thi, const LAS f32x2* Tlo, int offp, f32x2 (&x)[16]) {
    constexpr int sp = 1 << (LS - 2);
#pragma unroll
    for (int b = 0; b < 4; ++b) {
        if (b == 2) __builtin_amdgcn_sched_barrier(0);
        r4_fwd(x[b], x[4 + b], x[8 + b], x[12 + b]);
        const int e1 = (b * sp + offp) << (12 - LS);
        if (!(LS == 2 && b == 0)) { const f32x2 w1 = tw_get(Thi, Tlo, e1), w2 = cmul(w1, w1), w3 = cmul(w2, w1);
            x[4 + b] = cmul(x[4 + b], w1); x[8 + b] = cmul(x[8 + b], w2); x[12 + b] = cmul(x[12 + b], w3); }
    }
    f32x2 w1 = (f32x2){1.f, 0.f}, w2 = w1, w3 = w1;
    if (LS > 2) { w1 = tw_get(Thi, Tlo, offp << (14 - LS)); w2 = cmul(w1, w1); w3 = cmul(w2, w1); }
#pragma unroll
    for (int m = 0; m < 4; ++m) {
        r4_fwd(x[4 * m], x[4 * m + 1], x[4 * m + 2], x[4 * m + 3]);
        if (LS > 2) { x[4 * m + 1] = cmul(x[4 * m + 1], w1); x[4 * m + 2] = cmul(x[4 * m + 2], w2); x[4 * m + 3] = cmul(x[4 * m + 3], w3); }
    }
}
template <int LS>
DI void sp_inv_compute(const LAS f32x2* Thi, const LAS f32x2* Tlo, int offp, f32x2 (&x)[16]) {
    constexpr int sp = 1 << (LS - 2);
    f32x2 w1 = (f32x2){1.f, 0.f}, w2 = w1, w3 = w1;
    if (LS > 2) { w1 = tw_get(Thi, Tlo, offp << (14 - LS)); w2 = cmul(w1, w1); w3 = cmul(w2, w1); }
#pragma unroll
    for (int m = 0; m < 4; ++m) {
        if (LS > 2) { x[4 * m + 1] = cmulc(x[4 * m + 1], w1); x[4 * m + 2] = cmulc(x[4 * m + 2], w2); x[4 * m + 3] = cmulc(x[4 * m + 3], w3); }
        r4_inv(x[4 * m], x[4 * m + 1], x[4 * m + 2], x[4 * m + 3]);
    }
#pragma unroll
    for (int b = 0; b < 4; ++b) {
        if (b == 2) __builtin_amdgcn_sched_barrier(0);
        const int e1 = (b * sp + offp) << (12 - LS);
        if (!(LS == 2 && b == 0)) { const f32x2 v1 = tw_get(Thi, Tlo, e1), v2 = cmul(v1, v1), v3 = cmul(v2, v1);
            x[4 + b] = cmulc(x[4 + b], v1); x[8 + b] = cmulc(x[8 + b], v2); x[12 + b] = cmulc(x[12 + b], v3); }
        r4_inv(x[b], x[4 + b], x[8 + b], x[12 + b]);
    }
}
template <int LS> DI int sp_base(int g, int& offp) { constexpr int sp = 1 << (LS - 2); offp = g & (sp - 1); return ((g >> (LS - 2)) << (LS + 2)) + offp; }
template <int LS> DI void sp_load(const LAS f32x2* X, int base, f32x2 (&x)[16]) {
    constexpr int s = 1 << LS, sp = 1 << (LS - 2);
#pragma unroll
    for (int a = 0; a < 4; ++a)
#pragma unroll
        for (int b = 0; b < 4; ++b) x[a * 4 + b] = X[PX(base + a * s + b * sp)];
}
template <int LS> DI void sp_store(LAS f32x2* X, int base, const f32x2 (&x)[16]) {
    constexpr int s = 1 << LS, sp = 1 << (LS - 2);
#pragma unroll
    for (int a = 0; a < 4; ++a)
#pragma unroll
        for (int b = 0; b < 4; ++b) X[PX(base + a * s + b * sp)] = x[a * 4 + b];
}

DI void r4pass_fwd(LAS f32x2* X, const LAS f32x2* Thi, const LAS f32x2* Tlo, int tid) {
#pragma unroll 4
    for (int bq = 0; bq < 8; ++bq) { const int k = tid + 512 * bq, off = k & 15, base = ((k >> 4) << 6) + off;
        f32x2 x0 = X[PX(base)], x1 = X[PX(base + 16)], x2 = X[PX(base + 32)], x3 = X[PX(base + 48)];
        r4_fwd(x0, x1, x2, x3);
        const f32x2 w1 = tw_get(Thi, Tlo, off << 8), w2 = cmul(w1, w1), w3 = cmul(w2, w1);
        X[PX(base)] = x0; X[PX(base + 16)] = cmul(x1, w1); X[PX(base + 32)] = cmul(x2, w2); X[PX(base + 48)] = cmul(x3, w3); }
    __syncthreads();
}
DI void r4pass_inv(LAS f32x2* X, const LAS f32x2* Thi, const LAS f32x2* Tlo, int tid) {
#pragma unroll 4
    for (int bq = 0; bq < 8; ++bq) { const int k = tid + 512 * bq, off = k & 15, base = ((k >> 4) << 6) + off;
        f32x2 x0 = X[PX(base)], x1 = X[PX(base + 16)], x2 = X[PX(base + 32)], x3 = X[PX(base + 48)];
        const f32x2 w1 = tw_get(Thi, Tlo, off << 8), w2 = cmul(w1, w1), w3 = cmul(w2, w1);
        x1 = cmulc(x1, w1); x2 = cmulc(x2, w2); x3 = cmulc(x3, w3);
        r4_inv(x0, x1, x2, x3);
        X[PX(base)] = x0; X[PX(base + 16)] = x1; X[PX(base + 32)] = x2; X[PX(base + 48)] = x3; }
    __syncthreads();
}
template <int LS, int MODE>
DI void sp_fwd_pass(LAS f32x2* X, const LAS f32x2* Thi, const LAS f32x2* Tlo, int tid, f32x2 (&Kr)[2][16]) {
#pragma unroll
    for (int i = 0; i < 2; ++i) { __builtin_amdgcn_sched_barrier(0); int offp; const int base = sp_base<LS>(tid + 512 * i, offp); f32x2 x[16];
        sp_load<LS>(X, base, x); sp_fwd_compute<LS>(Thi, Tlo, offp, x);
        if (MODE == 1) {
#pragma unroll
            for (int e = 0; e < 16; ++e) Kr[i][e] = x[e]; }
        else { if (MODE == 2) {
#pragma unroll
                for (int e = 0; e < 16; ++e) x[e] = cmul(x[e], Kr[i][e]); }
            sp_store<LS>(X, base, x); } }
    __syncthreads();
}
template <int LS>
DI void sp_inv_pass(LAS f32x2* X, const LAS f32x2* Thi, const LAS f32x2* Tlo, int tid) {
#pragma unroll
    for (int i = 0; i < 2; ++i) { __builtin_amdgcn_sched_barrier(0); int offp; const int base = sp_base<LS>(tid + 512 * i, offp); f32x2 x[16];
        sp_load<LS>(X, base, x); sp_inv_compute<LS>(Thi, Tlo, offp, x); sp_store<LS>(X, base, x); }
    __syncthreads();
}
template <int MODE>
DI void fft_forward(LAS f32x2* X, const LAS f32x2* Thi, const LAS f32x2* Tlo, int tid, f32x2 (&Kr)[2][16]) {
    sp_fwd_pass<12, 0>(X, Thi, Tlo, tid, Kr); sp_fwd_pass<8, 0>(X, Thi, Tlo, tid, Kr); r4pass_fwd(X, Thi, Tlo, tid); sp_fwd_pass<2, MODE>(X, Thi, Tlo, tid, Kr);
}
DI void fft_inverse(LAS f32x2* X, const LAS f32x2* Thi, const LAS f32x2* Tlo, int tid) {
    sp_inv_pass<2>(X, Thi, Tlo, tid); r4pass_inv(X, Thi, Tlo, tid); sp_inv_pass<8>(X, Thi, Tlo, tid); sp_inv_pass<12>(X, Thi, Tlo, tid);
}
DI void hy_load_filter(const Frame& F, const KArgs& a, LAS f32x2* X, int o, int c) {
    const float* HYF = (const float*)(a.ws + WS_HYF);
    const float* hf = HYF + ((size_t)(o * 2 + 0) * 512 + c) * SEQ; const float* hb = HYF + ((size_t)(o * 2 + 1) * 512 + c) * SEQ;
    const float g0 = hf[0] + hb[0] + KIN(a, 40)[o * 512 + c];
    for (int n = F.tid; n < FN; n += NTHR) {
        float g;
        if (n == 0) g = g0; else if (n < SEQ) g = hf[n]; else if (n == SEQ) g = 0.f; else g = hb[FN - n];
        X[PX(n)] = (f32x2){g, 0.f};
    }
    __syncthreads();
}
DI void hyena_unit(const Frame& F, const KArgs& a, int c) {
    unsigned char* R1 = a.ws + WS_R1;
    const bf16_t* HVT = (const bf16_t*)(R1 + L1_HVT); bf16_t* HYT = (bf16_t*)(R1 + L1_HYT);
    float* ZT = (float*)(R1 + L1_ZT);
    LAS f32x2* X = (LAS f32x2*)F.lds;
    LAS f32x2* Thi = (LAS f32x2*)(F.lds + LDS_MISC + 512); LAS f32x2* Tlo = Thi + 128;
    const int tid = F.tid;
    const float rn = 1.0f / (float)FN;
    f32x2 Kr[2][16];
    hy_load_filter(F, a, X, 0, c);
    fft_forward<1>(X, Thi, Tlo, tid, Kr);
#pragma unroll 1
    for (int p = 0; p < 2; ++p) {
        const size_t r0 = ((size_t)(2 * p) * 512 + c) * SEQ, r1 = ((size_t)(2 * p + 1) * 512 + c) * SEQ;
        const bf16_t* v0 = HVT + r0; const bf16_t* v1 = HVT + r1;
        const bf16_t* x10 = HVT + (size_t)4 * 512 * SEQ + r0; const bf16_t* x11 = HVT + (size_t)4 * 512 * SEQ + r1;
#pragma unroll
        for (int i = 0; i < 2; ++i) { const int t = (tid + NTHR * i) * 8; float xa[8], xb[8]; load8bf(v0 + t, xa); load8bf(v1 + t, xb);
#pragma unroll
            for (int e = 0; e < 8; ++e) { X[PX(t + e)] = (f32x2){xa[e], xb[e]}; X[PX(SEQ + t + e)] = (f32x2){0.f, 0.f}; } }
        __syncthreads();
        fft_forward<2>(X, Thi, Tlo, tid, Kr);
        fft_inverse(X, Thi, Tlo, tid);
#pragma unroll
        for (int i = 0; i < 2; ++i) { const int t = (tid + NTHR * i) * 8; float xa[8], xb[8]; load8bf(x10 + t, xa); load8bf(x11 + t, xb);
#pragma unroll
            for (int e4 = 0; e4 < 2; ++e4) { f32x4 za, zb;
#pragma unroll
                for (int e = 0; e < 4; ++e) { const f32x2 y = X[PX(t + e4 * 4 + e)]; za[e] = xa[e4 * 4 + e] * y[0] * rn; zb[e] = xb[e4 * 4 + e] * y[1] * rn; }
                *(f32x4*)(ZT + r0 + t + e4 * 4) = za; *(f32x4*)(ZT + r1 + t + e4 * 4) = zb; } }
        __syncthreads();
    }
    hy_load_filter(F, a, X, 1, c);
    fft_forward<1>(X, Thi, Tlo, tid, Kr);
#pragma unroll 1
    for (int p = 0; p < 2; ++p) {
        const size_t r0 = ((size_t)(2 * p) * 512 + c) * SEQ, r1 = ((size_t)(2 * p + 1) * 512 + c) * SEQ;
        const bf16_t* x20 = HVT + (size_t)8 * 512 * SEQ + r0; const bf16_t* x21 = HVT + (size_t)8 * 512 * SEQ + r1;
#pragma unroll
        for (int i = 0; i < 2; ++i) { const int t = (tid + NTHR * i) * 8;
#pragma unroll
            for (int e4 = 0; e4 < 2; ++e4) { const f32x4 za = *(const f32x4*)(ZT + r0 + t + e4 * 4), zb = *(const f32x4*)(ZT + r1 + t + e4 * 4);
#pragma unroll
                for (int e = 0; e < 4; ++e) { X[PX(t + e4 * 4 + e)] = (f32x2){za[e], zb[e]}; X[PX(SEQ + t + e4 * 4 + e)] = (f32x2){0.f, 0.f}; } } }
        __syncthreads();
        fft_forward<2>(X, Thi, Tlo, tid, Kr);
        fft_inverse(X, Thi, Tlo, tid);
#pragma unroll
        for (int i = 0; i < 2; ++i) { const int t = (tid + NTHR * i) * 8; float xa[8], xb[8], oa[8], ob[8]; load8bf(x20 + t, xa); load8bf(x21 + t, xb);
#pragma unroll
            for (int e = 0; e < 8; ++e) { const f32x2 y = X[PX(t + e)]; oa[e] = xa[e] * y[0] * rn; ob[e] = xb[e] * y[1] * rn; }
            store8bf(HYT + r0 + t, oa); store8bf(HYT + r1 + t, ob); }
        __syncthreads();
    }
}
DI void p_na_hyena(const Frame& F, const KArgs& a) {
    unsigned* head = (unsigned*)(a.ws + WS_CTL + CW_Q);
    volatile LAS int* slot = (volatile LAS int*)(F.lds + LDS_MISC + 64);
    { LAS f32x2* Thi = (LAS f32x2*)(F.lds + LDS_MISC + 512); LAS f32x2* Tlo = Thi + 128; const int tid = F.tid;
      if (tid < 256) { const int i = tid & 127; const float ang = -6.283185307179586f * (float)((tid < 128) ? i * 128 : i) / (float)FN;
          float sn, cs; sincosf(ang, &sn, &cs); (tid < 128 ? Thi : Tlo)[i] = (f32x2){cs, sn}; } }
    if (threadIdx.x == 0) *slot = (int)__hip_atomic_fetch_add(head, 1u, __ATOMIC_RELAXED, __HIP_MEMORY_SCOPE_AGENT);
    for (;;) {
        __syncthreads();
        const int u = *slot;
        if (u >= 512 + NA_UNITS) break;
        int nxt = 0;
        if (threadIdx.x == 0) nxt = (int)__hip_atomic_fetch_add(head, 1u, __ATOMIC_RELAXED, __HIP_MEMORY_SCOPE_AGENT);
        Frame Fu = F; { int t_ = threadIdx.x; asm volatile("" : "+v"(t_)); Fu.tid = t_; Fu.lane = t_ & 63; }
        if (u < 512) hyena_unit(Fu, a, u); else na_unit(Fu, a, u - 512);
        if (threadIdx.x == 0) *slot = nxt;
    }
}
constexpr int NPHASE = 21;
__global__ void __launch_bounds__(NTHR, 2) fwd_kernel(Args kargs) {
    extern __shared__ __attribute__((aligned(16))) unsigned char lds_raw[];
    LAS unsigned char* const lds0 = (LAS unsigned char*)lds_raw;
#define MKF() Frame F; KArgs args; { int t_ = threadIdx.x; asm volatile("" : "+v"(t_)); unsigned long long kp_ = (unsigned long long)__builtin_amdgcn_kernarg_segment_ptr(); asm volatile("" : "+s"(kp_)); \
    args.kp = kp_; args.ws = (unsigned char*)(GAS unsigned char*)kload<336>(kp_); args.out = (float*)(GAS float*)kload<328>(kp_); \
    F.lds = lds0; F.ws = args.ws; F.tid = t_; F.lane = t_ & 63; F.wave = __builtin_amdgcn_readfirstlane(t_ >> 6); F.G = gridDim.x; F.bid = blockIdx.x; } \
    unsigned char* const ws = args.ws; const float* const mod = (const float*)(ws + WS_MOD); (void)mod
    volatile LAS unsigned* misc = (volatile LAS unsigned*)(lds0 + LDS_MISC);
    if (threadIdx.x < 4) misc[threadIdx.x] = 0u;
    __syncthreads();
    const int lo = kargs.ph_lo, hi = kargs.ph_hi;
    const bool use_bar = (hi - lo) > 1;
    XcdBarrier bar; bar.bar = (unsigned*)(kargs.ws + WS_CTL); bar.x = 0; bar.st = misc;
    if (use_bar) bar = xcd_barrier_post((unsigned*)(kargs.ws + WS_CTL), misc);
#ifndef PHMASK
#define PHMASK 0xFFFFFFFu
#endif
#define IN(k) ((((PHMASK) >> (k)) & 1u) && lo <= (k) && (k) < hi)
#define SEAM(k) do { if (IN(k) && IN((k) + 1)) xcd_barrier(bar); } while (0)
#ifndef REPK
#define REPK (-1)
#endif
#ifndef REP_NOSTORE
#define REP_NOSTORE 0
#endif
#define PHASE(k, ...) if (IN(k)) { { constexpr bool REPFLAG = false; (void)REPFLAG; __VA_ARGS__ } if (REPK == (k)) { xcd_barrier(bar); { constexpr bool REPFLAG = REP_NOSTORE != 0; (void)REPFLAG; __VA_ARGS__ } } } SEAM(k)
    LAS int* tstart = (LAS int*)(lds0 + LDS_MISC + 128); LAS int* lcnt = (LAS int*)(lds0 + LDS_MISC + 384);

    PHASE(0,  MKF(); p0_prologue(F, args););
    PHASE(1,  MKF(); p_modulate_in(F, args););
    PHASE(2,  MKF();
        pg8::PlainOrder S; S.init(TT, ABPAD, F.G, F.bid); pg8::EpiBf16 E{(bf16_t*)(ws + WS_U), ABPAD};
        pg8::gemm_phase(F.lds, (const bf16_t*)(ws + WS_HA), (const bf16_t*)(ws + WS_WIN0), S, E););
    PHASE(3,  MKF(); p_streams(F, args););
    PHASE(4,  MKF(); p_prep(F, args););
    PHASE(5,  MKF(); p_scan(F, args););
    PHASE(6,  MKF(); p_readout(F, args););
    PHASE(7,  MKF();
        pg8::PlainOrder S; S.init(TT, DM, F.G, F.bid); pg8::EpiResid<false> E{KIN(args, 0), KIN(args, 2), (bf16_t*)(ws + WS_XRES), mod + 2048};
        pg8::gemm_phase(F.lds, (const bf16_t*)(ws + WS_MIX), (const bf16_t*)(ws + WS_WOUT0), S, E););
    PHASE(8,  MKF(); p_route(F, args, 0, TT););
    PHASE(9,  MKF();
        moe_tables(F, args, 0, tstart, lcnt);
        pg8::MoeOrder S{tstart, lcnt, tstart + 224, (const int*)(ws + WS_LIST), 8, F.G, F.bid, true}; pg8::EpiSwiglu E{ws + WS_R1, KIN(args, 9)};
        pg8::gemm_phase(F.lds, (const bf16_t*)(ws + WS_HA), (const bf16_t*)(ws + WS_W1T), S, E););
    PHASE(10,  MKF();
        moe_tables(F, args, 0, tstart, lcnt);
        pg8::MoeOrder S{tstart, lcnt, tstart + 224, (const int*)(ws + WS_LIST), 4, F.G, F.bid, false}; pg8::EpiMoeOut E{ws + WS_R2, KIN(args, 11), (const int*)(ws + WS_LIST), (const float*)(ws + WS_SGATE)};
        pg8::gemm_phase(F.lds, (const bf16_t*)(ws + WS_R1), (const bf16_t*)(ws + WS_W2TM), S, E););
    PHASE(11,  MKF(); p_combine(F, args, 0, TT););
    PHASE(12,  MKF();
        pg8::PlainOrder S; S.init(TT, CDCOLS, F.G, F.bid); pg8::EpiBf16 E{(bf16_t*)(ws + WS_U), CDCOLS};
        pg8::gemm_phase(F.lds, (const bf16_t*)(ws + WS_HA), (const bf16_t*)(ws + WS_WIN1), S, E););
    PHASE(13,  MKF(); p_prep1(F, args););
    PHASE(14,  MKF(); p_na_hyena(F, args););
    PHASE(15,  MKF(); p_hy_back(F, args););
    PHASE(16,  MKF();
        pg8::PlainOrder S; S.init(TL, DM, F.G, F.bid); pg8::EpiResid<true> E{ws + WS_XRES, ws + WS_XRES, (bf16_t*)(ws + WS_XRES), mod + 5 * 6144 + 2048};
        pg8::gemm_phase(F.lds, (const bf16_t*)(ws + WS_MIX), (const bf16_t*)(ws + WS_WOUT1), S, E););
    PHASE(17,  MKF(); p_route(F, args, 1, TL););
    PHASE(18,  MKF();
        moe_tables(F, args, 1, tstart, lcnt);
        pg8::MoeOrder S{tstart, lcnt, tstart + 224, (const int*)(ws + WS_LIST), 8, F.G, F.bid, true}; pg8::EpiSwiglu E{ws + WS_R1, KIN(args, 9) + 32 * 2048};
        pg8::gemm_phase(F.lds, (const bf16_t*)(ws + WS_HA), (const bf16_t*)(ws + WS_W1T + (size_t)32 * 2048 * 1024), S, E););
    PHASE(19,  MKF();
        moe_tables(F, args, 1, tstart, lcnt);
        pg8::MoeOrder S{tstart, lcnt, tstart + 224, (const int*)(ws + WS_LIST), 4, F.G, F.bid, false}; pg8::EpiMoeOut E{ws + WS_R2, KIN(args, 11) + 32 * 1024, (const int*)(ws + WS_LIST), (const float*)(ws + WS_SGATE)};
        pg8::gemm_phase(F.lds, (const bf16_t*)(ws + WS_R1), (const bf16_t*)(ws + WS_W2TM + (size_t)32 * 1024 * 1024), S, E););
    PHASE(20,  MKF(); p_combine(F, args, 1, TL); );
#undef IN
#undef SEAM
#undef PHASE
}

#ifndef N_LAUNCH_MODE
#define N_LAUNCH_MODE 1
#endif
extern "C" void kernel_launch(void* const* d_in, const int* in_sizes, int n_in, void* d_out, int out_size, void* d_ws, size_t ws_size, hipStream_t stream) {
    static int grid = 0;
    if (grid == 0) {
        if (n_in != 41 || out_size != TL * DM || ws_size < WS_END) { fprintf(stderr, "kernel_launch: unexpected shapes: n_in %d out %d ws %zu (need %zu)\n", n_in, out_size, ws_size, (size_t)WS_END); grid = -1; return; }
        int dev = 0, cus = 0, per_cu = 0;
        if (hipGetDevice(&dev) != hipSuccess || hipDeviceGetAttribute(&cus, hipDeviceAttributeMultiprocessorCount, dev) != hipSuccess) { grid = -1; return; }
        if (hipFuncSetAttribute((const void*)fwd_kernel, hipFuncAttributeMaxDynamicSharedMemorySize, LDS_BYTES) != hipSuccess) { fprintf(stderr, "kernel_launch: hipFuncSetAttribute failed\n"); grid = -1; return; }
        if (hipOccupancyMaxActiveBlocksPerMultiprocessor(&per_cu, (const void*)fwd_kernel, NTHR, LDS_BYTES) != hipSuccess || per_cu < 1) { fprintf(stderr, "kernel_launch: occupancy query says %d blocks per CU\n", per_cu); }
        (void)hipGetLastError();
        grid = cus;
    }
    if (grid < 0) return;
    (void)hipMemsetAsync((char*)d_ws + WS_CTL, 0, CTL_BYTES, stream);
    Args a{};
    for (int i = 0; i < 41; ++i) a.in[i] = (const float*)d_in[i];
    a.out = (float*)d_out; a.ws = (unsigned char*)d_ws;
#if N_LAUNCH_MODE == 1
    a.ph_lo = 0; a.ph_hi = NPHASE;
    hipLaunchKernelGGL(fwd_kernel, dim3(grid), dim3(NTHR), LDS_BYTES, stream, a);
#else
    for (int p = 0; p < NPHASE; ++p) { a.ph_lo = p; a.ph_hi = p + 1; hipLaunchKernelGGL(fwd_kernel, dim3(grid), dim3(NTHR), LDS_BYTES, stream, a);
#ifdef REP_PHASE
        if (p == REP_PHASE) { if (p == 8 || p == 14 || p == 17) (void)hipMemsetAsync((char*)d_ws + WS_CTL + CW_CNT, 0, 4096, stream); hipLaunchKernelGGL(fwd_kernel, dim3(grid), dim3(NTHR), LDS_BYTES, stream, a); }
#endif
    }
#endif
}
```

```cpp
#include <hip/hip_runtime.h>
#include <cstdio>
#include <cstdint>

#define DI __device__ __forceinline__
#define LAS __attribute__((address_space(3)))
typedef unsigned short bf16_t;
typedef short bf16x8 __attribute__((ext_vector_type(8)));
typedef float f32x4 __attribute__((ext_vector_type(4)));
typedef float f32x2 __attribute__((ext_vector_type(2)));
typedef unsigned u32x4 __attribute__((ext_vector_type(4)));
typedef unsigned u32x2 __attribute__((ext_vector_type(2)));

constexpr int DM = 1024, NB = 4, SEQ = 8192, CL = 256;
constexpr int TL = NB * SEQ;
constexpr int TC = NB * CL;
constexpr int TT = TL + TC;
constexpr int ACOLS = 1920, ABCOLS = 4480, ABPAD = 4608, CDCOLS = 3072;
constexpr int NEXP = 32, TOPK = 4;
constexpr int NTHR = 512;

constexpr size_t al256(size_t x) { return (x + 255) & ~(size_t)255; }
constexpr size_t WS_CTL   = 0;
constexpr size_t CTL_BYTES = 32768;
constexpr size_t CW_CNT = 16384;
constexpr size_t CW_Q   = 16384 + 1024;
constexpr size_t WS_MOD   = WS_CTL + CTL_BYTES;
constexpr size_t WS_ROPE  = WS_MOD + al256(2 * 5 * 6144 * 4);
constexpr size_t WS_W2T   = WS_ROPE + 128 * 16 * 2 * 4;
constexpr size_t WS_A2T   = WS_W2T + 2 * 512 * 64 * 2;
constexpr size_t WS_G2T   = WS_A2T + 2 * 512 * 64 * 2;
constexpr size_t WS_WIN0  = WS_G2T + 512 * 128 * 2;
constexpr size_t WS_WOUT0 = WS_WIN0 + (size_t)ABPAD * DM * 2;
constexpr size_t WS_WIN1  = WS_WOUT0 + (size_t)DM * DM * 2;
constexpr size_t WS_WOUT1 = WS_WIN1 + (size_t)CDCOLS * DM * 2;
constexpr size_t WS_W1T   = WS_WOUT1 + (size_t)DM * DM * 2;
constexpr size_t WS_SGATE = WS_W1T + (size_t)2 * 32 * 2048 * 1024;
constexpr size_t WS_W2TM  = WS_W1T + (size_t)2 * 32 * 2048 * 1024 * 2;
constexpr size_t WS_HYF   = WS_W2TM + (size_t)2 * 32 * 1024 * 1024 * 2;
constexpr size_t WS_XRES  = WS_HYF + (size_t)4 * 512 * 8192 * 4;
constexpr size_t WS_HA    = WS_XRES + (size_t)TT * DM * 4;
constexpr size_t WS_MIX   = WS_HA + (size_t)TT * DM * 2;
constexpr size_t WS_GATE  = WS_MIX + (size_t)TT * DM * 2;
constexpr size_t WS_LIST  = WS_GATE + (size_t)TT * 4 * 4;
constexpr size_t WS_U     = WS_LIST + (size_t)32 * TT * 4;
constexpr size_t WS_R1    = WS_U + (size_t)TT * ABPAD * 2;
constexpr size_t R1_BYTES = (size_t)64 * 528 * (12288 + 7168) + (size_t)2 * TT * 512 * 2 + (size_t)2 * TT * 8 * 4;
constexpr size_t WS_R2    = WS_R1 + R1_BYTES;
constexpr size_t R2_BYTES = (size_t)4 * TT * 512 * 4;
constexpr size_t WS_END   = WS_R2 + R2_BYTES;
constexpr int HROWS = TT * 4 + 32 * 256;
static_assert((size_t)HROWS * 1024 * 2 <= R1_BYTES, "H fits region 1");
static_assert((size_t)TT * 4 * 1024 * 2 <= R2_BYTES, "Y fits region 2");
constexpr size_t STRB = (size_t)TT * 512 * 2;
constexpr size_t S_R = 0, S_V = 1, S_KK = 2, S_G = 3, S_LD0 = 4, S_LD1 = 5, S_B0 = 6, S_B1 = 7, S_KD0 = 8, S_KD1 = 9;
constexpr size_t L1_QN  = 0;
constexpr size_t L1_KN  = L1_QN + (size_t)TL * 512 * 2;
constexpr size_t L1_VT  = L1_KN + (size_t)TT * 512 * 2;
constexpr size_t L1_VCT = L1_VT + (size_t)4 * 512 * 8192 * 2;
constexpr size_t L1_HVT = L1_VCT + (size_t)4 * 512 * 256 * 2;
constexpr size_t L1_HYT = L1_HVT + (size_t)3 * 4 * 512 * 8192 * 2;
constexpr size_t L1_ZT  = L1_HYT + (size_t)4 * 512 * 8192 * 2;
static_assert(L1_ZT + (size_t)4 * 512 * 8192 * 4 <= R1_BYTES, "layer-1 buffers fit region 1");

constexpr int LDS_BYTES = 155648;
constexpr int LDS_MISC = 151552;

DI float bf2f(bf16_t b) { return __uint_as_float(((unsigned)b) << 16); }
typedef __bf16 bf16x2_t __attribute__((ext_vector_type(2)));
DI unsigned pack2(float lo, float hi) { const f32x2 v = (f32x2){lo, hi}; return __builtin_bit_cast(unsigned, __builtin_convertvector(v, bf16x2_t)); }
DI bf16_t f2bf(float f) { return (bf16_t)(pack2(f, 0.0f) & 0xFFFFu); }
DI float lo2f(unsigned w) { return __uint_as_float(w << 16); }
DI float hi2f(unsigned w) { return __uint_as_float(w & 0xFFFF0000u); }
DI float sigmoidf_(float x) { return 1.0f / (1.0f + __expf(-x)); }
DI float siluf_(float x) { return x / (1.0f + __expf(-x)); }
DI void load8bf(const bf16_t* p, float (&x)[8]) { const u32x4 w = *(const u32x4*)p; x[0] = lo2f(w.x); x[1] = hi2f(w.x); x[2] = lo2f(w.y); x[3] = hi2f(w.y); x[4] = lo2f(w.z); x[5] = hi2f(w.z); x[6] = lo2f(w.w); x[7] = hi2f(w.w); }
DI void store8bf(bf16_t* p, const float (&x)[8]) { u32x4 w; w.x = pack2(x[0], x[1]); w.y = pack2(x[2], x[3]); w.z = pack2(x[4], x[5]); w.w = pack2(x[6], x[7]); *(u32x4*)p = w; }
DI void load8f(const float* p, float (&x)[8]) { const f32x4 a = *(const f32x4*)p, b = *(const f32x4*)(p + 4); x[0] = a[0]; x[1] = a[1]; x[2] = a[2]; x[3] = a[3]; x[4] = b[0]; x[5] = b[1]; x[6] = b[2]; x[7] = b[3]; }
DI float wave_sum(float v) {
#pragma unroll
    for (int m = 32; m >= 1; m >>= 1) v += __shfl_xor(v, m, 64);
    return v;
}
template <int CTRL> DI float dppmov(float x) { return __builtin_bit_cast(float, __builtin_amdgcn_update_dpp(0, __builtin_bit_cast(int, x), CTRL, 0xF, 0xF, true)); }
DI float rowsum16(float x) { x += dppmov<0xB1>(x); x += dppmov<0x4E>(x); x += dppmov<0x141>(x); x += dppmov<0x140>(x); return x; }
DI float rowmax16(float x) { x = fmaxf(x, dppmov<0xB1>(x)); x = fmaxf(x, dppmov<0x4E>(x)); x = fmaxf(x, dppmov<0x141>(x)); x = fmaxf(x, dppmov<0x140>(x)); return x; }
DI float sum8(float x) { x += dppmov<0xB1>(x); x += dppmov<0x4E>(x); x += dppmov<0x141>(x); return x; }

#define XB_TMO      128
#define XB_XCNT(j)  (256  + 64 * (j))
#define XB_XSUB(j)  (1280 + 64 * (j))
#define XB_XGEN(j)  (2304 + 64 * (j))
#define XB_TOP      3328
#define XB_TOPGEN   3392
#define XCD_BAR_WORDS 3456
#define XB_SPIN_CAP (1u << 18)
DI unsigned xb_ld(unsigned* p)              { return __hip_atomic_load(p, __ATOMIC_RELAXED, __HIP_MEMORY_SCOPE_AGENT); }
DI unsigned xb_add(unsigned* p, unsigned v) { return __hip_atomic_fetch_add(p, v, __ATOMIC_RELAXED, __HIP_MEMORY_SCOPE_AGENT); }
DI unsigned xb_xcc_id() { return (unsigned)__builtin_amdgcn_s_getreg((3 << 11) | 20) & 0xFu; }
#define XB_SPIN(cond, bar) do { unsigned _sp = 0; while (cond) { __builtin_amdgcn_s_sleep(1); \
    if ((++_sp & 255u) == 0u) { if (xb_ld(&(bar)[XB_TMO])) break; if (_sp > XB_SPIN_CAP) { atomicAdd(&(bar)[XB_TMO], 1u); break; } } } } while (0)
struct XcdBarrier { unsigned* bar; unsigned x; volatile LAS unsigned* st; };
DI XcdBarrier xcd_barrier_post(unsigned* bar, volatile LAS unsigned* st) {
    XcdBarrier b; b.bar = bar; b.x = xb_xcc_id(); b.st = st;
    if (threadIdx.x == 0) (void)xb_add(&bar[XB_XCNT(b.x)], 1u);
    return b;
}
DI void xcd_barrier_complete(unsigned* bar, unsigned x, unsigned& nloc, unsigned& nx) {
    const unsigned G = gridDim.x * gridDim.y * gridDim.z;
    unsigned sum, cnt, mine, sp = 0u;
    for (;;) {
        sum = 0u; cnt = 0u; mine = 0u;
#pragma unroll
        for (unsigned j = 0; j < 16; ++j) { const unsigned c = xb_ld(&bar[XB_XCNT(j)]); sum += c; cnt += (c > 0u) ? 1u : 0u; mine = (j == x) ? c : mine; }
        if (sum == G) break;
        __builtin_amdgcn_s_sleep(1);
        if ((++sp & 255u) == 0u) { if (xb_ld(&bar[XB_TMO])) break; if (sp > XB_SPIN_CAP) { atomicAdd(&bar[XB_TMO], 1u); break; } }
    }
    nloc = mine > 0u ? mine : 1u; nx = cnt > 0u ? cnt : 1u;
}
DI void xcd_barrier(const XcdBarrier& b) {
    asm volatile("s_waitcnt vmcnt(0)" ::: "memory");
    __syncthreads();
    if (threadIdx.x == 0) {
        unsigned* bar = b.bar;
        __builtin_amdgcn_s_waitcnt(0);
        unsigned nloc = b.st[0], nx = b.st[1];
        if (nloc == 0u) { xcd_barrier_complete(bar, b.x, nloc, nx); b.st[0] = nloc; b.st[1] = nx; }
        const unsigned old = xb_add(&bar[XB_XSUB(b.x)], 1u);
        const unsigned gen = old / nloc;
        if (old + 1u == (gen + 1u) * nloc) {
            __builtin_amdgcn_fence(__ATOMIC_RELEASE, "agent");
            asm volatile("s_waitcnt vmcnt(0)" ::: "memory");
            const unsigned og = xb_add(&bar[XB_TOP], 1u);
            const unsigned tg = og / nx;
            if (og + 1u == (tg + 1u) * nx) xb_add(&bar[XB_TOPGEN], 1u);
            else XB_SPIN(xb_ld(&bar[XB_TOPGEN]) == tg, bar);
            __builtin_amdgcn_fence(__ATOMIC_ACQUIRE, "agent");
            xb_add(&bar[XB_XGEN(b.x)], 1u);
            asm volatile("s_waitcnt vmcnt(0)" ::: "memory");
        } else {
            XB_SPIN(xb_ld(&bar[XB_XGEN(b.x)]) == gen, bar);
            __builtin_amdgcn_fence(__ATOMIC_ACQUIRE, "agent");
            asm volatile("s_waitcnt vmcnt(0)" ::: "memory");
        }
    }
    __syncthreads();
}

DI void lds_barrier() { asm volatile("s_waitcnt lgkmcnt(0)" ::: "memory"); __builtin_amdgcn_s_barrier(); asm volatile("" ::: "memory"); }

struct Args {
    const float* in[41];
    float* out; unsigned char* ws;
    int ph_lo, ph_hi;
};
struct Frame {
    LAS unsigned char* lds;
    unsigned char* ws;
    int tid, lane, wave, G, bid;
};
struct KArgs { unsigned long long kp; unsigned char* ws; float* out; };
template <int OFF> DI unsigned long long kload(unsigned long long kp) { unsigned long long v; asm("s_load_dwordx2 %0, %1, %2\n\ts_waitcnt lgkmcnt(0)" : "=s"(v) : "s"(kp), "n"(OFF)); return v; }
#define GAS __attribute__((address_space(1)))
#define KIN(a, N) ((const float*)(GAS const float*)kload<(N) * 8>((a).kp))
typedef int i32x8 __attribute__((ext_vector_type(8)));
typedef int i32x4v __attribute__((ext_vector_type(4)));
DI unsigned pack4_fp8(float a, float b, float c, float d) { int w = __builtin_amdgcn_cvt_pk_fp8_f32(a, b, 0, false); w = __builtin_amdgcn_cvt_pk_fp8_f32(c, d, w, true); return (unsigned)w; }
DI float clamp8(float x) { return __builtin_fminf(__builtin_fmaxf(x, -448.f), 448.f); }
constexpr float Q8_W = 64.f, Q8_H = 4.f, Q8_Y = 16.f;
namespace pg8 {
constexpr int BM = 256, BK = 64, HALF = 128, HTB = HALF * BK * 2, STAGE_BYTES = 8 * HTB, NXCD = 8, WGM = 8, KD = 1024;
DI int lds_byte(int r, int c) { const int st = (r >> 4) * 2 + (c >> 5), rr = r & 15, cc = c & 31, ob = rr * 64 + cc * 2; return st * 1024 + (ob ^ (((ob >> 9) & 1) << 5)); }
DI void stage_rc(int b, int& R, int& C) { const int st = b / 1024, sb = b % 1024, swz = sb ^ (((sb >> 9) & 1) << 5); R = (st >> 1) * 16 + swz / 64; C = (st & 1) * 32 + (swz % 64) / 2; }
DI int perm32(int rho) { const int n = rho >> 4, i = rho & 15; return 8 * (i >> 2) + 4 * n + (i & 3); }
DI unsigned cvt_pk_bf16(float lo, float hi) { return pack2(lo, hi); }

struct Unit { int pm, pn, e, nvalid, slot0; };
template <bool PERM, bool FP8> DI void lane_rc(int (&Rr)[2], int (&Rb)[2], int (&Cc)[2]) {
    int tid = threadIdx.x; asm volatile("" : "+v"(tid));
#pragma unroll
    for (int i = 0; i < 2; ++i) { int R, C; stage_rc(tid * 16 + i * 8192, R, C); Rr[i] = R; Cc[i] = C * 2; Rb[i] = PERM ? ((R & ~31) + perm32(R & 31)) : R; }
}
template <int CM> DI int brow(int h, int rb) { return CM == 0 ? h * HALF + rb : (rb >> 5) * 64 + ((rb & 31) >> 3) * 16 + h * 8 + (rb & 7); }
constexpr int PRM_BASE = STAGE_BYTES, PRM_BYTES = 4096, PRM_VEC = 0, PRM_AID = 1024, PRM_GATE = 2048, PRM_NIDX = 3072;
DI void dma1k(const void* base, unsigned byte_off, unsigned lds_addr) {
    GAS const char* g = (GAS const char*)base + __builtin_amdgcn_readfirstlane(byte_off);
    const unsigned lo = ((unsigned)threadIdx.x & 63u) * 16u;
    asm volatile("s_mov_b32 m0, %2\n\ts_nop 0\n\tglobal_load_lds_dwordx4 %0, %1" :: "v"(lo), "s"(g), "s"(__builtin_amdgcn_readfirstlane(lds_addr)) : "memory", "m0");
}
struct PlainOrder {
    int nM, nN, nwg, G, c;
    DI void init(int M, int N, int G_, int c_) { nM = M / BM; nN = N / BM; nwg = nM * nN; G = G_; c = c_; }
    DI bool next(int i, Unit& u) const {
        const long L = (long)i * G + c; if (L >= nwg) return false;
        int wgid = (int)L; { const int q = nwg / NXCD, r = nwg % NXCD, xcd = wgid % NXCD, off = wgid / NXCD; wgid = (xcd < r ? xcd * (q + 1) : r * (q + 1) + (xcd - r) * q) + off; }
        const int nig = WGM * nN, gid = wgid / nig, fm = gid * WGM, gsz = (nM - fm) < WGM ? (nM - fm) : WGM;
        u.pm = fm + ((wgid % nig) % gsz); u.pn = (wgid % nig) / gsz; u.e = 0; u.nvalid = 256; u.slot0 = 0; return true;
    }
    DI void prefetch(const Unit&, unsigned, int) const {}
    template <bool PERM, bool FP8, int CM> DI void finish(const Unit& u, const LAS int*, unsigned (&va)[2][2], unsigned (&vb)[2][2]) const { offsets<PERM, FP8, CM>(u, va, vb); }
    template <bool PERM, bool FP8, int CM> DI void offsets(const Unit& u, unsigned (&va)[2][2], unsigned (&vb)[2][2]) const {
        int R[2], Rb[2], C[2]; lane_rc<PERM, FP8>(R, Rb, C);
        constexpr int ROWB = FP8 ? KD : KD * 2;
#pragma unroll
        for (int h = 0; h < 2; ++h)
#pragma unroll
            for (int i = 0; i < 2; ++i) {
                va[h][i] = (unsigned)((u.pm * BM + h * HALF + R[i]) * ROWB + C[i]);
                vb[h][i] = (unsigned)((u.pn * BM + brow<CM>(h, Rb[i])) * ROWB + C[i]);
            }
    }
};

struct MoeOrder {
    const LAS int* tstart; const LAS int* cnt; const LAS int* tile_e; const int* list;
    int NT, G, c; bool gather;
    DI bool next(int i, Unit& u) const {
        const int total = tstart[32] * NT;
        long L = (long)i * G + c;
        if (G == 256) L = ((long)i * 8 + (c & 7)) * 32 + (c >> 3);
        if (L >= total) return false;
        const int mt = (int)(L / NT); u.pn = (int)(L % NT);
        const int e = tile_e[mt];
        u.e = e; u.pm = mt - tstart[e]; const int rem = cnt[e] - u.pm * BM; u.nvalid = rem < BM ? rem : BM; u.slot0 = mt * BM; return true;
    }
    DI void prefetch(const Unit& n, unsigned prm, int wid) const {
        if (gather && wid == 3) dma1k(list, (unsigned)(((size_t)n.e * TT + n.pm * BM) * 4), prm + PRM_NIDX);
    }
    template <bool PERM, bool FP8, int CM> DI void finish(const Unit& u, const LAS int* nidx, unsigned (&va)[2][2], unsigned (&vb)[2][2]) const {
        int R[2], Rb[2], C[2]; lane_rc<PERM, FP8>(R, Rb, C);
        const int ncols = NT * BM;
        constexpr int ROWB = FP8 ? KD : KD * 2;
#pragma unroll
        for (int h = 0; h < 2; ++h)
#pragma unroll
            for (int i = 0; i < 2; ++i) {
                const int rl = h * HALF + R[i];
                int arow;
                if (gather) { const int idx = rl < u.nvalid ? rl : 0; arow = nidx[idx] >> 2; }
                else arow = u.slot0 + rl;
                va[h][i] = (unsigned)(arow * ROWB + C[i]);
                vb[h][i] = (unsigned)(((u.e * ncols) + u.pn * BM + brow<CM>(h, Rb[i])) * ROWB + C[i]);
            }
    }
    template <bool PERM, bool FP8, int CM> DI void offsets(const Unit& u, unsigned (&va)[2][2], unsigned (&vb)[2][2]) const {
        int R[2], Rb[2], C[2]; lane_rc<PERM, FP8>(R, Rb, C);
        const int ncols = NT * BM;
        constexpr int ROWB = FP8 ? KD : KD * 2;
#pragma unroll
        for (int h = 0; h < 2; ++h)
#pragma unroll
            for (int i = 0; i < 2; ++i) {
                const int rl = h * HALF + R[i];
                int arow;
                if (gather) { const int idx = rl < u.nvalid ? rl : 0; arow = list[(size_t)u.e * TT + u.pm * BM + idx] >> 2; }
                else arow = u.slot0 + rl;
                va[h][i] = (unsigned)(arow * ROWB + C[i]);
                vb[h][i] = (unsigned)(((u.e * ncols) + u.pn * BM + brow<CM>(h, Rb[i])) * ROWB + C[i]);
            }
    }
};
DI i32x8 cat8(bf16x8 lo, bf16x8 hi) { const i32x4v a = __builtin_bit_cast(i32x4v, lo), b = __builtin_bit_cast(i32x4v, hi); return __builtin_shufflevector(a, b, 0, 1, 2, 3, 4, 5, 6, 7); }

template <int SLP = 0, class Epi, class Sched>
DI void gemm_phase(LAS unsigned char* lds, const bf16_t* Abase, const bf16_t* Bbase, const Sched& S, const Epi& E) {
    const int tid = threadIdx.x, wid = __builtin_amdgcn_readfirstlane(tid >> 6), lane = tid & 63, wr = wid >> 2, wc = wid & 3, fr = lane & 15, fq = lane >> 4;
    constexpr bool FP8 = Epi::FP8;
    constexpr int nt = FP8 ? KD / (2 * BK) : KD / BK;
    constexpr size_t kstep = (size_t)(BK * 2);
    const unsigned ldsw = (unsigned)wid * 1024u;
    const unsigned ldsb = (unsigned)(size_t)lds + ldsw;
    const int aoff = lds_byte(wr * 64 + fr, fq * 8), boff = lds_byte(wc * 32 + fr, fq * 8);
    const char* const Ab = (const char*)Abase; const char* const Bb = (const char*)Bbase;
#define PG8_SA(b, h) (((b) * 2 + (h)) * HTB)
#define PG8_SB(b, h) ((4 + (b) * 2 + (h)) * HTB)
#define PG8_STAGE(bufoff, gbase, voff) do { GAS const char* g_ = (GAS const char*)(gbase); _Pragma("unroll") for (int _i = 0; _i < 2; ++_i) \
        asm volatile("s_mov_b32 m0, %2\n\ts_nop 0\n\tglobal_load_lds_dwordx4 %0, %1" :: "v"((voff)[_i]), "s"(g_), "s"(ldsb + (unsigned)((bufoff) + _i * 8192)) : "memory", "m0"); } while (0)
#define PG8_LDA(dst, b, h) do { _Pragma("unroll") for (int m = 0; m < 4; ++m) _Pragma("unroll") for (int k = 0; k < 2; ++k) dst[m][k] = *(const LAS bf16x8*)(lds + PG8_SA(b, h) + aoff + m * 2048 + k * 1024); } while (0)
#define PG8_LDB(dst, b, h) do { _Pragma("unroll") for (int n = 0; n < 2; ++n) _Pragma("unroll") for (int k = 0; k < 2; ++k) dst[n][k] = *(const LAS bf16x8*)(lds + PG8_SB(b, h) + boff + n * 2048 + k * 1024); } while (0)
#define PG8_LDA8(dst, b, h) do { _Pragma("unroll") for (int m = 0; m < 4; ++m) { const i32x4v lo_ = *(const LAS i32x4v*)(lds + PG8_SA(b, h) + aoff + m * 2048), hi_ = *(const LAS i32x4v*)(lds + PG8_SA(b, h) + aoff + m * 2048 + 1024); \
        dst[m] = __builtin_shufflevector(lo_, hi_, 0, 1, 2, 3, 4, 5, 6, 7); } } while (0)
#define PG8_LDB8(dst, b, h) do { _Pragma("unroll") for (int n = 0; n < 2; ++n) { const i32x4v lo_ = *(const LAS i32x4v*)(lds + PG8_SB(b, h) + boff + n * 2048), hi_ = *(const LAS i32x4v*)(lds + PG8_SB(b, h) + boff + n * 2048 + 1024); \
        dst[n] = __builtin_shufflevector(lo_, hi_, 0, 1, 2, 3, 4, 5, 6, 7); } } while (0)
#define PG8_MMA(ai, bj, At, Bt) do { __builtin_amdgcn_s_setprio(1); _Pragma("unroll") for (int k = 0; k < 2; ++k) _Pragma("unroll") for (int m = 0; m < 4; ++m) _Pragma("unroll") for (int n = 0; n < 2; ++n) \
        asm volatile("v_mfma_f32_16x16x32_bf16 %0, %1, %2, %0" : "+v"(acc[ai][bj][m][n]) : "v"(Bt[n][k]), "v"(At[m][k])); __builtin_amdgcn_s_setprio(0); } while (0)
#define PG8_MMA8(ai, bj, At, Bt) do { __builtin_amdgcn_s_setprio(1); _Pragma("unroll") for (int m = 0; m < 4; ++m) _Pragma("unroll") for (int n = 0; n < 2; ++n) \
        asm volatile("v_mfma_f32_16x16x128_f8f6f4 %0, %1, %2, %0" : "+v"(acc[ai][bj][m][n]) : "v"(Bt[n]), "v"(At[m])); __builtin_amdgcn_s_setprio(0); } while (0)
#define PG8_MMA_I(ai, bj, At, Bt) do { __builtin_amdgcn_s_setprio(1); _Pragma("unroll") for (int m = 0; m < 4; ++m) _Pragma("unroll") for (int n = 0; n < 2; ++n) \
        asm volatile("v_mfma_f32_16x16x32_bf16 %0, %1, %2, 0" : "=v"(acc[ai][bj][m][n]) : "v"(Bt[n][0]), "v"(At[m][0])); \
        _Pragma("unroll") for (int m = 0; m < 4; ++m) _Pragma("unroll") for (int n = 0; n < 2; ++n) \
        asm volatile("v_mfma_f32_16x16x32_bf16 %0, %1, %2, %0" : "+v"(acc[ai][bj][m][n]) : "v"(Bt[n][1]), "v"(At[m][1])); __builtin_amdgcn_s_setprio(0); } while (0)
#define PG8_MMA8_I(ai, bj, At, Bt) do { __builtin_amdgcn_s_setprio(1); _Pragma("unroll") for (int m = 0; m < 4; ++m) _Pragma("unroll") for (int n = 0; n < 2; ++n) \
        asm volatile("v_mfma_f32_16x16x128_f8f6f4 %0, %1, %2, 0" : "=v"(acc[ai][bj][m][n]) : "v"(Bt[n]), "v"(At[m])); __builtin_amdgcn_s_setprio(0); } while (0)
#define PG8_MM_I(ai, bj, AtX, BtX) do { if constexpr (FP8) PG8_MMA8_I(ai, bj, AtX##8, BtX##8); else PG8_MMA_I(ai, bj, AtX, BtX); } while (0)
#define PG8_MM(ai, bj, AtX, BtX) do { if constexpr (FP8) PG8_MMA8(ai, bj, AtX##8, BtX##8); else PG8_MMA(ai, bj, AtX, BtX); } while (0)
#define PG8_LA(AtX, b, h) do { if constexpr (FP8) PG8_LDA8(AtX##8, b, h); else PG8_LDA(AtX, b, h); } while (0)
#define PG8_LB(BtX, b, h) do { if constexpr (FP8) PG8_LDB8(BtX##8, b, h); else PG8_LDB(BtX, b, h); } while (0)
#define PG8_WAIT_V(n) asm volatile("s_waitcnt vmcnt(" #n ")" ::: "memory")
#define PG8_WAIT_L(n) asm volatile("s_waitcnt lgkmcnt(" #n ")" ::: "memory")
#define PG8_BAR __builtin_amdgcn_s_barrier()
#define PG8_SCHED __builtin_amdgcn_sched_barrier(0)
    Unit cur, nxt; int ui = 0;
    if (!S.next(0, cur)) return;
    if constexpr (SLP > 0) { const int slot = (blockIdx.x >> 3) & 31;
#pragma unroll 1
        for (int i = 0; i < slot; ++i) __builtin_amdgcn_s_sleep(SLP); }
    f32x4 acc[2][2][4][2];
    bf16x8 At[4][2], B0[2][2], B1[2][2];
    i32x8 At8[4], B08[2], B18[2];
    unsigned vaC[2][2], vbC[2][2], vaN[2][2], vbN[2][2];
    S.template offsets<Epi::PERM, FP8, Epi::CM>(cur, vaC, vbC);
    PG8_STAGE(PG8_SB(0, 0), Bb, vbC[0]); PG8_STAGE(PG8_SA(0, 0), Ab, vaC[0]); PG8_STAGE(PG8_SB(0, 1), Bb, vbC[1]); PG8_STAGE(PG8_SA(0, 1), Ab, vaC[1]);
    if (wr == 1) PG8_BAR;
    PG8_WAIT_V(4); PG8_BAR;
    PG8_STAGE(PG8_SB(1, 0), Bb + kstep, vbC[0]); PG8_STAGE(PG8_SA(1, 0), Ab + kstep, vaC[0]); PG8_STAGE(PG8_SB(1, 1), Bb + kstep, vbC[1]);
    PG8_WAIT_V(6); PG8_BAR;
    for (;;) {
        const bool has_next = S.next(ui + 1, nxt);
        const unsigned prm = (unsigned)(size_t)lds + (unsigned)(PRM_BASE + (ui & 1) * PRM_BYTES);
        const LAS unsigned char* const prmp = lds + PRM_BASE + (ui & 1) * PRM_BYTES;
        E.prefetch(cur, prm, wid);
        if (has_next) S.prefetch(nxt, prm, wid);
#define PG8_KBODY(K1, K2, K3, VA2, VB2, MMF) do { \
              \
            PG8_LB(B0, 0, 0); PG8_SCHED; PG8_LA(At, 0, 0); PG8_STAGE(PG8_SA(1, 1), Ab + (K1), vaC[1]); \
            PG8_WAIT_L(8); PG8_BAR; PG8_WAIT_L(0); MMF(0, 0, At, B0); PG8_BAR; PG8_SCHED; \
              \
            PG8_LB(B1, 0, 1); PG8_STAGE(PG8_SB(0, 0), Bb + (K2), VB2[0]); \
            PG8_BAR; PG8_WAIT_L(0); MMF(0, 1, At, B1); PG8_BAR; \
              \
            PG8_LA(At, 0, 1); PG8_STAGE(PG8_SA(0, 0), Ab + (K2), VA2[0]); \
            PG8_BAR; PG8_WAIT_L(0); MMF(1, 0, At, B0); PG8_BAR; PG8_SCHED; \
              \
            PG8_STAGE(PG8_SB(0, 1), Bb + (K2), VB2[1]); \
            PG8_WAIT_V(6); PG8_BAR; MMF(1, 1, At, B1); PG8_BAR; \
              \
            PG8_LB(B0, 1, 0); PG8_SCHED; PG8_LA(At, 1, 0); PG8_STAGE(PG8_SA(0, 1), Ab + (K2), VA2[1]); \
            PG8_WAIT_L(8); PG8_BAR; PG8_WAIT_L(0); PG8_MM(0, 0, At, B0); PG8_BAR; PG8_SCHED; \
              \
            PG8_LB(B1, 1, 1); PG8_STAGE(PG8_SB(1, 0), Bb + (K3), VB2[0]); \
            PG8_BAR; PG8_WAIT_L(0); PG8_MM(0, 1, At, B1); PG8_BAR; \
              \
            PG8_LA(At, 1, 1); PG8_STAGE(PG8_SA(1, 0), Ab + (K3), VA2[0]); \
            PG8_BAR; PG8_WAIT_L(0); PG8_MM(1, 0, At, B0); PG8_BAR; PG8_SCHED; \
              \
            PG8_STAGE(PG8_SB(1, 1), Bb + (K3), VB2[1]); \
            PG8_WAIT_V(6); PG8_BAR; PG8_MM(1, 1, At, B1); PG8_BAR; } while (0)
        PG8_KBODY(kstep, 2 * kstep, 3 * kstep, vaC, vbC, PG8_MM_I);
#pragma unroll 1
        for (int t = 2; t < nt - 2; t += 2) {
            const size_t k1 = (size_t)(t + 1) * kstep, k2 = (size_t)(t + 2) * kstep, k3 = k2 + kstep;
            PG8_KBODY(k1, k2, k3, vaC, vbC, PG8_MM);
        }
        if (has_next) S.template finish<Epi::PERM, FP8, Epi::CM>(nxt, (const LAS int*)(prmp + PRM_NIDX), vaN, vbN);
        else {
#pragma unroll
            for (int h = 0; h < 2; ++h)
#pragma unroll
                for (int i = 0; i < 2; ++i) { vaN[h][i] = vaC[h][i]; vbN[h][i] = vbC[h][i]; }
        }
        PG8_KBODY((size_t)(nt - 1) * kstep, (size_t)0, kstep, vaN, vbN, PG8_MM);
        asm volatile("s_nop 15\n\ts_nop 15" ::: "memory");
        E(acc, cur, wr, wc, fr, fq, prmp);
        if (!has_next) break;
        cur = nxt; ++ui;
#pragma unroll
        for (int h = 0; h < 2; ++h)
#pragma unroll
            for (int i = 0; i < 2; ++i) { vaC[h][i] = vaN[h][i]; vbC[h][i] = vbN[h][i]; }
    }
    PG8_WAIT_V(0);
    if (wr == 0) PG8_BAR;
    PG8_BAR;
#undef PG8_KBODY
#undef PG8_SA
#undef PG8_SB
#undef PG8_STAGE
#undef PG8_LDA
#undef PG8_LDB
#undef PG8_MMA
#undef PG8_MMA8
#undef PG8_LDA8
#undef PG8_LDB8
#undef PG8_LA
#undef PG8_LB
#undef PG8_MM
#undef PG8_MM_I
#undef PG8_MMA_I
#undef PG8_MMA8_I
#undef PG8_WAIT_V
#undef PG8_WAIT_L
#undef PG8_BAR
#undef PG8_SCHED
}

struct EpiBf16 {
    static constexpr bool PERM = true, FP8 = false; static constexpr int CM = 0;
    bf16_t* O; int ldc;
    DI void prefetch(const Unit&, unsigned, int) const {}
    DI void operator()(const f32x4 (&acc)[2][2][4][2], const Unit& u, int wr, int wc, int fr, int fq, const LAS unsigned char*) const {
        const int row0 = u.pm * BM + wr * 64 + fr, col0 = u.pn * BM + wc * 32 + 8 * fq;
#pragma unroll
        for (int ai = 0; ai < 2; ++ai)
#pragma unroll
            for (int m = 0; m < 4; ++m) { bf16_t* rowp = O + (size_t)(row0 + ai * HALF + m * 16) * ldc + col0;
#pragma unroll
                for (int bj = 0; bj < 2; ++bj) { const f32x4 v0 = acc[ai][bj][m][0], v1 = acc[ai][bj][m][1];
                    u32x4 w; w.x = cvt_pk_bf16(v0[0], v0[1]); w.y = cvt_pk_bf16(v0[2], v0[3]); w.z = cvt_pk_bf16(v1[0], v1[1]); w.w = cvt_pk_bf16(v1[2], v1[3]);
                    *(u32x4*)(rowp + bj * HALF) = w; } }
    }
};
template <bool SRCBF> struct EpiResid {
    static constexpr bool PERM = true, FP8 = false; static constexpr int CM = 0;
    const void* src0; const void* src1; bf16_t* dst; const float* gate;
    DI void prefetch(const Unit& u, unsigned prm, int wid) const {
        const int tile_row = u.pm * BM, sel = tile_row < TL ? tile_row / SEQ : 4;
        if (wid == 0) dma1k(gate, (unsigned)((sel * 6144 + u.pn * BM) * 4), prm + PRM_VEC);
    }
    DI void operator()(const f32x4 (&acc)[2][2][4][2], const Unit& u, int wr, int wc, int fr, int fq, const LAS unsigned char* prmp) const {
        const int row0 = u.pm * BM + wr * 64 + fr, cl0 = wc * 32 + 8 * fq, col0 = u.pn * BM + cl0;
        const int tile_row = u.pm * BM;
        const size_t soff = tile_row < TL ? (size_t)0 : (size_t)TL * DM;
        const void* sbase = tile_row < TL ? src0 : src1;
        f32x4 gv[2][2];
#pragma unroll
        for (int bj = 0; bj < 2; ++bj)
#pragma unroll
            for (int n = 0; n < 2; ++n) gv[bj][n] = *(const LAS f32x4*)(prmp + PRM_VEC + (cl0 + bj * HALF + 4 * n) * 4);
#pragma unroll
        for (int ai = 0; ai < 2; ++ai)
#pragma unroll
            for (int m = 0; m < 4; ++m) { const size_t ro = (size_t)(row0 + ai * HALF + m * 16) * DM + col0;
#pragma unroll
                for (int bj = 0; bj < 2; ++bj) { f32x4 x0, x1;
                    if constexpr (SRCBF) { const u32x4 q = *(const u32x4*)((const bf16_t*)sbase + (ro - soff) + bj * HALF);
                        x0 = (f32x4){lo2f(q.x), hi2f(q.x), lo2f(q.y), hi2f(q.y)}; x1 = (f32x4){lo2f(q.z), hi2f(q.z), lo2f(q.w), hi2f(q.w)}; }
                    else { const float* sp = (const float*)sbase + (ro - soff) + bj * HALF; x0 = *(const f32x4*)sp; x1 = *(const f32x4*)(sp + 4); }
                    const f32x4 r0 = x0 + gv[bj][0] * acc[ai][bj][m][0], r1 = x1 + gv[bj][1] * acc[ai][bj][m][1];
                    u32x4 w; w.x = cvt_pk_bf16(r0[0], r0[1]); w.y = cvt_pk_bf16(r0[2], r0[3]); w.z = cvt_pk_bf16(r1[0], r1[1]); w.w = cvt_pk_bf16(r1[2], r1[3]);
                    *(u32x4*)(dst + ro + bj * HALF) = w; } }
    }
};
DI float swiglu1(float glu, float lin) {
    glu = fminf(glu, 7.0f); lin = fminf(fmaxf(lin, -7.0f), 7.0f);
    return glu * __builtin_amdgcn_rcpf(1.0f + __builtin_amdgcn_exp2f(-1.702f * 1.44269504f * glu)) * (lin + 1.0f);
}
struct EpiSwiglu {
    static constexpr bool PERM = true, FP8 = true; static constexpr int CM = 0;
    unsigned char* H; const float* b1;
    DI void prefetch(const Unit& u, unsigned prm, int wid) const { if (wid == 0) dma1k(b1, (unsigned)((u.e * 2048 + u.pn * BM) * 4), prm + PRM_VEC); }
    DI void operator()(const f32x4 (&acc)[2][2][4][2], const Unit& u, int wr, int wc, int fr, int fq, const LAS unsigned char* prmp) const {
        const int row0 = u.slot0 + wr * 64 + fr, colh = u.pn * 128 + wc * 32 + 8 * fq;
        f32x4 bv[2][2];
#pragma unroll
        for (int bj = 0; bj < 2; ++bj)
#pragma unroll
            for (int n = 0; n < 2; ++n) bv[bj][n] = *(const LAS f32x4*)(prmp + PRM_VEC + (wc * 64 + 16 * fq + 8 * bj + 4 * n) * 4);
        constexpr float ds = 1.0f / Q8_W;
#pragma unroll
        for (int ai = 0; ai < 2; ++ai)
#pragma unroll
            for (int m = 0; m < 4; ++m) { unsigned char* rowp = H + (size_t)(row0 + ai * HALF + m * 16) * 1024 + colh;
                u32x2 w;
#pragma unroll
                for (int bj = 0; bj < 2; ++bj) { const f32x4 v0 = acc[ai][bj][m][0] * ds + bv[bj][0], v1 = acc[ai][bj][m][1] * ds + bv[bj][1];
                    const unsigned p = pack4_fp8(swiglu1(v0[0], v0[1]) * Q8_H, swiglu1(v0[2], v0[3]) * Q8_H, swiglu1(v1[0], v1[1]) * Q8_H, swiglu1(v1[2], v1[3]) * Q8_H);
                    if (bj == 0) w.x = p; else w.y = p; }
                *(u32x2*)rowp = w; }
    }
};
struct EpiMoeOut {
    static constexpr bool PERM = true, FP8 = true; static constexpr int CM = 2;
    unsigned char* Y; const float* b2; const int* list; const float* sgate;
    DI void prefetch(const Unit& u, unsigned prm, int wid) const {
        const unsigned lo = (unsigned)(((size_t)u.e * TT + u.pm * BM) * 4);
        if (wid == 0) dma1k(b2, (unsigned)((u.e * 1024 + u.pn * BM) * 4), prm + PRM_VEC);
        if (wid == 1) dma1k(list, lo, prm + PRM_AID);
        if (wid == 2) dma1k(sgate, lo, prm + PRM_GATE);
    }
    DI void operator()(const f32x4 (&acc)[2][2][4][2], const Unit& u, int wr, int wc, int fr, int fq, const LAS unsigned char* prmp) const {
        const int rl0 = wr * 64 + fr, cl0 = wc * 64 + 16 * fq;
        constexpr float ds = 1.0f / (Q8_W * Q8_H);
        f32x4 bv[2][2];
#pragma unroll
        for (int bj = 0; bj < 2; ++bj)
#pragma unroll
            for (int n = 0; n < 2; ++n) bv[bj][n] = *(const LAS f32x4*)(prmp + PRM_VEC + (cl0 + bj * 8 + 4 * n) * 4);
#pragma unroll
        for (int ai = 0; ai < 2; ++ai)
#pragma unroll
            for (int m = 0; m < 4; ++m) { const int rl = rl0 + ai * HALF + m * 16;
                if (rl < u.nvalid) {
                    const int aid = *(const LAS int*)(prmp + PRM_AID + rl * 4); const float gt = *(const LAS float*)(prmp + PRM_GATE + rl * 4) * Q8_Y;
                    u32x4 w;
#pragma unroll
                    for (int bj = 0; bj < 2; ++bj) { const f32x4 v0 = (acc[ai][bj][m][0] * ds + bv[bj][0]) * gt, v1 = (acc[ai][bj][m][1] * ds + bv[bj][1]) * gt;
                        const unsigned p0 = pack4_fp8(clamp8(v0[0]), clamp8(v0[1]), clamp8(v0[2]), clamp8(v0[3])), p1 = pack4_fp8(clamp8(v1[0]), clamp8(v1[1]), clamp8(v1[2]), clamp8(v1[3]));
                        if (bj == 0) { w.x = p0; w.y = p1; } else { w.z = p0; w.w = p1; } }
                    *(u32x4*)(Y + (size_t)aid * 1024 + u.pn * BM + cl0) = w; } }
    }
};
}
constexpr int TR_W1 = 0, TR_W2 = 8192, TR_WIN0 = 12288, TR_WOUT0 = 12576, TR_WIN1 = 12640, TR_WOUT1 = 12832, TR_SW2 = 12896, TR_SA2 = 12900, TR_SG2 = 12904, NTR = 12908;
constexpr int P0_MOD = NTR, P0_FIL = NTR + 384, P0_ROPE = P0_FIL + 256, P0_UNITS = P0_ROPE + 1;

struct TrJob { const float* src; bf16_t* dst; int K, N, Npad, kt, nt, q8; };
DI TrJob tr_job(const KArgs& a, int u) {
    TrJob j; unsigned char* ws = a.ws; j.q8 = 0;
    if (u < TR_W2) { const int m = u / 128, r = u % 128; j.src = KIN(a, 8) + (size_t)m * 1024 * 2048; j.dst = (bf16_t*)(ws + WS_W1T + (size_t)m * 2048 * 1024); j.q8 = 2; j.K = 1024; j.N = 2048; j.Npad = 2048; j.kt = r / 8; j.nt = r % 8; }
    else if (u < TR_WIN0) { const int v = u - TR_W2, m = v / 64, r = v % 64; j.src = KIN(a, 10) + (size_t)m * 1024 * 1024; j.dst = (bf16_t*)(ws + WS_W2TM + (size_t)m * 1024 * 1024); j.q8 = 1; j.K = 1024; j.N = 1024; j.Npad = 1024; j.kt = r / 4; j.nt = r % 4; }
    else if (u < TR_WOUT0) { const int r = u - TR_WIN0; j.src = KIN(a, 12); j.dst = (bf16_t*)(ws + WS_WIN0); j.K = 1024; j.N = ABCOLS; j.Npad = ABPAD; j.kt = r / 18; j.nt = r % 18; }
    else if (u < TR_WIN1) { const int r = u - TR_WOUT0; j.src = KIN(a, 13); j.dst = (bf16_t*)(ws + WS_WOUT0); j.K = 1024; j.N = 1024; j.Npad = 1024; j.kt = r / 4; j.nt = r % 4; }
    else if (u < TR_WOUT1) { const int r = u - TR_WIN1; j.src = KIN(a, 27); j.dst = (bf16_t*)(ws + WS_WIN1); j.K = 1024; j.N = CDCOLS; j.Npad = CDCOLS; j.kt = r / 12; j.nt = r % 12; }
    else if (u < TR_SW2) { const int r = u - TR_WOUT1; j.src = KIN(a, 28); j.dst = (bf16_t*)(ws + WS_WOUT1); j.K = 1024; j.N = 1024; j.Npad = 1024; j.kt = r / 4; j.nt = r % 4; }
    else if (u < TR_SA2) { const int r = u - TR_SW2, m = r / 2; j.src = KIN(a, 16) + (size_t)m * 64 * 512; j.dst = (bf16_t*)(ws + WS_W2T) + (size_t)m * 512 * 64; j.K = 64; j.N = 512; j.Npad = 512; j.kt = 0; j.nt = r % 2; }
    else if (u < TR_SG2) { const int r = u - TR_SA2, m = r / 2; j.src = KIN(a, 18) + (size_t)m * 64 * 512; j.dst = (bf16_t*)(ws + WS_A2T) + (size_t)m * 512 * 64; j.K = 64; j.N = 512; j.Npad = 512; j.kt = 0; j.nt = r % 2; }
    else { const int r = u - TR_SG2; j.src = KIN(a, 19); j.dst = (bf16_t*)(ws + WS_G2T); j.K = 128; j.N = 512; j.Npad = 512; j.kt = r / 2; j.nt = r % 2; }
    return j;
}
DI void tr_load(const TrJob& j, int tid, f32x4 (&v)[8]) {
    const int c4 = tid & 63, r0 = tid >> 6, n = j.nt * 256 + c4 * 4;
#pragma unroll
    for (int p = 0; p < 8; ++p) {
        const int k = j.kt * 64 + p * 8 + r0;
        v[p] = (n < j.N) ? *(const f32x4*)(j.src + (size_t)k * j.N + n) : (f32x4){0.f, 0.f, 0.f, 0.f};
    }
}
DI void tr_step(LAS float* sT, const KArgs& a, TrJob& j, f32x4 (&v)[8], int tid, int un, int uend) {
    const int c4 = tid & 63, r0 = tid >> 6;
#pragma unroll
    for (int p = 0; p < 8; ++p) { LAS float* d = sT + (p * 8 + r0) * 257 + c4 * 4; d[0] = v[p][0]; d[1] = v[p][1]; d[2] = v[p][2]; d[3] = v[p][3]; }
    __syncthreads();
    const TrJob jo = j;
    if (un < uend) { j = tr_job(a, un); tr_load(j, tid, v); }
    const int k8 = tid & 7;
#pragma unroll
    for (int q = 0; q < 4; ++q) {
        const int nl = q * 64 + (tid >> 3), n = jo.nt * 256 + nl;
        float x[8];
#pragma unroll
        for (int e = 0; e < 8; ++e) x[e] = sT[(k8 * 8 + e) * 257 + nl];
        if (jo.q8) {
            const int g = jo.q8 == 2 ? ((((nl >> 3) & 1) << 7) | (((nl >> 6) & 3) << 5) | (((nl >> 4) & 3) << 3) | (nl & 7)) : nl;
            u32x2 w; w.x = pack4_fp8(clamp8(x[0] * Q8_W), clamp8(x[1] * Q8_W), clamp8(x[2] * Q8_W), clamp8(x[3] * Q8_W)); w.y = pack4_fp8(clamp8(x[4] * Q8_W), clamp8(x[5] * Q8_W), clamp8(x[6] * Q8_W), clamp8(x[7] * Q8_W));
            *(u32x2*)((unsigned char*)jo.dst + (size_t)(jo.nt * 256 + g) * 1024 + jo.kt * 64 + k8 * 8) = w;
        } else if (n < jo.Npad) { u32x4 w; w.x = pack2(x[0], x[1]); w.y = pack2(x[2], x[3]); w.z = pack2(x[4], x[5]); w.w = pack2(x[6], x[7]);
            *(u32x4*)(jo.dst + (size_t)n * jo.K + jo.kt * 64 + k8 * 8) = w; }
    }
    __syncthreads();
}
struct Tr8Job { const float* src; unsigned char* dst; int N, kt, nt, w1; };
DI Tr8Job tr8_job(const KArgs& a, int u) {
    Tr8Job j; unsigned char* ws = a.ws;
    if (u < TR_W2) { const int m = u / 128, r = u % 128; j.src = KIN(a, 8) + (size_t)m * 1024 * 2048; j.dst = ws + WS_W1T + (size_t)m * 2048 * 1024; j.N = 2048; j.kt = r / 16; j.nt = r % 16; j.w1 = 1; }
    else { const int v = u - TR_W2, m = v / 64, r = v % 64; j.src = KIN(a, 10) + (size_t)m * 1024 * 1024; j.dst = ws + WS_W2TM + (size_t)m * 1024 * 1024; j.N = 1024; j.kt = r / 8; j.nt = r % 8; j.w1 = 0; }
    return j;
}
DI void tr8_load(const Tr8Job& j, int tid, f32x4 (&v)[8]) {
    const int c4 = tid & 31, r0 = tid >> 5;
    const float* p = j.src + (size_t)(j.kt * 128 + r0 * 8) * j.N + j.nt * 128 + c4 * 4;
#pragma unroll
    for (int q = 0; q < 8; ++q) v[q] = *(const f32x4*)(p + (size_t)q * j.N);
}
DI void tr8_step(LAS unsigned char* img, const KArgs& a, Tr8Job& j, f32x4 (&v)[8], int tid, int un, int uend) {
    const int c4 = tid & 31, r0 = tid >> 5;
#pragma unroll
    for (int e = 0; e < 4; ++e) { const int n = c4 * 4 + e;
        u32x2 w; w.x = pack4_fp8(clamp8(v[0][e] * Q8_W), clamp8(v[1][e] * Q8_W), clamp8(v[2][e] * Q8_W), clamp8(v[3][e] * Q8_W)); w.y = pack4_fp8(clamp8(v[4][e] * Q8_W), clamp8(v[5][e] * Q8_W), clamp8(v[6][e] * Q8_W), clamp8(v[7][e] * Q8_W));
        *(LAS u32x2*)(img + n * 128 + ((r0 ^ (c4 & 15)) * 8)) = w; }
    __syncthreads();
    const Tr8Job jo = j;
    if (un < uend) { j = tr8_job(a, un); tr8_load(j, tid, v); }
#pragma unroll
    for (int q = 0; q < 2; ++q) { const int idx = tid + q * NTHR, n = idx >> 3, g = idx & 7, s = (n >> 2) & 15;
        u32x4 w = *(const LAS u32x4*)(img + n * 128 + ((g ^ (s >> 1)) * 16));
        if (s & 1) { const unsigned t0 = w.x, t1 = w.y; w.x = w.z; w.y = w.w; w.z = t0; w.w = t1; }
        const int nn = jo.nt * 128 + n;
        const int nl = nn & 255, row = jo.w1 ? ((nn & ~255) | (((nl >> 3) & 1) << 7) | (((nl >> 6) & 3) << 5) | (((nl >> 4) & 3) << 3) | (nl & 7)) : nn;
        *(u32x4*)(jo.dst + (size_t)row * 1024 + jo.kt * 128 + g * 16) = w; }
}
DI void tr8_range(LAS unsigned char* lds, const KArgs& a, int tid, int u0, int uend, int stride) {
    int u = u0, par = 0; f32x4 vA[8], vB[8]; Tr8Job jA{}, jB{};
    if (u < uend) { jA = tr8_job(a, u); tr8_load(jA, tid, vA); }
    if (u + stride < uend) { jB = tr8_job(a, u + stride); tr8_load(jB, tid, vB); }
    while (u < uend) {
        tr8_step(lds + par * 16384, a, jA, vA, tid, u + 2 * stride, uend); par ^= 1;
        u += stride; if (u >= uend) break;
        tr8_step(lds + par * 16384, a, jB, vB, tid, u + 2 * stride, uend); par ^= 1;
        u += stride;
    }
    __syncthreads();
}
DI void tr_range(LAS float* sT, const KArgs& a, int tid, int u0, int uend, int stride) {
    int u = u0; f32x4 vA[8], vB[8]; TrJob jA{}, jB{};
    if (u < uend) { jA = tr_job(a, u); tr_load(jA, tid, vA); }
    if (u + stride < uend) { jB = tr_job(a, u + stride); tr_load(jB, tid, vB); }
    while (u < uend) {
        tr_step(sT, a, jA, vA, tid, u + 2 * stride, uend);
        u += stride; if (u >= uend) break;
        tr_step(sT, a, jB, vB, tid, u + 2 * stride, uend);
        u += stride;
    }
}
DI void p0_prologue(const Frame& F, const KArgs& a) {
    LAS float* sT = (LAS float*)F.lds;
    const int tid = F.tid;
    tr8_range(F.lds, a, tid, F.bid, TR_WIN0, F.G);
    tr_range(sT, a, tid, TR_WIN0 + F.bid, NTR, F.G);
    {
        LAS float* sc = (LAS float*)F.lds;
        LAS float* red = sc + 5 * 1024;
        bool staged = false;
        for (int u = P0_MOD + F.bid; u < P0_FIL; u += F.G) {
            if (!staged) {
                for (int i = tid; i < 5 * 1024; i += NTHR) { const float cv = (i < 4096) ? KIN(a, 1)[i] : KIN(a, 3)[i - 4096]; sc[i] = siluf_(cv); }
                staged = true; __syncthreads();
            }
            const int v = u - P0_MOD, l = v / 192, n0 = (v % 192) * 32;
            const int cg = tid & 7, ks = tid >> 3;
            const float* W = KIN(a, 4) + (size_t)l * 1024 * 6144 + n0 + cg * 4;
            f32x4 wv4[16];
#pragma unroll
            for (int kk = 0; kk < 16; ++kk) wv4[kk] = *(const f32x4*)(W + (size_t)(kk * 64 + ks) * 6144);
            f32x4 acc[5];
#pragma unroll
            for (int b = 0; b < 5; ++b) acc[b] = (f32x4){0.f, 0.f, 0.f, 0.f};
#pragma unroll
            for (int kk = 0; kk < 16; ++kk)
#pragma unroll
                for (int b = 0; b < 5; ++b) acc[b] += wv4[kk] * sc[b * 1024 + kk * 64 + ks];
#pragma unroll
            for (int b = 0; b < 5; ++b) *(LAS f32x4*)(red + (ks * 5 + b) * 32 + cg * 4) = acc[b];
            __syncthreads();
            if (tid < 160) { const int b = tid >> 5, c = tid & 31; float s = KIN(a, 5)[(size_t)l * 6144 + n0 + c];
#pragma unroll 8
                for (int k2 = 0; k2 < 64; ++k2) s += red[(k2 * 5 + b) * 32 + c];
                ((float*)(a.ws + WS_MOD))[((size_t)l * 5 + b) * 6144 + n0 + c] = s; }
            __syncthreads();
        }
    }
    {
        LAS float* z = (LAS float*)F.lds;
        LAS float* h1 = z + 32 * 36;
        LAS float* h2T = h1 + 32 * 64;
        LAS float* w1s = h2T + 64 * 32;
        LAS float* w2s = w1s + 33 * 64;
        const float* w1 = KIN(a, 33); const float* b1 = KIN(a, 34); const float* fr1 = KIN(a, 35);
        const float* w2 = KIN(a, 36); const float* b2 = KIN(a, 37); const float* fr2 = KIN(a, 38); const float* w3 = KIN(a, 39);
        bool wst = false;
        for (int u = P0_FIL + F.bid; u < P0_ROPE; u += F.G) {
            const int p0 = (u - P0_FIL) * 32;
            if (!wst) { for (int i = tid; i < 33 * 64; i += NTHR) w1s[i] = w1[i];
                for (int i = tid; i < 64 * 64; i += NTHR) w2s[i] = w2[i];
                wst = true; }
            { const int p = tid >> 4, f = tid & 15; const int pos = p0 + p;
              const float freq = 1e-4f + (float)f * ((15.0f - 1e-4f) / 15.0f);
              const float ang = (6.283185307179586f / 8192.0f) * (float)pos * freq;
              float sn, cs; __sincosf(ang, &sn, &cs);
              z[p * 36 + 1 + f] = cs; z[p * 36 + 17 + f] = -sn;
              if (f == 0) z[p * 36] = (float)pos * (1.0f / 8191.0f); }
            __syncthreads();
#pragma unroll
            for (int q = 0; q < 4; ++q) { const int o = tid + q * NTHR, p = o >> 6, jn = o & 63; float s = b1[jn];
#pragma unroll
                for (int i = 0; i < 33; ++i) s += z[p * 36 + i] * w1s[i * 64 + jn];
                h1[p * 64 + jn] = __sinf(fr1[jn] * s); }
            __syncthreads();
#pragma unroll
            for (int q = 0; q < 4; ++q) { const int o = tid + q * NTHR, p = o >> 6, jn = o & 63; float s = b2[jn];
#pragma unroll
                for (int i = 0; i < 64; ++i) s += h1[p * 64 + i] * w2s[i * 64 + jn];
                h2T[jn * 32 + p] = __sinf(fr2[jn] * s); }
            __syncthreads();
#pragma unroll 1
            for (int q = 0; q < 4; ++q) {
                const int n = tid + q * NTHR;
                f32x4 acc[8];
#pragma unroll
                for (int p = 0; p < 8; ++p) acc[p] = (f32x4){0.f, 0.f, 0.f, 0.f};
#pragma unroll 1
                for (int i0 = 0; i0 < 64; i0 += 16) { float w[16];
#pragma unroll
                    for (int i = 0; i < 16; ++i) w[i] = w3[(i0 + i) * 2048 + n];
#pragma unroll
                    for (int i = 0; i < 16; ++i)
#pragma unroll
                        for (int p4 = 0; p4 < 8; ++p4) { const f32x4 hv = *(const LAS f32x4*)(h2T + (i0 + i) * 32 + p4 * 4); acc[p4] += hv * w[i]; } }
                const int c = n & 511;
                const float dlo = -3.0701134573253946f, dhi = -15.350567286626973f;
                const float delta = fabsf(dlo + (dhi - dlo) * ((float)c / 511.0f));
                float* dst = (float*)(a.ws + WS_HYF) + (size_t)n * 8192 + p0;
#pragma unroll
                for (int p4 = 0; p4 < 8; ++p4) { f32x4 o4;
#pragma unroll
                    for (int e = 0; e < 4; ++e) { const float tn = (float)(p0 + p4 * 4 + e) * (1.0f / 8191.0f); o4[e] = acc[p4][e] * __expf(-tn * delta); }
                    *(f32x4*)(dst + p4 * 4) = o4; }
            }
            __syncthreads();
        }
    }
    for (int u = P0_ROPE + F.bid; u < P0_UNITS; u += F.G) {
        for (int i = tid; i < 2048; i += NTHR) { const int pos = i >> 4, k = i & 15; const float inv = powf(10000.0f, -(float)k / 16.0f);
            float sn, cs; sincosf((float)pos * inv, &sn, &cs); ((f32x2*)(a.ws + WS_ROPE))[i] = (f32x2){cs, sn}; }
    }
}

DI void row_load16_bf(const bf16_t* src, int lane, f32x4 (&v)[4]) {
#pragma unroll
    for (int i = 0; i < 4; ++i) { const u32x2 q = *(const u32x2*)(src + i * 256 + lane * 4); v[i] = (f32x4){lo2f(q.x), hi2f(q.x), lo2f(q.y), hi2f(q.y)}; }
}
DI void row_load16(const float* src, int lane, f32x4 (&v)[4]) {
#pragma unroll
    for (int i = 0; i < 4; ++i) v[i] = *(const f32x4*)(src + i * 256 + lane * 4);
}
DI void row_modulate(f32x4 (&v)[4], const float* sh, const float* scl, int lane) {
    float ss = 0.f;
#pragma unroll
    for (int i = 0; i < 4; ++i) ss += v[i][0] * v[i][0] + v[i][1] * v[i][1] + v[i][2] * v[i][2] + v[i][3] * v[i][3];
    ss = wave_sum(ss);
    const float inv = rsqrtf(ss * (1.0f / 1024.0f) + 1e-6f);
#pragma unroll
    for (int i = 0; i < 4; ++i) { const f32x4 s4 = *(const f32x4*)(sh + i * 256 + lane * 4), c4 = *(const f32x4*)(scl + i * 256 + lane * 4);
        v[i] = v[i] * inv * (c4 + 1.0f) + s4; }
}
DI void row_store_bf16(bf16_t* dst, int lane, const f32x4 (&v)[4]) {
#pragma unroll
    for (int i = 0; i < 4; ++i) { u32x2 w; w.x = pack2(v[i][0], v[i][1]); w.y = pack2(v[i][2], v[i][3]); *(u32x2*)(dst + i * 256 + lane * 4) = w; }
}
DI int row_sel(int row) { return row < TL ? row / SEQ : 4; }
DI void p_modulate_in(const Frame& F, const KArgs& a) {
    const float* mod = (const float*)(a.ws + WS_MOD);
    bf16_t* hA = (bf16_t*)(a.ws + WS_HA);
    for (int row = F.bid * 8 + F.wave; row < TT; row += F.G * 8) {
        const float* src = row < TL ? KIN(a, 0) + (size_t)row * DM : KIN(a, 2) + (size_t)(row - TL) * DM;
        f32x4 v[4]; row_load16(src, F.lane, v);
        const float* m = mod + (size_t)row_sel(row) * 6144;
        row_modulate(v, m, m + 1024, F.lane);
        row_store_bf16(hA + (size_t)row * DM, F.lane, v);
    }
}
constexpr int ST_TOK = 32, ST_UNITS = TL / 32 + TC / 16, APITCH = 136, NSTEP = CL + SEQ;
constexpr int NCHUNK = NSTEP / 16, CBR = 12288, CBH = 7168;
constexpr size_t RW_OFF = 0, RW_BYTES = (size_t)64 * NCHUNK * CBR, HG_OFF = RW_OFF + RW_BYTES, HG_BYTES = (size_t)64 * NCHUNK * CBH, G_OFF = HG_OFF + HG_BYTES,
                 VTOK_OFF = G_OFF + (size_t)TT * 512 * 2, CBON_OFF = VTOK_OFF + (size_t)TT * 512 * 2;
static_assert(CBON_OFF + (size_t)2 * TT * 8 * 4 <= R1_BYTES, "layer-0 streams fit region 1");
DI size_t hg_elem(int chain, int s) { return ((size_t)chain * NCHUNK + (s >> 4)) * (CBH / 2) + (s & 15) * 192; }
DI float fast_rcp(float x) { return __builtin_amdgcn_rcpf(x); }
DI float fsigmoid(float x) { return fast_rcp(1.0f + __expf(-x)); }
DI float fsilu(float x) { return x * fast_rcp(1.0f + __expf(-x)); }
DI float ftanh(float x) { return 1.0f - 2.0f * fast_rcp(1.0f + __expf(2.0f * x)); }
DI int step_of(int row, int d) {
    if (row < TL) { const int t = row & (SEQ - 1); return CL + (d ? SEQ - 1 - t : t); }
    const int t = (row - TL) & (CL - 1); return d ? CL - 1 - t : t;
}
DI int batch_of(int row) { return row < TL ? row / SEQ : (row - TL) / CL; }
DI int scan_row(int b, int d, int s) {
    if (s < CL) return TL + b * CL + (d ? CL - 1 - s : s);
    const int t = s - CL; return b * SEQ + (d ? SEQ - 1 - t : t);
}
DI void p_streams(const Frame& F, const KArgs& a) {
    const bf16_t* U = (const bf16_t*)(a.ws + WS_U);
    bf16_t* RW = (bf16_t*)(a.ws + WS_R1 + RW_OFF); bf16_t* HG = (bf16_t*)(a.ws + WS_R1 + HG_OFF); bf16_t* G = (bf16_t*)(a.ws + WS_R1 + G_OFF); bf16_t* VTOK = (bf16_t*)(a.ws + WS_R1 + VTOK_OFF);
    LAS bf16_t* Ks  = (LAS bf16_t*)F.lds;
    LAS bf16_t* KKs = Ks + 32 * 512;
    LAS bf16_t* Alw = KKs + 32 * 512;
    LAS bf16_t* Aad = Alw + 32 * APITCH;
    LAS bf16_t* Asg = Aad + 32 * APITCH;
    const float* shiftw = KIN(a, 14);
    const bf16_t* w2t = (const bf16_t*)(a.ws + WS_W2T);
    const bf16_t* a2t = (const bf16_t*)(a.ws + WS_A2T);
    const bf16_t* g2t = (const bf16_t*)(a.ws + WS_G2T);
    const float* w0p = KIN(a, 15); const float* a0p = KIN(a, 17); const float* kap = KIN(a, 21); const float* kkp = KIN(a, 20); const float* lbl = KIN(a, 25);
    const int tid = F.tid, lane = F.lane, wv = F.wave;
    for (int u = F.bid; u < ST_UNITS; u += F.G) {
        const int row0 = u < TL / 32 ? u * 32 : TL + (u - TL / 32) * 16, ntok = u < TL / 32 ? 32 : 16;
        const int seq_start = row0 < TL ? (row0 / SEQ) * SEQ : TL + ((row0 - TL) / CL) * CL;
        const int seq_end = row0 < TL ? seq_start + SEQ : seq_start + CL;
        const int bb = batch_of(row0);
        const int s0f = step_of(row0, 0), s0b = step_of(row0, 1);
        if (tid < 480) {
            const int col = tid * 4;
            float t0[4], t1[4], t2[4];
#pragma unroll
            for (int e = 0; e < 4; ++e) { t0[e] = shiftw[col + e]; t1[e] = shiftw[1920 + col + e]; t2[e] = shiftw[3840 + col + e]; }
            float kk_k[4] = {0.f, 0.f, 0.f, 0.f};
            if (col >= 512 && col < 1024) {
#pragma unroll
                for (int e = 0; e < 4; ++e) kk_k[e] = kkp[col - 512 + e];
            }
            const int vsel = col < 512 ? 0 : (col < 1024 ? 2 : 1), hcol = col & 511, hh = hcol >> 6, hc = hcol & 63;
            bf16_t* dF = RW + ((size_t)((bb * 8 + hh) * 2 + 0) * NSTEP + s0f) * 384 + vsel * 64 + hc;
            bf16_t* dB = RW + ((size_t)((bb * 8 + hh) * 2 + 1) * NSTEP + s0b) * 384 + vsel * 64 + hc;
            const u32x2 zero2 = (u32x2){0u, 0u};
#pragma unroll 1
            for (int hf = 0; hf < ntok / 16; ++hf) {
            u32x2 rws[18];
#pragma unroll
            for (int i = 0; i < 18; ++i) { const int rr_ = row0 + hf * 16 - 1 + i; rws[i] = (rr_ >= seq_start && rr_ < seq_end) ? *(const u32x2*)(U + (size_t)rr_ * ABPAD + col) : zero2; }
#pragma unroll
            for (int tt = 0; tt < 16; ++tt) {
                const int t = hf * 16 + tt, row = row0 + t;
                const u32x2 prv = rws[tt], cur = rws[tt + 1], nxt = rws[tt + 2];
                float x[4];
                x[0] = lo2f(prv.x) * t0[0] + lo2f(cur.x) * t1[0] + lo2f(nxt.x) * t2[0];
                x[1] = hi2f(prv.x) * t0[1] + hi2f(cur.x) * t1[1] + hi2f(nxt.x) * t2[1];
                x[2] = lo2f(prv.y) * t0[2] + lo2f(cur.y) * t1[2] + lo2f(nxt.y) * t2[2];
                x[3] = hi2f(prv.y) * t0[3] + hi2f(cur.y) * t1[3] + hi2f(nxt.y) * t2[3];
                if (col < 512 || (col >= 1024 && col < 1536)) {
                    u32x2 w; w.x = pack2(x[0], x[1]); w.y = pack2(x[2], x[3]);
                    *(u32x2*)(dF + (size_t)t * 384) = w; *(u32x2*)(dB - (size_t)t * 384) = w;
                    if (col >= 1024) *(u32x2*)(VTOK + (size_t)row * 512 + (col - 1024)) = w;
                } else if (col < 1024) {
                    const int kc = col - 512;
                    u32x2 w; w.x = pack2(x[0], x[1]); w.y = pack2(x[2], x[3]);
                    *(LAS u32x2*)(Ks + t * 512 + kc) = w;
                    float q[4]; float ss = 0.f;
#pragma unroll
                    for (int e = 0; e < 4; ++e) { q[e] = x[e] * kk_k[e]; ss += q[e] * q[e]; }
                    ss = rowsum16(ss);
                    const float inv = 1.0f / fmaxf(sqrtf(ss), 1e-12f);
                    u32x2 w2; w2.x = pack2(q[0] * inv, q[1] * inv); w2.y = pack2(q[2] * inv, q[3] * inv);
                    *(LAS u32x2*)(KKs + t * 512 + kc) = w2;
                    *(u32x2*)(dF + (size_t)t * 384) = w2; *(u32x2*)(dB - (size_t)t * 384) = w2;
                } else if (col < 1664) {
                    u32x2 w; w.x = pack2(ftanh(x[0]), ftanh(x[1])); w.y = pack2(ftanh(x[2]), ftanh(x[3]));
                    *(LAS u32x2*)(Alw + t * APITCH + (col - 1536)) = w;
                } else if (col < 1792) {
                    u32x2 w; w.x = pack2(x[0], x[1]); w.y = pack2(x[2], x[3]);
                    *(LAS u32x2*)(Aad + t * APITCH + (col - 1664)) = w;
                } else {
                    u32x2 w; w.x = pack2(fsigmoid(x[0]), fsigmoid(x[1])); w.y = pack2(fsigmoid(x[2]), fsigmoid(x[3]));
                    *(LAS u32x2*)(Asg + t * APITCH + (col - 1792)) = w;
                }
            }
            }
        }
        {
#pragma unroll 4
            for (int it = 0; it < ntok / 2; ++it) {
                const int idx = tid + it * NTHR, t = idx >> 8, rem = idx & 255, vec = rem >> 6, pc = rem & 63, hh = pc >> 3, hc = (pc & 7) * 8;
                float x[8]; load8bf(U + (size_t)(row0 + t) * ABPAD + ACOLS + vec * 512 + pc * 8, x);
                bf16_t* cF = HG + hg_elem((bb * 8 + hh) * 2 + 0, s0f + t) + hc;
                bf16_t* cB = HG + hg_elem((bb * 8 + hh) * 2 + 1, s0b - t) + hc;
                if (vec == 0) {
#pragma unroll
                    for (int e = 0; e < 8; ++e) x[e] = fsilu(x[e]);
                    store8bf(cF, x); store8bf(cB, x);
                } else if (vec == 3) { store8bf(cF + 128, x); store8bf(cB + 128, x); }
                else {
                    float l0[8], l1[8]; load8f(lbl + pc * 8, l0); load8f(lbl + 512 + pc * 8, l1);
#pragma unroll
                    for (int e = 0; e < 8; ++e) { const float lb = fast_rcp(1.0f + __expf(l1[e] - l0[e])); x[e] = (1.0f - lb) * (1.0f - fsigmoid(x[e])); }
                    store8bf((vec == 1 ? cF : cB) + 64, x);
                }
            }
        }
        __syncthreads();
        {
            const int fr = lane & 15, fq = lane >> 4;
            bf16_t* eF = RW + ((size_t)((bb * 8 + wv) * 2 + 0) * NSTEP + s0f) * 384;
            bf16_t* eB = RW + ((size_t)((bb * 8 + wv) * 2 + 1) * NSTEP + s0b) * 384;
#pragma unroll 1
            for (int nt = 0; nt < 2; ++nt) {
                const int cb = wv * 64 + nt * 32;
                f32x4 accW[2][2][2], accA[2][2][2], accG[2][2];
#pragma unroll
                for (int m = 0; m < 2; ++m)
#pragma unroll
                    for (int n = 0; n < 2; ++n) { accG[m][n] = (f32x4){0.f, 0.f, 0.f, 0.f};
#pragma unroll
                        for (int d = 0; d < 2; ++d) { accW[d][m][n] = (f32x4){0.f, 0.f, 0.f, 0.f}; accA[d][m][n] = (f32x4){0.f, 0.f, 0.f, 0.f}; } }
#pragma unroll
                for (int n = 0; n < 2; ++n) {
                    const int c = cb + 8 * (fr >> 2) + 4 * n + (fr & 3);
#pragma unroll
                    for (int d = 0; d < 2; ++d)
#pragma unroll
                        for (int ks = 0; ks < 2; ++ks) {
                            const bf16x8 bw = *(const bf16x8*)(w2t + ((size_t)d * 512 + c) * 64 + ks * 32 + fq * 8);
                            const bf16x8 ba = *(const bf16x8*)(a2t + ((size_t)d * 512 + c) * 64 + ks * 32 + fq * 8);
#pragma unroll
                            for (int m = 0; m < 2; ++m) {
                                const bf16x8 aw = *(const LAS bf16x8*)(Alw + (m * 16 + fr) * APITCH + d * 64 + ks * 32 + fq * 8);
                                const bf16x8 aa = *(const LAS bf16x8*)(Aad + (m * 16 + fr) * APITCH + d * 64 + ks * 32 + fq * 8);
                                accW[d][m][n] = __builtin_amdgcn_mfma_f32_16x16x32_bf16(bw, aw, accW[d][m][n], 0, 0, 0);
                                accA[d][m][n] = __builtin_amdgcn_mfma_f32_16x16x32_bf16(ba, aa, accA[d][m][n], 0, 0, 0);
                            }
                        }
#pragma unroll
                    for (int ks = 0; ks < 4; ++ks) {
                        const bf16x8 bg = *(const bf16x8*)(g2t + (size_t)c * 128 + ks * 32 + fq * 8);
#pragma unroll
                        for (int m = 0; m < 2; ++m) {
                            const bf16x8 ag = *(const LAS bf16x8*)(Asg + (m * 16 + fr) * APITCH + ks * 32 + fq * 8);
                            accG[m][n] = __builtin_amdgcn_mfma_f32_16x16x32_bf16(bg, ag, accG[m][n], 0, 0, 0);
                        }
                    }
                }
                const int c8 = cb + fq * 8, hc8 = nt * 32 + fq * 8;
                f32x4 ka[2];
#pragma unroll
                for (int n = 0; n < 2; ++n) ka[n] = *(const f32x4*)(kap + c8 + 4 * n);
#pragma unroll
                for (int m = 0; m < 2; ++m) {
                    __builtin_amdgcn_sched_barrier(0);
                    const int tt = m * 16 + fr;
                    if (tt >= ntok) continue;
                    const u32x4 kw = *(const LAS u32x4*)(Ks + tt * 512 + c8), kkw = *(const LAS u32x4*)(KKs + tt * 512 + c8);
                    float kv[8], kkv[8];
                    kv[0] = lo2f(kw.x); kv[1] = hi2f(kw.x); kv[2] = lo2f(kw.y); kv[3] = hi2f(kw.y); kv[4] = lo2f(kw.z); kv[5] = hi2f(kw.z); kv[6] = lo2f(kw.w); kv[7] = hi2f(kw.w);
                    kkv[0] = lo2f(kkw.x); kkv[1] = hi2f(kkw.x); kkv[2] = lo2f(kkw.y); kkv[3] = hi2f(kkw.y); kkv[4] = lo2f(kkw.z); kkv[5] = hi2f(kkw.z); kkv[6] = lo2f(kkw.w); kkv[7] = hi2f(kkw.w);
#pragma unroll
                    for (int d = 0; d < 2; ++d) {
                        float mm[8], bq[8], kq[8];
                        f32x4 w0d[2], a0d[2];
#pragma unroll
                        for (int n = 0; n < 2; ++n) { w0d[n] = *(const f32x4*)(w0p + d * 512 + c8 + 4 * n); a0d[n] = *(const f32x4*)(a0p + d * 512 + c8 + 4 * n); }
#pragma unroll
                        for (int n = 0; n < 2; ++n)
#pragma unroll
                            for (int j = 0; j < 4; ++j) { const int e = n * 4 + j;
                                const float xw = -(w0d[n][j] + accW[d][m][n][j]);
                                const float sp = xw > 20.f ? xw : __logf(1.0f + __expf(xw));
                                mm[e] = 1.0f - __expf(-__expf(-sp - 0.5f));
                                const float av = fsigmoid(a0d[n][j] + accA[d][m][n][j]);
                                bq[e] = kkv[e] * av; kq[e] = kv[e] * (1.0f + (av - 1.0f) * ka[n][j]); }
                        bf16_t* dp = (d ? eB - (size_t)tt * 384 : eF + (size_t)tt * 384) + hc8;
                        store8bf(dp + 192, mm); store8bf(dp + 256, bq); store8bf(dp + 320, kq);
                    }
                    { float gg8[8];
#pragma unroll
                      for (int n = 0; n < 2; ++n)
#pragma unroll
                          for (int j = 0; j < 4; ++j) gg8[n * 4 + j] = accG[m][n][j];
                      store8bf(G + (size_t)(row0 + tt) * 512 + c8, gg8); }
                }
            }
        }
        __syncthreads();
    }
}
constexpr int RB_KT = 0, RB_RT = 2048, RB_KO = 4096, RB_BO = 6144, RB_VT = 8192, RB_NKT = 10240, RB_MK = 10752, RB_MB = 11264, RB_G = 11776;
constexpr int HB_QT = 0, HB_KO = 2048, HB_VT = 4096, HB_MK = 6144, HB_G = 6656;
constexpr int GP = 72;
DI int kperm(int k) { const int kk = k & 31, hi = kk >> 4, q = (kk & 15) >> 2, e = kk & 3; return (k & 32) + q * 8 + hi * 4 + e; }
DI f32x4 gram16(const LAS bf16_t* X, const LAS bf16_t* Y, int fr, int fq) {
    f32x4 acc = (f32x4){0.f, 0.f, 0.f, 0.f};
#pragma unroll
    for (int ks = 0; ks < 2; ++ks) { const bf16x8 af = *(const LAS bf16x8*)(X + fr * GP + ks * 32 + fq * 8), bfr = *(const LAS bf16x8*)(Y + fr * GP + ks * 32 + fq * 8);
        acc = __builtin_amdgcn_mfma_f32_16x16x32_bf16(af, bfr, acc, 0, 0, 0); }
    return acc;
}
DI void store16bf(bf16_t* p, const float (&x)[16]) {
    u32x4 w0, w1; w0.x = pack2(x[0], x[1]); w0.y = pack2(x[2], x[3]); w0.z = pack2(x[4], x[5]); w0.w = pack2(x[6], x[7]);
    w1.x = pack2(x[8], x[9]); w1.y = pack2(x[10], x[11]); w1.z = pack2(x[12], x[13]); w1.w = pack2(x[14], x[15]);
    *(u32x4*)p = w0; *(u32x4*)(p + 8) = w1;
}
DI void tri_solve16(float (&x)[16], const LAS float* NBc) {
#pragma unroll
    for (int tp = 1; tp < 16; ++tp) {
        float acc = x[tp];
#pragma unroll
        for (int t4 = 0; t4 < (tp + 3) / 4; ++t4) { const f32x4 nb = *(const LAS f32x4*)(NBc + tp * 16 + t4 * 4);
#pragma unroll
            for (int e = 0; e < 4; ++e) if (t4 * 4 + e < tp) acc -= x[t4 * 4 + e] * nb[e]; }
        x[tp] = acc;
    }
}
DI void p_prep(const Frame& F, const KArgs& a) {
    unsigned char* RWB = a.ws + WS_R1 + RW_OFF; unsigned char* HGB = a.ws + WS_R1 + HG_OFF;
    float* CBON = (float*)(a.ws + WS_R1 + CBON_OFF);
    const float* rkp = KIN(a, 22);
    const int lane = F.lane, wv = F.wave, fr = lane & 15, fq = lane >> 4;
    LAS unsigned char* wl = F.lds + wv * 16384;
    LAS bf16_t* M0 = (LAS bf16_t*)wl; LAS bf16_t* M1 = M0 + 16 * GP; LAS bf16_t* M2 = M1 + 16 * GP; LAS bf16_t* M3 = M2 + 16 * GP;
    LAS float* NBc = (LAS float*)(wl + 9216); LAS float* NKr = NBc + 256;
    const int pk = kperm(lane);
    const int NU = 64 * NCHUNK;
    LAS unsigned char* rawl = wl;
    const int ustep = F.G * 8;
    u32x4 nx[12];
    int u = F.bid * 8 + wv;
    if (u < 2 * NU) { const unsigned char* bp = u < NU ? RWB + (size_t)u * CBR : HGB + (size_t)(u - NU) * CBH; const int np = u < NU ? 12 : 7;
#pragma unroll
        for (int i = 0; i < 12; ++i) if (i < np) nx[i] = *(const u32x4*)(bp + i * 1024 + lane * 16); }
    for (; u < 2 * NU; u += ustep) {
        { const int np = u < NU ? 12 : 7;
#pragma unroll
          for (int i = 0; i < 12; ++i) if (i < np) *(LAS u32x4*)(rawl + i * 1024 + lane * 16) = nx[i]; }
        { const int un = u + ustep;
          if (un < 2 * NU) { const unsigned char* bp = un < NU ? RWB + (size_t)un * CBR : HGB + (size_t)(un - NU) * CBH; const int np = un < NU ? 12 : 7;
#pragma unroll
              for (int i = 0; i < 12; ++i) if (i < np) nx[i] = *(const u32x4*)(bp + i * 1024 + lane * 16); } }
        asm volatile("s_waitcnt lgkmcnt(0)" ::: "memory");
        __builtin_amdgcn_wave_barrier();
        if (u < NU) {
            const int chain = u / NCHUNK, chunk = u - chain * NCHUNK, b = chain >> 4, h = (chain >> 1) & 7, d = chain & 1;
            bf16_t* blk = (bf16_t*)(RWB + (size_t)u * CBR);
            const float rkv = rkp[h * 64 + lane];
            float kt[16], rt[16], kh[16], bh[16], vv[16], cbp[16];
            float g = 1.0f;
#pragma unroll
            for (int t = 0; t < 16; ++t) {
                const LAS bf16_t* sp = (const LAS bf16_t*)rawl + t * 384 + lane;
                const float rr = bf2f(sp[0]), v_ = bf2f(sp[64]), kk = bf2f(sp[128]), mm = bf2f(sp[192]), bb = bf2f(sp[256]), kd = bf2f(sp[320]);
                kt[t] = g * kk; g *= (1.0f - mm); rt[t] = g * rr;
                const float ig = fast_rcp(g); kh[t] = kd * ig; bh[t] = bb * ig; vv[t] = v_; cbp[t] = rr * kd * rkv;
            }
            const float g15 = g;
#pragma unroll
            for (int t = 0; t < 16; ++t) { const float s = wave_sum(cbp[t]); if (lane == t) CBON[((size_t)d * TT + scan_row(b, d, chunk * 16 + t)) * 8 + h] = s; }
            store16bf((bf16_t*)((unsigned char*)blk + RB_VT) + lane * 16, vv);
            asm volatile("" ::: "memory");
#pragma unroll
            for (int t = 0; t < 16; ++t) { M0[t * GP + lane] = f2bf(kt[t]); M1[t * GP + lane] = f2bf(rt[t]); M2[t * GP + lane] = f2bf(kh[t]); M3[t * GP + lane] = f2bf(bh[t]); }
#pragma unroll
            for (int t = 0; t < 16; ++t) { kh[t] *= g15; bh[t] *= g15; }
            store16bf((bf16_t*)((unsigned char*)blk + RB_KO) + lane * 16, kh);
            store16bf((bf16_t*)((unsigned char*)blk + RB_BO) + lane * 16, bh);
            asm volatile("" ::: "memory");
            asm volatile("s_waitcnt lgkmcnt(0)" ::: "memory");
            __builtin_amdgcn_wave_barrier();
            f32x4 nk = gram16(M2, M0, fr, fq), nb = gram16(M3, M0, fr, fq), mk = gram16(M2, M1, fr, fq), mb = gram16(M3, M1, fr, fq);
#pragma unroll
            for (int j = 0; j < 4; ++j) { const int i = fq * 4 + j;
                nk[j] = i < fr ? nk[j] : 0.f; nb[j] = i < fr ? nb[j] : 0.f; mk[j] = i <= fr ? mk[j] : 0.f; mb[j] = i <= fr ? mb[j] : 0.f;
                NBc[fr * 16 + i] = nb[j]; NKr[i * 16 + fr] = nk[j]; }
            { u32x2 w; w.x = pack2(mk[0], mk[1]); w.y = pack2(mk[2], mk[3]); *(u32x2*)((unsigned char*)blk + RB_MK + (fr * 16 + fq * 4) * 2) = w;
              w.x = pack2(mb[0], mb[1]); w.y = pack2(mb[2], mb[3]); *(u32x2*)((unsigned char*)blk + RB_MB + (fr * 16 + fq * 4) * 2) = w; }
            asm volatile("s_waitcnt lgkmcnt(0)" ::: "memory");
            __builtin_amdgcn_wave_barrier();
            tri_solve16(kt, NBc);
            bf16_t* kto = (bf16_t*)((unsigned char*)blk + RB_KT) + pk; bf16_t* rto = (bf16_t*)((unsigned char*)blk + RB_RT) + pk;
#pragma unroll
            for (int t = 0; t < 16; ++t) { kto[t * 64] = f2bf(kt[t]); rto[t * 64] = f2bf(rt[t]); }
            { float x2[16];
#pragma unroll
              for (int t4 = 0; t4 < 4; ++t4) { const f32x4 q = *(const LAS f32x4*)(NKr + fr * 16 + t4 * 4); x2[t4 * 4] = q[0]; x2[t4 * 4 + 1] = q[1]; x2[t4 * 4 + 2] = q[2]; x2[t4 * 4 + 3] = q[3]; }
              tri_solve16(x2, NBc);
              if (lane < 16) { bf16_t* no = (bf16_t*)((unsigned char*)blk + RB_NKT) + lane;
#pragma unroll
                  for (int t = 0; t < 16; ++t) no[t * 16] = f2bf(x2[t]); } }
            ((float*)((unsigned char*)blk + RB_G))[lane] = g15;
            __builtin_amdgcn_wave_barrier();
        } else {
            const int uu = u - NU;
            bf16_t* blk = (bf16_t*)(HGB + (size_t)uu * CBH);
            float qt[16], kh[16], vv[16];
            float g = 1.0f;
#pragma unroll
            for (int t = 0; t < 16; ++t) {
                const LAS bf16_t* sp = (const LAS bf16_t*)rawl + t * 192 + lane;
                const float qq = bf2f(sp[0]), kk = bf2f(sp[64]), ii = bf2f(sp[128]);
                g *= (1.0f - kk); qt[t] = g * qq; kh[t] = kk * fast_rcp(g); vv[t] = ii;
            }
            const float g15 = g;
#pragma unroll
            for (int t = 0; t < 16; ++t) { M0[t * GP + lane] = f2bf(qt[t]); M2[t * GP + lane] = f2bf(kh[t]); }
            asm volatile("s_waitcnt lgkmcnt(0)" ::: "memory");
            __builtin_amdgcn_wave_barrier();
            f32x4 mk = gram16(M2, M0, fr, fq);
#pragma unroll
            for (int j = 0; j < 4; ++j) mk[j] = (fq * 4 + j) <= fr ? mk[j] : 0.f;
            { u32x2 w; w.x = pack2(mk[0], mk[1]); w.y = pack2(mk[2], mk[3]); *(u32x2*)((unsigned char*)blk + HB_MK + (fr * 16 + fq * 4) * 2) = w; }
            bf16_t* qto = (bf16_t*)((unsigned char*)blk + HB_QT) + pk;
#pragma unroll
            for (int t = 0; t < 16; ++t) { qto[t * 64] = f2bf(qt[t]); kh[t] *= g15; }
            store16bf((bf16_t*)((unsigned char*)blk + HB_KO) + lane * 16, kh);
            store16bf((bf16_t*)((unsigned char*)blk + HB_VT) + lane * 16, vv);
            ((float*)((unsigned char*)blk + HB_G))[lane] = g15;
            asm volatile("s_waitcnt lgkmcnt(0)" ::: "memory");
            __builtin_amdgcn_wave_barrier();
        }
    }
}
constexpr int SCD = 11;
DI bf16x8 pk8(const f32x4 lo, const f32x4 hi) {
    u32x4 w; w.x = pg8::cvt_pk_bf16(lo[0], lo[1]); w.y = pg8::cvt_pk_bf16(lo[2], lo[3]); w.z = pg8::cvt_pk_bf16(hi[0], hi[1]); w.w = pg8::cvt_pk_bf16(hi[2], hi[3]);
    return __builtin_bit_cast(bf16x8, w);
}
DI bf16x8 ld_tok(const LAS unsigned char* p) { const u32x2 w = *(const LAS u32x2*)p; u32x4 q; q.x = w.x; q.y = w.y; q.z = 0u; q.w = 0u; return __builtin_bit_cast(bf16x8, q); }
DI void p_scan(const Frame& F, const KArgs& a) {
    bf16_t* YO = (bf16_t*)(a.ws + WS_R2);
    const int lane = F.lane, wv = F.wave, fr = lane & 15, fq = lane >> 4;
    LAS unsigned char* ring = F.lds;
    LAS unsigned char* dummy = F.lds + SCD * CBR;
    LAS unsigned char* xb = dummy + 1024;
    for (int su = F.bid; su < 256; su += F.G) {
        const bool is_rw = su < 128;
        const int cu = su & 127, chain = cu >> 1, half = cu & 1, b = chain >> 4, d = chain & 1, h = (chain >> 1) & 7;
        const int bsz = is_rw ? CBR : CBH, nkb = is_rw ? 12 : 7;
        const unsigned char* src = a.ws + WS_R1 + (is_rw ? RW_OFF : HG_OFF) + (size_t)chain * NCHUNK * bsz;
        const bool stager = wv >= 4;
        const int d0 = (wv - 4) * 3;
#define SC_DMA(c_) do { if (stager) { const int cc_ = (c_) < NCHUNK ? (c_) : NCHUNK - 1; const unsigned char* bs_ = src + (size_t)cc_ * bsz; LAS unsigned char* sl_ = ring + ((c_) % SCD) * CBR; \
        _Pragma("unroll") for (int i_ = 0; i_ < 3; ++i_) { const int dd_ = d0 + i_; const bool ok_ = dd_ < nkb; \
            __builtin_amdgcn_global_load_lds((const unsigned*)(bs_ + (ok_ ? dd_ * 1024 : 0) + lane * 16), (LAS unsigned*)(ok_ ? sl_ + dd_ * 1024 : dummy), 16, 0, 16); } } } while (0)
#pragma unroll 1
        for (int c = 0; c < SCD - 2; ++c) SC_DMA(c);
        if (stager) asm volatile("s_waitcnt vmcnt(24)" ::: "memory");
        asm volatile("" ::: "memory"); __builtin_amdgcn_s_barrier(); asm volatile("" ::: "memory");
        f32x4 ST[4];
#pragma unroll
        for (int n = 0; n < 4; ++n) ST[n] = (f32x4){0.f, 0.f, 0.f, 0.f};
        const int qw = wv & 1;
        const int vbase = (half * 2 + qw) * 16;
        bf16_t* yout = YO + ((size_t)(is_rw ? 0 : 2) + d) * TT * 512 + h * 64 + vbase + (fr & ~1);
        int yoff[4];
#pragma unroll
        for (int j = 0; j < 4; ++j) yoff[j] = (d ? -(fq * 4 + j) : (fq * 4 + j)) * 512;
        const f32x4 z4 = (f32x4){0.f, 0.f, 0.f, 0.f};
#pragma unroll 1
        for (int c = 0; c <= NCHUNK; ++c) {
            SC_DMA(c + SCD - 2);
            if (wv < 2 && c < NCHUNK) {
                const LAS unsigned char* blk = ring + (c % SCD) * CBR;
                const bf16x8 Sb0 = pk8(ST[0], ST[1]), Sb1 = pk8(ST[2], ST[3]);
                LAS unsigned char* xo = xb + (((c & 1) * 2 + qw) * 64 + lane) * 48;
                if (is_rw) {
                    const bf16x8 kt0 = *(const LAS bf16x8*)(blk + RB_KT + (fr * 64 + fq * 8) * 2), kt1 = *(const LAS bf16x8*)(blk + RB_KT + (fr * 64 + 32 + fq * 8) * 2);
                    const bf16x8 nkt = ld_tok(blk + RB_NKT + (fr * 16 + fq * 4) * 2);
                    const bf16x8 Vb = ld_tok(blk + RB_VT + ((vbase + fr) * 16 + fq * 4) * 2);
                    f32x4 gg[4]; bf16x8 ko[4], bo[4];
#pragma unroll
                    for (int n = 0; n < 4; ++n) { gg[n] = *(const LAS f32x4*)(blk + RB_G + (n * 16 + fq * 4) * 4);
                        ko[n] = ld_tok(blk + RB_KO + ((n * 16 + fr) * 16 + fq * 4) * 2); bo[n] = ld_tok(blk + RB_BO + ((n * 16 + fr) * 16 + fq * 4) * 2); }
                    __builtin_amdgcn_sched_barrier(0);
                    f32x4 UTa = __builtin_amdgcn_mfma_f32_16x16x32_bf16(kt0, Sb0, z4, 0, 0, 0);
                    f32x4 UTb = __builtin_amdgcn_mfma_f32_16x16x32_bf16(kt1, Sb1, z4, 0, 0, 0);
                    UTb = __builtin_amdgcn_mfma_f32_16x16x32_bf16(nkt, Vb, UTb, 0, 0, 0);
#pragma unroll
                    for (int n = 0; n < 4; ++n) ST[n] = __builtin_amdgcn_mfma_f32_16x16x32_bf16(ko[n], Vb, ST[n] * gg[n], 0, 0, 0);
                    const f32x4 UT = UTa + UTb;
                    u32x4 un; un.x = pack2(UT[0], UT[1]) ^ 0x80008000u; un.y = pack2(UT[2], UT[3]) ^ 0x80008000u; un.z = 0u; un.w = 0u;
                    const bf16x8 Un = __builtin_bit_cast(bf16x8, un);
                    *(LAS bf16x8*)xo = Sb0; *(LAS bf16x8*)(xo + 16) = Sb1; *(LAS u32x2*)(xo + 32) = (u32x2){un.x, un.y};
#pragma unroll
                    for (int n = 0; n < 4; ++n) ST[n] = __builtin_amdgcn_mfma_f32_16x16x32_bf16(bo[n], Un, ST[n], 0, 0, 0);
                } else {
                    const bf16x8 Vb = ld_tok(blk + HB_VT + ((vbase + fr) * 16 + fq * 4) * 2);
                    f32x4 gg[4]; bf16x8 ko[4];
#pragma unroll
                    for (int n = 0; n < 4; ++n) { gg[n] = *(const LAS f32x4*)(blk + HB_G + (n * 16 + fq * 4) * 4); ko[n] = ld_tok(blk + HB_KO + ((n * 16 + fr) * 16 + fq * 4) * 2); }
                    *(LAS bf16x8*)xo = Sb0; *(LAS bf16x8*)(xo + 16) = Sb1;
#pragma unroll
                    for (int n = 0; n < 4; ++n) ST[n] = __builtin_amdgcn_mfma_f32_16x16x32_bf16(ko[n], Vb, ST[n] * gg[n], 0, 0, 0);
                }
            } else if (wv >= 2 && wv < 4 && c > 0) {
                const int cp = c - 1;
                const LAS unsigned char* blk = ring + (cp % SCD) * CBR;
                const LAS unsigned char* xi = xb + (((cp & 1) * 2 + qw) * 64 + lane) * 48;
                const bf16x8 Sb0 = *(const LAS bf16x8*)xi, Sb1 = *(const LAS bf16x8*)(xi + 16);
                f32x4 YT, YTa;
                if (is_rw) {
                    const bf16x8 rt0 = *(const LAS bf16x8*)(blk + RB_RT + (fr * 64 + fq * 8) * 2), rt1 = *(const LAS bf16x8*)(blk + RB_RT + (fr * 64 + 32 + fq * 8) * 2);
                    const bf16x8 mkt = ld_tok(blk + RB_MK + (fr * 16 + fq * 4) * 2), mbt = ld_tok(blk + RB_MB + (fr * 16 + fq * 4) * 2);
                    const bf16x8 Vb = ld_tok(blk + RB_VT + ((vbase + fr) * 16 + fq * 4) * 2);
                    const bf16x8 Un = ld_tok(xi + 32);
                    YTa = __builtin_amdgcn_mfma_f32_16x16x32_bf16(rt0, Sb0, z4, 0, 0, 0);
                    YT = __builtin_amdgcn_mfma_f32_16x16x32_bf16(rt1, Sb1, z4, 0, 0, 0);
                    YTa = __builtin_amdgcn_mfma_f32_16x16x32_bf16(mkt, Vb, YTa, 0, 0, 0);
                    YT = __builtin_amdgcn_mfma_f32_16x16x32_bf16(mbt, Un, YT, 0, 0, 0);
                } else {
                    const bf16x8 qt0 = *(const LAS bf16x8*)(blk + HB_QT + (fr * 64 + fq * 8) * 2), qt1 = *(const LAS bf16x8*)(blk + HB_QT + (fr * 64 + 32 + fq * 8) * 2);
                    const bf16x8 mkt = ld_tok(blk + HB_MK + (fr * 16 + fq * 4) * 2);
                    const bf16x8 Vb = ld_tok(blk + HB_VT + ((vbase + fr) * 16 + fq * 4) * 2);
                    YTa = __builtin_amdgcn_mfma_f32_16x16x32_bf16(qt0, Sb0, z4, 0, 0, 0);
                    YT = __builtin_amdgcn_mfma_f32_16x16x32_bf16(qt1, Sb1, z4, 0, 0, 0);
                    YTa = __builtin_amdgcn_mfma_f32_16x16x32_bf16(mkt, Vb, YTa, 0, 0, 0);
                }
                YT = YT + YTa;
                { const int r0 = __builtin_amdgcn_readfirstlane(scan_row(b, d, cp * 16)); bf16_t* yb = yout + (size_t)r0 * 512;
                  f32x4 YP;
#pragma unroll
                  for (int j = 0; j < 4; ++j) YP[j] = dppmov<0xB1>(YT[j]);
                  if (!(fr & 1)) {
#pragma unroll
                      for (int j = 0; j < 4; ++j) *(unsigned*)(yb + yoff[j]) = pack2(YT[j], YP[j]); } }
            }
            if (stager) asm volatile("s_waitcnt vmcnt(24)" ::: "memory");
            asm volatile("s_waitcnt lgkmcnt(0)" ::: "memory"); __builtin_amdgcn_s_barrier(); asm volatile("" ::: "memory");
        }
        asm volatile("s_waitcnt vmcnt(0)" ::: "memory");
        __syncthreads();
#undef SC_DMA
    }
}

DI void p_readout(const Frame& F, const KArgs& a) {
    const bf16_t* U = (const bf16_t*)(a.ws + WS_U);
    const bf16_t* G = (const bf16_t*)(a.ws + WS_R1 + G_OFF); const bf16_t* VTOK = (const bf16_t*)(a.ws + WS_R1 + VTOK_OFF);
    const float* CBON = (const float*)(a.ws + WS_R1 + CBON_OFF);
    const bf16_t* YO = (const bf16_t*)(a.ws + WS_R2);
    bf16_t* MIX = (bf16_t*)(a.ws + WS_MIX);
    const int lane = F.lane, c0 = lane * 8, hh = lane >> 3;
    float lnw[8], lnb[8], nw[8];
    load8f(KIN(a, 23) + c0, lnw); load8f(KIN(a, 24) + c0, lnb); load8f(KIN(a, 26) + (c0 & 63), nw);
    for (int row = F.bid * 8 + F.wave; row < TT; row += F.G * 8) {
        const size_t o = (size_t)row * 512 + c0;
        float y0[8], y1[8], y[8], v[8], g[8], out[8];
        load8bf(YO + o, y0); load8bf(YO + (size_t)TT * 512 + o, y1);
        load8bf(VTOK + o, v); load8bf(G + o, g);
        const float cb = CBON[(size_t)row * 8 + hh] + CBON[((size_t)TT + row) * 8 + hh];
        float s = 0.f;
#pragma unroll
        for (int e = 0; e < 8; ++e) { y[e] = y0[e] + y1[e]; s += y[e]; }
        s = sum8(s);
        const float mu = s * (1.0f / 64.0f);
        float vs = 0.f;
#pragma unroll
        for (int e = 0; e < 8; ++e) { const float dlt = y[e] - mu; vs += dlt * dlt; }
        vs = sum8(vs);
        const float inv = rsqrtf(vs * (1.0f / 64.0f) + 64e-5f);
#pragma unroll
        for (int e = 0; e < 8; ++e) out[e] = ((y[e] - mu) * inv * lnw[e] + lnb[e] + cb * v[e]) * g[e];
        store8bf(MIX + (size_t)row * DM + c0, out);
        float og[8];
        load8bf(YO + (size_t)2 * TT * 512 + o, y0); load8bf(YO + (size_t)3 * TT * 512 + o, y1);
        load8bf(U + (size_t)row * ABPAD + ACOLS + 2048 + c0, og);
        float ms = 0.f;
#pragma unroll
        for (int e = 0; e < 8; ++e) { y[e] = y0[e] + y1[e]; ms += y[e] * y[e]; }
        ms = sum8(ms);
        const float inv2 = rsqrtf(ms * (1.0f / 64.0f) + 1e-6f);
#pragma unroll
        for (int e = 0; e < 8; ++e) out[e] = y[e] * inv2 * nw[e] * fsilu(og[e]);
        store8bf(MIX + (size_t)row * DM + 512 + c0, out);
    }
}
constexpr int RT_TOK = 16;
DI void p_route(const Frame& F, const KArgs& a, int layer, int nrows) {
    const float* mod = (const float*)(a.ws + WS_MOD) + (size_t)layer * 5 * 6144;
    const bf16_t* X = (const bf16_t*)(a.ws + WS_XRES);
    bf16_t* hA = (bf16_t*)(a.ws + WS_HA);
    const float* rw = KIN(a, 6) + (size_t)layer * 1024 * 32; const float* rb = KIN(a, 7) + layer * 32;
    int* cnt = (int*)(a.ws + WS_CTL + CW_CNT) + layer * 32;
    int* list = (int*)(a.ws + WS_LIST); float* sgate = (float*)(a.ws + WS_SGATE);
    constexpr int HP = 1026;
    LAS float* h2 = (LAS float*)F.lds;
    LAS float* part = h2 + 16 * HP;
    LAS float* lg = part + 8 * 512;
    LAS int* lcnt = (LAS int*)(lg + 16 * 32);
    LAS int* lbase = lcnt + 32;
    LAS float* selv = (LAS float*)(lbase + 32);
    const int tid = F.tid, lane = F.lane, wv = F.wave;
    const int fr = lane & 15, kq = lane >> 4;
    float bw[32][2];
#pragma unroll
    for (int s = 0; s < 32; ++s)
#pragma unroll
        for (int n = 0; n < 2; ++n) bw[s][n] = rw[(size_t)(wv * 128 + s * 4 + kq) * 32 + n * 16 + fr];
    const int nun = nrows / RT_TOK;
    u32x2 pre[2][4];
    if (F.bid < nun) {
#pragma unroll
        for (int k = 0; k < 2; ++k)
#pragma unroll
            for (int i = 0; i < 4; ++i) pre[k][i] = *(const u32x2*)(X + (size_t)(F.bid * RT_TOK + wv * 2 + k) * DM + i * 256 + lane * 4);
    }
    const int tk = tid >> 5, ex = tid & 31;
    int prank = 4, ptrk = 0, prow0 = -1, pend = 0; float pgt = 0.f;
    for (int u = F.bid; u < nun; u += F.G) {
        const int row0 = u * RT_TOK;
        if (tid < 32) lcnt[tid] = 0;
#pragma unroll
        for (int k = 0; k < 2; ++k) {
            const int ti = wv * 2 + k, row = row0 + ti;
            f32x4 v[4];
#pragma unroll
            for (int i = 0; i < 4; ++i) { const u32x2 q = pre[k][i]; v[i] = (f32x4){lo2f(q.x), hi2f(q.x), lo2f(q.y), hi2f(q.y)}; }
            const float* m = mod + (size_t)row_sel(row) * 6144;
            row_modulate(v, m + 3072, m + 4096, lane);
#pragma unroll
            for (int i = 0; i < 4; ++i) *(unsigned*)((unsigned char*)hA + (size_t)row * DM + i * 256 + lane * 4) = pack4_fp8(clamp8(v[i][0]), clamp8(v[i][1]), clamp8(v[i][2]), clamp8(v[i][3]));
#pragma unroll
            for (int i = 0; i < 4; ++i) { LAS float* d = h2 + ti * HP + i * 256 + lane * 4; *(LAS f32x2*)d = (f32x2){v[i][0], v[i][1]}; *(LAS f32x2*)(d + 2) = (f32x2){v[i][2], v[i][3]}; }
        }
        if (u + F.G < nun) {
#pragma unroll
            for (int k = 0; k < 2; ++k)
#pragma unroll
                for (int i = 0; i < 4; ++i) pre[k][i] = *(const u32x2*)(X + (size_t)((u + F.G) * RT_TOK + wv * 2 + k) * DM + i * 256 + lane * 4);
        }
        lds_barrier();
        {
            f32x4 acc0 = (f32x4){0.f, 0.f, 0.f, 0.f}, acc1 = acc0;
            const LAS float* hp = h2 + fr * HP + wv * 128 + kq;
#pragma unroll
            for (int s = 0; s < 32; ++s) { const float av = hp[s * 4];
                acc0 = __builtin_amdgcn_mfma_f32_16x16x4f32(av, bw[s][0], acc0, 0, 0, 0);
                acc1 = __builtin_amdgcn_mfma_f32_16x16x4f32(av, bw[s][1], acc1, 0, 0, 0); }
#pragma unroll
            for (int j = 0; j < 4; ++j) { part[wv * 512 + (kq * 4 + j) * 32 + fr] = acc0[j]; part[wv * 512 + (kq * 4 + j) * 32 + 16 + fr] = acc1[j]; }
        }
        lds_barrier();
        float myl;
        {
            float s = rb[tid & 31];
#pragma unroll
            for (int w = 0; w < 8; ++w) s += part[w * 512 + tid];
            lg[tid] = s; myl = s;
        }
        lds_barrier();
        int rank = 0;
#pragma unroll 2
        for (int e4 = 0; e4 < 8; ++e4) { const f32x4 q = *(const LAS f32x4*)(lg + tk * 32 + e4 * 4);
#pragma unroll
            for (int j = 0; j < 4; ++j) { const int e2 = e4 * 4 + j; rank += (q[j] > myl || (q[j] == myl && e2 < ex)) ? 1 : 0; } }
        const bool sel = rank < 4;
        int trk = 0;
        if (sel) { selv[tk * 4 + rank] = myl; trk = atomicAdd((int*)&lcnt[ex], 1); }
        if (tid < 32 && prow0 >= 0) lbase[tid] = pend;
        lds_barrier();
        float gt = 0.f;
        if (sel) { const f32x4 sv = *(const LAS f32x4*)(selv + tk * 4);
            const float den = 1.0f + __expf(sv[1] - sv[0]) + __expf(sv[2] - sv[0]) + __expf(sv[3] - sv[0]);
            gt = __expf(myl - sv[0]) / den; }
        if (tid < 32) { const int n = lcnt[tid]; pend = n > 0 ? atomicAdd(&cnt[tid], n) : 0; }
        if (prow0 >= 0 && prank < 4) { const int pos = lbase[ex] + ptrk; list[(size_t)ex * TT + pos] = (prow0 + tk) * 4 + prank; sgate[(size_t)ex * TT + pos] = pgt; }
        prank = rank; ptrk = trk; pgt = gt; prow0 = row0;
        lds_barrier();
    }
    if (prow0 >= 0) {
        if (tid < 32) lbase[tid] = pend;
        lds_barrier();
        if (prank < 4) { const int pos = lbase[ex] + ptrk; list[(size_t)ex * TT + pos] = (prow0 + tk) * 4 + prank; sgate[(size_t)ex * TT + pos] = pgt; }
    }
    lds_barrier();
}
DI void moe_tables(const Frame& F, const KArgs& a, int layer, LAS int* tstart, LAS int* lc) {
    const int* cnt = (const int*)(a.ws + WS_CTL + CW_CNT) + layer * 32;
    if (F.tid == 0) { int acc = 0;
        for (int e = 0; e < 32; ++e) { const int n = cnt[e]; lc[e] = n; tstart[e] = acc; acc += (n + 255) >> 8; }
        tstart[32] = acc; }
    __syncthreads();
    LAS int* tile_e = tstart + 224;
    for (int mt = F.tid; mt < tstart[32]; mt += NTHR) { int e = 0;
        for (int k = 1; k < 32; ++k) e = (tstart[k] <= mt) ? k : e;
        tile_e[mt] = e; }
    __syncthreads();
}
DI void comb_load(const bf16_t* X, const unsigned char* Y, int row, int lane, f32x4 (&v)[4], unsigned (&y)[4][4]) {
    row_load16_bf(X + (size_t)row * DM, lane, v);
#pragma unroll
    for (int k = 0; k < 4; ++k)
#pragma unroll
        for (int i = 0; i < 4; ++i) y[k][i] = *(const unsigned*)(Y + (size_t)(row * 4 + k) * DM + i * 256 + lane * 4);
}
DI void comb_finish(const KArgs& a, const float* mod, bf16_t* X, bf16_t* hA, int layer, int row, int lane, f32x4 (&v)[4], const unsigned (&y)[4][4]) {
    const float* m = mod + (size_t)row_sel(row) * 6144;
#pragma unroll
    for (int i = 0; i < 4; ++i) { f32x4 acc = (f32x4){0.f, 0.f, 0.f, 0.f};
#pragma unroll
        for (int k = 0; k < 4; ++k) { const f32x2 lo = __builtin_amdgcn_cvt_pk_f32_fp8((int)y[k][i], false), hi = __builtin_amdgcn_cvt_pk_f32_fp8((int)y[k][i], true);
            acc[0] += lo[0]; acc[1] += lo[1]; acc[2] += hi[0]; acc[3] += hi[1]; }
        const f32x4 g4 = *(const f32x4*)(m + 5120 + i * 256 + lane * 4); v[i] = v[i] + g4 * acc * (1.0f / Q8_Y); }
    if (layer == 0) {
        row_store_bf16(X + (size_t)row * DM, lane, v);
        const float* m1 = mod + (size_t)5 * 6144 + (size_t)row_sel(row) * 6144;
        row_modulate(v, m1, m1 + 1024, lane);
        row_store_bf16(hA + (size_t)row * DM, lane, v);
    } else {
#pragma unroll
        for (int i = 0; i < 4; ++i) *(f32x4*)(a.out + (size_t)row * DM + i * 256 + lane * 4) = v[i];
    }
}
DI void p_combine(const Frame& F, const KArgs& a, int layer, int nrows) {
    const float* mod = (const float*)(a.ws + WS_MOD) + (size_t)layer * 5 * 6144;
    bf16_t* X = (bf16_t*)(a.ws + WS_XRES);
    const unsigned char* Y = a.ws + WS_R2;
    bf16_t* hA = (bf16_t*)(a.ws + WS_HA);
    const int lane = F.lane, stride = F.G * 8;
    int row = F.bid * 8 + F.wave;
    f32x4 vA[4], vB[4]; unsigned yA[4][4], yB[4][4];
    if (row < nrows) comb_load(X, Y, row, lane, vA, yA);
    while (row < nrows) {
        int r2 = row + stride;
        if (r2 < nrows) comb_load(X, Y, r2, lane, vB, yB);
        comb_finish(a, mod, X, hA, layer, row, lane, vA, yA);
        row = r2; if (row >= nrows) break;
        r2 = row + stride;
        if (r2 < nrows) comb_load(X, Y, r2, lane, vA, yA);
        comb_finish(a, mod, X, hA, layer, row, lane, vB, yB);
        row = r2;
    }
}
DI void p_prep1(const Frame& F, const KArgs& a) {
    const bf16_t* U = (const bf16_t*)(a.ws + WS_U);
    unsigned char* R1 = a.ws + WS_R1;
    bf16_t* QN = (bf16_t*)(R1 + L1_QN); bf16_t* KN = (bf16_t*)(R1 + L1_KN);
    const f32x2* rope = (const f32x2*)(a.ws + WS_ROPE);
    const int lane = F.lane, tid = F.tid;
    {
        const int d0 = (lane & 7) * 8;
        float qn[8], kn[8]; load8f(KIN(a, 29) + d0, qn); load8f(KIN(a, 30) + d0, kn);
        const int l8 = lane & 7, ax = l8 >> 2, ph = (l8 >> 1) & 1, i0 = (l8 & 1) * 8;
        for (int row = F.bid * 8 + F.wave; row < TT; row += F.G * 8) {
            const bool lat = row < TL;
            const int t = row & (SEQ - 1), pos = ax ? (t & 63) : (t >> 6);
#pragma unroll
            for (int which = 0; which < 2; ++which) {
                if (which == 0 && !lat) continue;
                float x[8]; load8bf(U + (size_t)row * CDCOLS + which * 512 + lane * 8, x);
                float ss = 0.f;
#pragma unroll
                for (int e = 0; e < 8; ++e) ss += x[e] * x[e];
                ss = sum8(ss);
                const float inv = rsqrtf(ss * (1.0f / 64.0f) + 1e-6f);
#pragma unroll
                for (int e = 0; e < 8; ++e) x[e] = x[e] * inv * (which ? kn[e] : qn[e]);
                float o[8];
#pragma unroll
                for (int e = 0; e < 8; ++e) {
                    const float xp = dppmov<0x4E>(x[e]);
                    const f32x2 cs = rope[pos * 16 + i0 + e];
                    const float rot = ph ? (xp * cs[1] + x[e] * cs[0]) : (x[e] * cs[0] - xp * cs[1]);
                    o[e] = lat ? rot : x[e];
                }
                if (which == 0) {
#pragma unroll
                    for (int e = 0; e < 8; ++e) o[e] *= 0.125f;
                    store8bf(QN + (size_t)row * 512 + lane * 8, o);
                } else store8bf(KN + (size_t)row * 512 + lane * 8, o);
            }
        }
    }
    {
        LAS unsigned char* Tb = F.lds;
        bf16_t* VT = (bf16_t*)(R1 + L1_VT); bf16_t* VCT = (bf16_t*)(R1 + L1_VCT); bf16_t* HVT = (bf16_t*)(R1 + L1_HVT);
        const float* hs = KIN(a, 32);
        int par = 0;
        for (int u = F.bid; u < (TT / 64) * 8; u += F.G) {
            const int tile = u >> 3, ch = u & 7, row0 = tile * 64;
            const bool lat = row0 < TL;
            if (!lat && ch >= 2) continue;
            const int seq_start = lat ? (row0 / SEQ) * SEQ : TL + ((row0 - TL) / CL) * CL;
            const int seq_end = lat ? seq_start + SEQ : seq_start + CL;
            const int col8 = tid & 31, tr = tid >> 5;
            const int scol = 1024 + ch * 256 + col8 * 8;
            const int r0 = row0 + tr * 4;
            LAS unsigned char* img = Tb + par * 32768; par ^= 1;
            float y[4][8];
            if (ch >= 2) {
                float w0[8], w1[8], w2[8];
                load8f(hs + (scol - 1536), w0); load8f(hs + 1536 + (scol - 1536), w1); load8f(hs + 3072 + (scol - 1536), w2);
                float x[6][8];
#pragma unroll
                for (int r = 0; r < 6; ++r) { const int row = r0 - 1 + r;
                    if (row >= seq_start && row < seq_end) load8bf(U + (size_t)row * CDCOLS + scol, x[r]); else {
#pragma unroll
                        for (int e = 0; e < 8; ++e) x[r][e] = 0.f; } }
#pragma unroll
                for (int t = 0; t < 4; ++t)
#pragma unroll
                    for (int e = 0; e < 8; ++e) y[t][e] = x[t][e] * w0[e] + x[t + 1][e] * w1[e] + x[t + 2][e] * w2[e];
            } else {
#pragma unroll
                for (int t = 0; t < 4; ++t) load8bf(U + (size_t)(r0 + t) * CDCOLS + scol, y[t]);
            }
#pragma unroll
            for (int e = 0; e < 8; ++e) { u32x2 w; w.x = pack2(y[0][e], y[1][e]); w.y = pack2(y[2][e], y[3][e]);
                *(LAS u32x2*)(img + (col8 * 8 + e) * 128 + ((tr ^ (col8 & 15)) * 8)) = w; }
            __syncthreads();
#pragma unroll
            for (int q = 0; q < 4; ++q) {
                const int idx = tid + q * NTHR, cl = idx >> 3, pc = idx & 7, sw = (cl >> 3) & 15;
                u32x4 w = *(const LAS u32x4*)(img + cl * 128 + ((pc ^ (sw >> 1)) * 16));
                if (sw & 1) { const unsigned t0 = w.x, t1 = w.y; w.x = w.z; w.y = w.w; w.z = t0; w.w = t1; }
                const int cg = ch * 256 + cl;
                bf16_t* dst;
                if (cg < 512) {
                    if (lat) { const int b = row0 / SEQ, t0 = row0 - b * SEQ; dst = VT + ((size_t)b * 512 + cg) * SEQ + t0 + pc * 8; }
                    else { const int b = (row0 - TL) / CL, t0 = (row0 - TL) - b * CL; dst = VCT + ((size_t)b * 512 + cg) * CL + t0 + pc * 8; }
                } else { const int hc = cg - 512, st = hc >> 9, c = hc & 511, b = row0 / SEQ, t0 = row0 - b * SEQ;
                    dst = HVT + (((size_t)st * 4 + b) * 512 + c) * SEQ + t0 + pc * 8; }
                *(u32x4*)dst = w;
            }
        }
        __syncthreads();
    }
}
DI void p_hy_back(const Frame& F, const KArgs& a) {
    const bf16_t* HYT = (const bf16_t*)(a.ws + WS_R1 + L1_HYT);
    bf16_t* MIX = (bf16_t*)(a.ws + WS_MIX);
    const int tid = F.tid, pc = tid & 7, c4 = tid >> 3;
    int par = 0;
    for (int u = F.bid; u < (TL / 64) * 2; u += F.G) {
        const int tile = u >> 1, ch = u & 1, row0 = tile * 64, b = row0 / SEQ, t0 = row0 - b * SEQ;
        LAS unsigned char* img = F.lds + par * 32768; par ^= 1;
        u32x4 x[4];
#pragma unroll
        for (int i = 0; i < 4; ++i) x[i] = *(const u32x4*)(HYT + ((size_t)b * 512 + ch * 256 + c4 * 4 + i) * SEQ + t0 + pc * 8);
#pragma unroll
        for (int e = 0; e < 8; ++e) {
            const int sh = (e & 1) * 16; unsigned v[4];
#pragma unroll
            for (int i = 0; i < 4; ++i) v[i] = (x[i][e >> 1] >> sh) & 0xFFFFu;
            u32x2 w; w.x = v[0] | (v[1] << 16); w.y = v[2] | (v[3] << 16);
            *(LAS u32x2*)(img + (pc * 8 + e) * 512 + ((c4 ^ (pc << 3)) * 8)) = w;
        }
        __syncthreads();
#pragma unroll
        for (int q = 0; q < 4; ++q) {
            const int idx = tid + q * NTHR, tt = idx >> 5, c8 = idx & 31;
            const u32x4 w = *(const LAS u32x4*)(img + tt * 512 + ((c8 ^ ((tt >> 3) << 2)) * 16));
            *(u32x4*)(MIX + (size_t)(row0 + tt) * DM + 512 + ch * 256 + c8 * 8) = w;
        }
    }
    __syncthreads();
}
constexpr int NA_UNITS = NB * 8 * 64, KPB = 144, NA_KROWS = 9 * 64 + 256, VPB = NA_KROWS * 2 + 16;
DI void na_unit(const Frame& F, const KArgs& a, int u) {
    unsigned char* R1 = a.ws + WS_R1;
    const bf16_t* QN = (const bf16_t*)(R1 + L1_QN); const bf16_t* KN = (const bf16_t*)(R1 + L1_KN);
    const bf16_t* VT = (const bf16_t*)(R1 + L1_VT); const bf16_t* VCT = (const bf16_t*)(R1 + L1_VCT);
    bf16_t* MIX = (bf16_t*)(a.ws + WS_MIX);
    const int tid = F.tid, lane = F.lane, wv = F.wave, fr = lane & 15, fq = lane >> 4;
    const int b = u >> 9, h = (u >> 6) & 7, rb = u & 63;
    const int rsA = min(max(2 * rb - 4, 0), 120);
    LAS unsigned char* Ksm = F.lds;
    LAS float* Bsm = (LAS float*)(F.lds + NA_KROWS * KPB);
#pragma unroll
    for (int i = 0; i < 13; ++i) {
        const int p = tid + i * NTHR, kx = p >> 3, pc = p & 7;
        const size_t tok = kx < 576 ? (size_t)b * SEQ + min(rsA + (kx >> 6), 127) * 64 + (kx & 63) : (size_t)TL + b * CL + (kx - 576);
        *(LAS u32x4*)(Ksm + kx * KPB + pc * 16) = *(const u32x4*)(KN + tok * 512 + h * 64 + pc * 8);
    }
    if (tid < 465) Bsm[tid] = KIN(a, 31)[h * 465 + tid];
    const int r = 2 * rb + (wv >> 2), c0 = 16 * (wv & 3);
    const int rs = min(max(r - 4, 0), 120), kc0 = min(max(c0 - 8, 0), 32);
    const int cq = c0 + fr, cs = min(max(cq - 8, 0), 48);
    bf16x8 qf[2];
    { const bf16_t* qp = QN + ((size_t)b * SEQ + r * 64 + cq) * 512 + h * 64 + fq * 8; qf[0] = *(const bf16x8*)qp; qf[1] = *(const bf16x8*)(qp + 32); }
    __syncthreads();
    float lsum = 0.f;
    const int prow = (fr >> 2) * 8 + (fr & 3);
    u32x4 PF[16];
#pragma unroll
    for (int g = 0; g < 4; ++g) {
#pragma unroll
        for (int s4 = 0; s4 < 4; ++s4) {
            const int kx0 = (g < 2) ? (rs - rsA + g * 4 + s4) * 64 + kc0 : 576 + (g - 2) * 128 + s4 * 32;
            f32x4 P2[2];
#pragma unroll
            for (int hh = 0; hh < 2; ++hh) {
                const LAS unsigned char* kp = Ksm + (kx0 + prow + hh * 4) * KPB + fq * 16;
                const bf16x8 k0 = *(const LAS bf16x8*)kp, k1 = *(const LAS bf16x8*)(kp + 64);
                f32x4 acc = (f32x4){0.f, 0.f, 0.f, 0.f};
                acc = __builtin_amdgcn_mfma_f32_16x16x32_bf16(k0, qf[0], acc, 0, 0, 0);
                acc = __builtin_amdgcn_mfma_f32_16x16x32_bf16(k1, qf[1], acc, 0, 0, 0);
#pragma unroll
                for (int j = 0; j < 4; ++j) {
                    float sv = acc[j];
                    if (g < 2) { const int kr = rs + g * 4 + s4, kc = kc0 + fq * 8 + hh * 4 + j; const bool ok = kc >= cs && kc < cs + 16;
                        sv = ok ? sv + Bsm[(kr - r + 7) * 31 + (kc - cq + 15)] : -1.0e30f; }
                    const float pv = __expf(fminf(sv, 80.0f)); acc[j] = pv; lsum += pv;
                }
                P2[hh] = acc;
            }
            u32x4 pw; pw.x = pack2(P2[0][0], P2[0][1]); pw.y = pack2(P2[0][2], P2[0][3]); pw.z = pack2(P2[1][0], P2[1][1]); pw.w = pack2(P2[1][2], P2[1][3]);
            PF[g * 4 + s4] = pw;
        }
    }
    __syncthreads();
#pragma unroll
    for (int i = 0; i < 13; ++i) {
        const int p = tid + i * NTHR;
        int dim, kx; const bf16_t* src;
        if (p < 4608) { dim = p / 72; const int rem = p - dim * 72, rw_ = rem >> 3, pc = rem & 7; kx = rw_ * 64 + pc * 8;
            src = VT + ((size_t)b * 512 + h * 64 + dim) * SEQ + min(rsA + rw_, 127) * 64 + pc * 8; }
        else { const int q = p - 4608; dim = q >> 5; const int pc = q & 31; kx = 576 + pc * 8; src = VCT + ((size_t)b * 512 + h * 64 + dim) * CL + pc * 8; }
        *(LAS u32x4*)(Ksm + dim * VPB + kx * 2) = *(const u32x4*)src;
    }
    __syncthreads();
    f32x4 O[4];
#pragma unroll
    for (int n = 0; n < 4; ++n) O[n] = (f32x4){0.f, 0.f, 0.f, 0.f};
#pragma unroll
    for (int ks = 0; ks < 16; ++ks) {
        const int g = ks >> 2, s4 = ks & 3;
        const int kx0 = (g < 2) ? (rs - rsA + g * 4 + s4) * 64 + kc0 : 576 + (g - 2) * 128 + s4 * 32;
        const bf16x8 pf = __builtin_bit_cast(bf16x8, PF[ks]);
#pragma unroll
        for (int n = 0; n < 4; ++n) { const bf16x8 vf = *(const LAS bf16x8*)(Ksm + (n * 16 + fr) * VPB + (kx0 + fq * 8) * 2);
            O[n] = __builtin_amdgcn_mfma_f32_16x16x32_bf16(pf, vf, O[n], 0, 0, 0); }
    }
    lsum += __builtin_bit_cast(float, __builtin_amdgcn_ds_bpermute((lane ^ 16) << 2, __builtin_bit_cast(int, lsum)));
    lsum += __builtin_bit_cast(float, __builtin_amdgcn_ds_bpermute((lane ^ 32) << 2, __builtin_bit_cast(int, lsum)));
    const float rl = 1.0f / lsum;
    float rq[4];
#pragma unroll
    for (int j = 0; j < 4; ++j) rq[j] = __builtin_bit_cast(float, __builtin_amdgcn_ds_bpermute((fq * 4 + j) << 2, __builtin_bit_cast(int, rl)));
#pragma unroll
    for (int n = 0; n < 4; ++n)
#pragma unroll
        for (int j = 0; j < 4; ++j)
            MIX[((size_t)b * SEQ + r * 64 + c0 + fq * 4 + j) * DM + h * 64 + n * 16 + fr] = f2bf(O[n][j] * rq[j]);
}

constexpr int FN = 16384;
DI f32x2 cmul(f32x2 a, f32x2 b) {
    f32x2 t, r;
    asm("v_pk_mul_f32 %0, %1, %2 op_sel:[0,0] op_sel_hi:[0,1]" : "=v"(t) : "v"(a), "v"(b));
    asm("v_pk_fma_f32 %0, %1, %2, %3 op_sel:[1,1,0] op_sel_hi:[1,0,1] neg_lo:[0,1,0]" : "=v"(r) : "v"(a), "v"(b), "v"(t));
    return r;
}
DI f32x2 cmulc(f32x2 a, f32x2 b) {
    f32x2 t, r;
    asm("v_pk_mul_f32 %0, %1, %2 op_sel:[0,0] op_sel_hi:[1,0]" : "=v"(t) : "v"(a), "v"(b));
    asm("v_pk_fma_f32 %0, %1, %2, %3 op_sel:[1,1,0] op_sel_hi:[0,1,1] neg_hi:[0,1,0]" : "=v"(r) : "v"(a), "v"(b), "v"(t));
    return r;
}
DI f32x2 add_mi(f32x2 a, f32x2 d) { f32x2 r; asm("v_pk_add_f32 %0, %1, %2 op_sel:[0,1] op_sel_hi:[1,0] neg_hi:[0,1]" : "=v"(r) : "v"(a), "v"(d)); return r; }
DI f32x2 add_pi(f32x2 a, f32x2 d) { f32x2 r; asm("v_pk_add_f32 %0, %1, %2 op_sel:[0,1] op_sel_hi:[1,0] neg_lo:[0,1]" : "=v"(r) : "v"(a), "v"(d)); return r; }
DI f32x2 tw_get(const LAS f32x2* Thi, const LAS f32x2* Tlo, int e) { return cmul(Thi[e >> 7], Tlo[e & 127]); }
DI int PX(int i) { return i + ((i >> 4) << 1); }
DI void r4_fwd(f32x2& x0, f32x2& x1, f32x2& x2, f32x2& x3) {
    const f32x2 a0 = x0 + x2, a1 = x0 - x2, a2 = x1 + x3, d = x1 - x3;
    x0 = a0 + a2; x1 = add_mi(a1, d); x2 = a0 - a2; x3 = add_pi(a1, d);
}
DI void r4_inv(f32x2& z0, f32x2& z1, f32x2& z2, f32x2& z3) {
    const f32x2 a0 = z0 + z2, a1 = z0 - z2, a2 = z1 + z3, d = z1 - z3;
    z0 = a0 + a2; z1 = add_pi(a1, d); z2 = a0 - a2; z3 = add_mi(a1, d);
}
template <int LS>
DI void sp_fwd_compute(const LAS f32x2* Thi, const LAS f32x2* Tlo, int offp, f32x2 (&x)[16]) {
    constexpr int sp = 1 << (LS - 2);
#pragma unroll
    for (int b = 0; b < 4; ++b) {
        if (b == 2) __builtin_amdgcn_sched_barrier(0);
        r4_fwd(x[b], x[4 + b], x[8 + b], x[12 + b]);
        const int e1 = (b * sp + offp) << (12 - LS);
        if (!(LS == 2 && b == 0)) { const f32x2 w1 = tw_get(Thi, Tlo, e1), w2 = cmul(w1, w1), w3 = cmul(w2, w1);
            x[4 + b] = cmul(x[4 + b], w1); x[8 + b] = cmul(x[8 + b], w2); x[12 + b] = cmul(x[12 + b], w3); }
    }
    f32x2 w1 = (f32x2){1.f, 0.f}, w2 = w1, w3 = w1;
    if (LS > 2) { w1 = tw_get(Thi, Tlo, offp << (14 - LS)); w2 = cmul(w1, w1); w3 = cmul(w2, w1); }
#pragma unroll
    for (int m = 0; m < 4; ++m) {
        r4_fwd(x[4 * m], x[4 * m + 1], x[4 * m + 2], x[4 * m + 3]);
        if (LS > 2) { x[4 * m + 1] = cmul(x[4 * m + 1], w1); x[4 * m + 2] = cmul(x[4 * m + 2], w2); x[4 * m + 3] = cmul(x[4 * m + 3], w3); }
    }
}
template <int LS>
DI void sp_inv_compute(const LAS f32x2* Thi, const LAS f32x2* Tlo, int offp, f32x2 (&x)[16]) {
    constexpr int sp = 1 << (LS - 2);
    f32x2 w1 = (f32x2){1.f, 0.f}, w2 = w1, w3 = w1;
    if (LS > 2) { w1 = tw_get(Thi, Tlo, offp << (14 - LS)); w2 = cmul(w1, w1); w3 = cmul(w2, w1); }
#pragma unroll
    for (int m = 0; m < 4; ++m) {
        if (LS > 2) { x[4 * m + 1] = cmulc(x[4 * m + 1], w1); x[4 * m + 2] = cmulc(x[4 * m + 2], w2); x[4 * m + 3] = cmulc(x[4 * m + 3], w3); }
        r4_inv(x[4 * m], x[4 * m + 1], x[4 * m + 2], x[4 * m + 3]);
    }
#pragma unroll
    for (int b = 0; b < 4; ++b) {
        if (b == 2) __builtin_amdgcn_sched_barrier(0);
        const int e1 = (b * sp + offp) << (12 - LS);
        if (!(LS == 2 && b == 0)) { const f32x2 v1 = tw_get(Thi, Tlo, e1), v2 = cmul(v1, v1), v3 = cmul(v2, v1);
            x[4 + b] = cmulc(x[4 + b], v1); x[8 + b] = cmulc(x[8 + b], v2); x[12 + b] = cmulc(x[12 + b], v3); }
        r4_inv(x[b], x[4 + b], x[8 + b], x[12 + b]);
    }
}
template <int LS> DI int sp_base(int g, int& offp) { constexpr int sp = 1 << (LS - 2); offp = g & (sp - 1); return ((g >> (LS - 2)) << (LS + 2)) + offp; }
template <int LS> DI void sp_load(const LAS f32x2* X, int base, f32x2 (&x)[16]) {
    constexpr int s = 1 << LS, sp = 1 << (LS - 2);
#pragma unroll
    for (int a = 0; a < 4; ++a)
#pragma unroll
        for (int b = 0; b < 4; ++b) x[a * 4 + b] = X[PX(base + a * s + b * sp)];
}
template <int LS> DI void sp_store(LAS f32x2* X, int base, const f32x2 (&x)[16]) {
    constexpr int s = 1 << LS, sp = 1 << (LS - 2);
#pragma unroll
    for (int a = 0; a < 4; ++a)
#pragma unroll
        for (int b = 0; b < 4; ++b) X[PX(base + a * s + b * sp)] = x[a * 4 + b];
}

DI void r4pass_fwd(LAS f32x2* X, const LAS f32x2* Thi, const LAS f32x2* Tlo, int tid) {
#pragma unroll 4
    for (int bq = 0; bq < 8; ++bq) { const int k = tid + 512 * bq, off = k & 15, base = ((k >> 4) << 6) + off;
        f32x2 x0 = X[PX(base)], x1 = X[PX(base + 16)], x2 = X[PX(base + 32)], x3 = X[PX(base + 48)];
        r4_fwd(x0, x1, x2, x3);
        const f32x2 w1 = tw_get(Thi, Tlo, off << 8), w2 = cmul(w1, w1), w3 = cmul(w2, w1);
        X[PX(base)] = x0; X[PX(base + 16)] = cmul(x1, w1); X[PX(base + 32)] = cmul(x2, w2); X[PX(base + 48)] = cmul(x3, w3); }
    __syncthreads();
}
DI void r4pass_inv(LAS f32x2* X, const LAS f32x2* Thi, const LAS f32x2* Tlo, int tid) {
#pragma unroll 4
    for (int bq = 0; bq < 8; ++bq) { const int k = tid + 512 * bq, off = k & 15, base = ((k >> 4) << 6) + off;
        f32x2 x0 = X[PX(base)], x1 = X[PX(base + 16)], x2 = X[PX(base + 32)], x3 = X[PX(base + 48)];
        const f32x2 w1 = tw_get(Thi, Tlo, off << 8), w2 = cmul(w1, w1), w3 = cmul(w2, w1);
        x1 = cmulc(x1, w1); x2 = cmulc(x2, w2); x3 = cmulc(x3, w3);
        r4_inv(x0, x1, x2, x3);
        X[PX(base)] = x0; X[PX(base + 16)] = x1; X[PX(base + 32)] = x2; X[PX(base + 48)] = x3; }
    __syncthreads();
}
template <int LS, int MODE>
DI void sp_fwd_pass(LAS f32x2* X, const LAS f32x2* Thi, const LAS f32x2* Tlo, int tid, f32x2 (&Kr)[2][16]) {
#pragma unroll
    for (int i = 0; i < 2; ++i) { __builtin_amdgcn_sched_barrier(0); int offp; const int base = sp_base<LS>(tid + 512 * i, offp); f32x2 x[16];
        sp_load<LS>(X, base, x); sp_fwd_compute<LS>(Thi, Tlo, offp, x);
        if (MODE == 1) {
#pragma unroll
            for (int e = 0; e < 16; ++e) Kr[i][e] = x[e]; }
        else { if (MODE == 2) {
#pragma unroll
                for (int e = 0; e < 16; ++e) x[e] = cmul(x[e], Kr[i][e]); }
            sp_store<LS>(X, base, x); } }
    __syncthreads();
}
template <int LS>
DI void sp_inv_pass(LAS f32x2* X, const LAS f32x2* Thi, const LAS f32x2* Tlo, int tid) {
#pragma unroll
    for (int i = 0; i < 2; ++i) { __builtin_amdgcn_sched_barrier(0); int offp; const int base = sp_base<LS>(tid + 512 * i, offp); f32x2 x[16];
        sp_load<LS>(X, base, x); sp_inv_compute<LS>(Thi, Tlo, offp, x); sp_store<LS>(X, base, x); }
    __syncthreads();
}
template <int MODE>
DI void fft_forward(LAS f32x2* X, const LAS f32x2* Thi, const LAS f32x2* Tlo, int tid, f32x2 (&Kr)[2][16]) {
    sp_fwd_pass<12, 0>(X, Thi, Tlo, tid, Kr); sp_fwd_pass<8, 0>(X, Thi, Tlo, tid, Kr); r4pass_fwd(X, Thi, Tlo, tid); sp_fwd_pass<2, MODE>(X, Thi, Tlo, tid, Kr);
}
DI void fft_inverse(LAS f32x2* X, const LAS f32x2* Thi, const LAS f32x2* Tlo, int tid) {
    sp_inv_pass<2>(X, Thi, Tlo, tid); r4pass_inv(X, Thi, Tlo, tid); sp_inv_pass<8>(X, Thi, Tlo, tid); sp_inv_pass<12>(X, Thi, Tlo, tid);
}
DI void hy_load_filter(const Frame& F, const KArgs& a, LAS f32x2* X, int o, int c) {
    const float* HYF = (const float*)(a.ws + WS_HYF);
    const float* hf = HYF + ((size_t)(o * 2 + 0) * 512 + c) * SEQ; const float* hb = HYF + ((size_t)(o * 2 + 1) * 512 + c) * SEQ;
    const float g0 = hf[0] + hb[0] + KIN(a, 40)[o * 512 + c];
    for (int n = F.tid; n < FN; n += NTHR) {
        float g;
        if (n == 0) g = g0; else if (n < SEQ) g = hf[n]; else if (n == SEQ) g = 0.f; else g = hb[FN - n];
        X[PX(n)] = (f32x2){g, 0.f};
    }
    __syncthreads();
}
DI void hyena_unit(const Frame& F, const KArgs& a, int c) {
    unsigned char* R1 = a.ws + WS_R1;
    const bf16_t* HVT = (const bf16_t*)(R1 + L1_HVT); bf16_t* HYT = (bf16_t*)(R1 + L1_HYT);
    float* ZT = (float*)(R1 + L1_ZT);
    LAS f32x2* X = (LAS f32x2*)F.lds;
    LAS f32x2* Thi = (LAS f32x2*)(F.lds + LDS_MISC + 512); LAS f32x2* Tlo = Thi + 128;
    const int tid = F.tid;
    const float rn = 1.0f / (float)FN;
    f32x2 Kr[2][16];
    hy_load_filter(F, a, X, 0, c);
    fft_forward<1>(X, Thi, Tlo, tid, Kr);
#pragma unroll 1
    for (int p = 0; p < 2; ++p) {
        const size_t r0 = ((size_t)(2 * p) * 512 + c) * SEQ, r1 = ((size_t)(2 * p + 1) * 512 + c) * SEQ;
        const bf16_t* v0 = HVT + r0; const bf16_t* v1 = HVT + r1;
        const bf16_t* x10 = HVT + (size_t)4 * 512 * SEQ + r0; const bf16_t* x11 = HVT + (size_t)4 * 512 * SEQ + r1;
#pragma unroll
        for (int i = 0; i < 2; ++i) { const int t = (tid + NTHR * i) * 8; float xa[8], xb[8]; load8bf(v0 + t, xa); load8bf(v1 + t, xb);
#pragma unroll
            for (int e = 0; e < 8; ++e) { X[PX(t + e)] = (f32x2){xa[e], xb[e]}; X[PX(SEQ + t + e)] = (f32x2){0.f, 0.f}; } }
        __syncthreads();
        fft_forward<2>(X, Thi, Tlo, tid, Kr);
        fft_inverse(X, Thi, Tlo, tid);
#pragma unroll
        for (int i = 0; i < 2; ++i) { const int t = (tid + NTHR * i) * 8; float xa[8], xb[8]; load8bf(x10 + t, xa); load8bf(x11 + t, xb);
#pragma unroll
            for (int e4 = 0; e4 < 2; ++e4) { f32x4 za, zb;
#pragma unroll
                for (int e = 0; e < 4; ++e) { const f32x2 y = X[PX(t + e4 * 4 + e)]; za[e] = xa[e4 * 4 + e] * y[0] * rn; zb[e] = xb[e4 * 4 + e] * y[1] * rn; }
                *(f32x4*)(ZT + r0 + t + e4 * 4) = za; *(f32x4*)(ZT + r1 + t + e4 * 4) = zb; } }
        __syncthreads();
    }
    hy_load_filter(F, a, X, 1, c);
    fft_forward<1>(X, Thi, Tlo, tid, Kr);
#pragma unroll 1
    for (int p = 0; p < 2; ++p) {
        const size_t r0 = ((size_t)(2 * p) * 512 + c) * SEQ, r1 = ((size_t)(2 * p + 1) * 512 + c) * SEQ;
        const bf16_t* x20 = HVT + (size_t)8 * 512 * SEQ + r0; const bf16_t* x21 = HVT + (size_t)8 * 512 * SEQ + r1;
#pragma unroll
        for (int i = 0; i < 2; ++i) { const int t = (tid + NTHR * i) * 8;
#pragma unroll
            for (int e4 = 0; e4 < 2; ++e4) { const f32x4 za = *(const f32x4*)(ZT + r0 + t + e4 * 4), zb = *(const f32x4*)(ZT + r1 + t + e4 * 4);
#pragma unroll
                for (int e = 0; e < 4; ++e) { X[PX(t + e4 * 4 + e)] = (f32x2){za[e], zb[e]}; X[PX(SEQ + t + e4 * 4 + e)] = (f32x2){0.f, 0.f}; } } }
        __syncthreads();
        fft_forward<2>(X, Thi, Tlo, tid, Kr);
        fft_inverse(X, Thi, Tlo, tid);
#pragma unroll
        for (int i = 0; i < 2; ++i) { const int t = (tid + NTHR * i) * 8; float xa[8], xb[8], oa[8], ob[8]; load8bf(x20 + t, xa); load8bf(x21 + t, xb);
#pragma unroll
            for (int e = 0; e < 8; ++e) { const f32x2 y = X[PX(t + e)]; oa[e] = xa[e] * y[0] * rn; ob[e] = xb[e] * y[1] * rn; }
            store8bf(HYT + r0 + t, oa); store8bf(HYT + r1 + t, ob); }
        __syncthreads();
    }
}
DI void p_na_hyena(const Frame& F, const KArgs& a) {
    unsigned* head = (unsigned*)(a.ws + WS_CTL + CW_Q);
    volatile LAS int* slot = (volatile LAS int*)(F.lds + LDS_MISC + 64);
    { LAS f32x2* Thi = (LAS f32x2*)(F.lds + LDS_MISC + 512); LAS f32x2* Tlo = Thi + 128; const int tid = F.tid;
      if (tid < 256) { const int i = tid & 127; const float ang = -6.283185307179586f * (float)((tid < 128) ? i * 128 : i) / (float)FN;
          float sn, cs; sincosf(ang, &sn, &cs); (tid < 128 ? Thi : Tlo)[i] = (f32x2){cs, sn}; } }
    if (threadIdx.x == 0) *slot = (int)__hip_atomic_fetch_add(head, 1u, __ATOMIC_RELAXED, __HIP_MEMORY_SCOPE_AGENT);
    for (;;) {
        __syncthreads();
        const int u = *slot;
        if (u >= 512 + NA_UNITS) break;
        int nxt = 0;
        if (threadIdx.x == 0) nxt = (int)__hip_atomic_fetch_add(head, 1u, __ATOMIC_RELAXED, __HIP_MEMORY_SCOPE_AGENT);
        Frame Fu = F; { int t_ = threadIdx.x; asm volatile("" : "+v"(t_)); Fu.tid = t_; Fu.lane = t_ & 63; }
        if (u < 512) hyena_unit(Fu, a, u); else na_unit(Fu, a, u - 512);
        if (threadIdx.x == 0) *slot = nxt;
    }
}
constexpr int NPHASE = 21;
__global__ void __launch_bounds__(NTHR, 2) fwd_kernel(Args kargs) {
    extern __shared__ __attribute__((aligned(16))) unsigned char lds_raw[];
    LAS unsigned char* const lds0 = (LAS unsigned char*)lds_raw;
#define MKF() Frame F; KArgs args; { int t_ = threadIdx.x; asm volatile("" : "+v"(t_)); unsigned long long kp_ = (unsigned long long)__builtin_amdgcn_kernarg_segment_ptr(); asm volatile("" : "+s"(kp_)); \
    args.kp = kp_; args.ws = (unsigned char*)(GAS unsigned char*)kload<336>(kp_); args.out = (float*)(GAS float*)kload<328>(kp_); \
    F.lds = lds0; F.ws = args.ws; F.tid = t_; F.lane = t_ & 63; F.wave = __builtin_amdgcn_readfirstlane(t_ >> 6); F.G = gridDim.x; F.bid = blockIdx.x; } \
    unsigned char* const ws = args.ws; const float* const mod = (const float*)(ws + WS_MOD); (void)mod
    volatile LAS unsigned* misc = (volatile LAS unsigned*)(lds0 + LDS_MISC);
    if (threadIdx.x < 4) misc[threadIdx.x] = 0u;
    __syncthreads();
    const int lo = kargs.ph_lo, hi = kargs.ph_hi;
    const bool use_bar = (hi - lo) > 1;
    XcdBarrier bar; bar.bar = (unsigned*)(kargs.ws + WS_CTL); bar.x = 0; bar.st = misc;
    if (use_bar) bar = xcd_barrier_post((unsigned*)(kargs.ws + WS_CTL), misc);
#ifndef PHMASK
#define PHMASK 0xFFFFFFFu
#endif
#define IN(k) ((((PHMASK) >> (k)) & 1u) && lo <= (k) && (k) < hi)
#define SEAM(k) do { if (IN(k) && IN((k) + 1)) xcd_barrier(bar); } while (0)
#ifndef REPK
#define REPK (-1)
#endif
#ifndef REP_NOSTORE
#define REP_NOSTORE 0
#endif
#define PHASE(k, ...) if (IN(k)) { { constexpr bool REPFLAG = false; (void)REPFLAG; __VA_ARGS__ } if (REPK == (k)) { xcd_barrier(bar); { constexpr bool REPFLAG = REP_NOSTORE != 0; (void)REPFLAG; __VA_ARGS__ } } } SEAM(k)
    LAS int* tstart = (LAS int*)(lds0 + LDS_MISC + 128); LAS int* lcnt = (LAS int*)(lds0 + LDS_MISC + 384);

    PHASE(0,  MKF(); p0_prologue(F, args););
    PHASE(1,  MKF(); p_modulate_in(F, args););
    PHASE(2,  MKF();
        pg8::PlainOrder S; S.init(TT, ABPAD, F.G, F.bid); pg8::EpiBf16 E{(bf16_t*)(ws + WS_U), ABPAD};
        pg8::gemm_phase(F.lds, (const bf16_t*)(ws + WS_HA), (const bf16_t*)(ws + WS_WIN0), S, E););
    PHASE(3,  MKF(); p_streams(F, args););
    PHASE(4,  MKF(); p_prep(F, args););
    PHASE(5,  MKF(); p_scan(F, args););
    PHASE(6,  MKF(); p_readout(F, args););
    PHASE(7,  MKF();
        pg8::PlainOrder S; S.init(TT, DM, F.G, F.bid); pg8::EpiResid<false> E{KIN(args, 0), KIN(args, 2), (bf16_t*)(ws + WS_XRES), mod + 2048};
        pg8::gemm_phase(F.lds, (const bf16_t*)(ws + WS_MIX), (const bf16_t*)(ws + WS_WOUT0), S, E););
    PHASE(8,  MKF(); p_route(F, args, 0, TT););
    PHASE(9,  MKF();
        moe_tables(F, args, 0, tstart, lcnt);
        pg8::MoeOrder S{tstart, lcnt, tstart + 224, (const int*)(ws + WS_LIST), 8, F.G, F.bid, true}; pg8::EpiSwiglu E{ws + WS_R1, KIN(args, 9)};
        pg8::gemm_phase(F.lds, (const bf16_t*)(ws + WS_HA), (const bf16_t*)(ws + WS_W1T), S, E););
    PHASE(10,  MKF();
        moe_tables(F, args, 0, tstart, lcnt);
        pg8::MoeOrder S{tstart, lcnt, tstart + 224, (const int*)(ws + WS_LIST), 4, F.G, F.bid, false}; pg8::EpiMoeOut E{ws + WS_R2, KIN(args, 11), (const int*)(ws + WS_LIST), (const float*)(ws + WS_SGATE)};
        pg8::gemm_phase(F.lds, (const bf16_t*)(ws + WS_R1), (const bf16_t*)(ws + WS_W2TM), S, E););
    PHASE(11,  MKF(); p_combine(F, args, 0, TT););
    PHASE(12,  MKF();
        pg8::PlainOrder S; S.init(TT, CDCOLS, F.G, F.bid); pg8::EpiBf16 E{(bf16_t*)(ws + WS_U), CDCOLS};
        pg8::gemm_phase(F.lds, (const bf16_t*)(ws + WS_HA), (const bf16_t*)(ws + WS_WIN1), S, E););
    PHASE(13,  MKF(); p_prep1(F, args););
    PHASE(14,  MKF(); p_na_hyena(F, args););
    PHASE(15,  MKF(); p_hy_back(F, args););
    PHASE(16,  MKF();
        pg8::PlainOrder S; S.init(TL, DM, F.G, F.bid); pg8::EpiResid<true> E{ws + WS_XRES, ws + WS_XRES, (bf16_t*)(ws + WS_XRES), mod + 5 * 6144 + 2048};
        pg8::gemm_phase(F.lds, (const bf16_t*)(ws + WS_MIX), (const bf16_t*)(ws + WS_WOUT1), S, E););
    PHASE(17,  MKF(); p_route(F, args, 1, TL););
    PHASE(18,  MKF();
        moe_tables(F, args, 1, tstart, lcnt);
        pg8::MoeOrder S{tstart, lcnt, tstart + 224, (const int*)(ws + WS_LIST), 8, F.G, F.bid, true}; pg8::EpiSwiglu E{ws + WS_R1, KIN(args, 9) + 32 * 2048};
        pg8::gemm_phase(F.lds, (const bf16_t*)(ws + WS_HA), (const bf16_t*)(ws + WS_W1T + (size_t)32 * 2048 * 1024), S, E););
    PHASE(19,  MKF();
        moe_tables(F, args, 1, tstart, lcnt);
        pg8::MoeOrder S{tstart, lcnt, tstart + 224, (const int*)(ws + WS_LIST), 4, F.G, F.bid, false}; pg8::EpiMoeOut E{ws + WS_R2, KIN(args, 11) + 32 * 1024, (const int*)(ws + WS_LIST), (const float*)(ws + WS_SGATE)};
        pg8::gemm_phase(F.lds, (const bf16_t*)(ws + WS_R1), (const bf16_t*)(ws + WS_W2TM + (size_t)32 * 1024 * 1024), S, E););
    PHASE(20,  MKF(); p_combine(F, args, 1, TL); );
#undef IN
#undef SEAM
#undef PHASE
}

#ifndef N_LAUNCH_MODE
#define N_LAUNCH_MODE 1
#endif
extern "C" void kernel_launch(void* const* d_in, const int* in_sizes, int n_in, void* d_out, int out_size, void* d_ws, size_t ws_size, hipStream_t stream) {
    static int grid = 0;
    if (grid == 0) {
        if (n_in != 41 || out_size != TL * DM || ws_size < WS_END) { fprintf(stderr, "kernel_launch: unexpected shapes: n_in %d out %d ws %zu (need %zu)\n", n_in, out_size, ws_size, (size_t)WS_END); grid = -1; return; }
        int dev = 0, cus = 0, per_cu = 0;
        if (hipGetDevice(&dev) != hipSuccess || hipDeviceGetAttribute(&cus, hipDeviceAttributeMultiprocessorCount, dev) != hipSuccess) { grid = -1; return; }
        if (hipFuncSetAttribute((const void*)fwd_kernel, hipFuncAttributeMaxDynamicSharedMemorySize, LDS_BYTES) != hipSuccess) { fprintf(stderr, "kernel_launch: hipFuncSetAttribute failed\n"); grid = -1; return; }
        if (hipOccupancyMaxActiveBlocksPerMultiprocessor(&per_cu, (const void*)fwd_kernel, NTHR, LDS_BYTES) != hipSuccess || per_cu < 1) { fprintf(stderr, "kernel_launch: occupancy query says %d blocks per CU\n", per_cu); }
        (void)hipGetLastError();
        grid = cus;
    }
    if (grid < 0) return;
    (void)hipMemsetAsync((char*)d_ws + WS_CTL, 0, CTL_BYTES, stream);
    Args a{};
    for (int i = 0; i < 41; ++i) a.in[i] = (const float*)d_in[i];
    a.out = (float*)d_out; a.ws = (unsigned char*)d_ws;
#if N_LAUNCH_MODE == 1
    a.ph_lo = 0; a.ph_hi = NPHASE;
    hipLaunchKernelGGL(fwd_kernel, dim3(grid), dim3(NTHR), LDS_BYTES, stream, a);
#else
    for (int p = 0; p < NPHASE; ++p) { a.ph_lo = p; a.ph_hi = p + 1; hipLaunchKernelGGL(fwd_kernel, dim3(grid), dim3(NTHR), LDS_BYTES, stream, a);
#ifdef REP_PHASE
        if (p == REP_PHASE) { if (p == 8 || p == 14 || p == 17) (void)hipMemsetAsync((char*)d_ws + WS_CTL + CW_CNT, 0, 4096, stream); hipLaunchKernelGGL(fwd_kernel, dim3(grid), dim3(NTHR), LDS_BYTES, stream, a); }
#endif
    }
#endif
}
```

```cpp
#include <hip/hip_runtime.h>
#include <cstdio>
#include <cstdint>

#define DI __device__ __forceinline__
#define LAS __attribute__((address_space(3)))
typedef unsigned short bf16_t;
typedef short bf16x8 __attribute__((ext_vector_type(8)));
typedef float f32x4 __attribute__((ext_vector_type(4)));
typedef float f32x2 __attribute__((ext_vector_type(2)));
typedef unsigned u32x4 __attribute__((ext_vector_type(4)));
typedef unsigned u32x2 __attribute__((ext_vector_type(2)));

constexpr int DM = 1024, NB = 4, SEQ = 8192, CL = 256;
constexpr int TL = NB * SEQ;
constexpr int TC = NB * CL;
constexpr int TT = TL + TC;
constexpr int ACOLS = 1920, ABCOLS = 4480, ABPAD = 4608, CDCOLS = 3072;
constexpr int NEXP = 32, TOPK = 4;
constexpr int NTHR = 512;

constexpr size_t al256(size_t x) { return (x + 255) & ~(size_t)255; }
constexpr size_t WS_CTL   = 0;
constexpr size_t CTL_BYTES = 32768;
constexpr size_t CW_CNT = 16384;
constexpr size_t CW_Q   = 16384 + 1024;
constexpr size_t WS_MOD   = WS_CTL + CTL_BYTES;
constexpr size_t WS_ROPE  = WS_MOD + al256(2 * 5 * 6144 * 4);
constexpr size_t WS_W2T   = WS_ROPE + 128 * 16 * 2 * 4;
constexpr size_t WS_A2T   = WS_W2T + 2 * 512 * 64 * 2;
constexpr size_t WS_G2T   = WS_A2T + 2 * 512 * 64 * 2;
constexpr size_t WS_WIN0  = WS_G2T + 512 * 128 * 2;
constexpr size_t WS_WOUT0 = WS_WIN0 + (size_t)ABPAD * DM * 2;
constexpr size_t WS_WIN1  = WS_WOUT0 + (size_t)DM * DM * 2;
constexpr size_t WS_WOUT1 = WS_WIN1 + (size_t)CDCOLS * DM * 2;
constexpr size_t WS_W1T   = WS_WOUT1 + (size_t)DM * DM * 2;
constexpr size_t WS_SGATE = WS_W1T + (size_t)2 * 32 * 2048 * 1024;
constexpr size_t WS_W2TM  = WS_W1T + (size_t)2 * 32 * 2048 * 1024 * 2;
constexpr size_t WS_HYF   = WS_W2TM + (size_t)2 * 32 * 1024 * 1024 * 2;
constexpr size_t WS_XRES  = WS_HYF + (size_t)4 * 512 * 8192 * 4;
constexpr size_t WS_HA    = WS_XRES + (size_t)TT * DM * 4;
constexpr size_t WS_MIX   = WS_HA + (size_t)TT * DM * 2;
constexpr size_t WS_GATE  = WS_MIX + (size_t)TT * DM * 2;
constexpr size_t WS_LIST  = WS_GATE + (size_t)TT * 4 * 4;
constexpr size_t WS_U     = WS_LIST + (size_t)32 * TT * 4;
constexpr size_t WS_R1    = WS_U + (size_t)TT * ABPAD * 2;
constexpr size_t R1_BYTES = (size_t)64 * 528 * (12288 + 7168) + (size_t)2 * TT * 512 * 2 + (size_t)2 * TT * 8 * 4;
constexpr size_t WS_R2    = WS_R1 + R1_BYTES;
constexpr size_t R2_BYTES = (size_t)4 * TT * 512 * 4;
constexpr size_t WS_END   = WS_R2 + R2_BYTES;
constexpr int HROWS = TT * 4 + 32 * 256;
static_assert((size_t)HROWS * 1024 * 2 <= R1_BYTES, "H fits region 1");
static_assert((size_t)TT * 4 * 1024 * 2 <= R2_BYTES, "Y fits region 2");
constexpr size_t STRB = (size_t)TT * 512 * 2;
constexpr size_t S_R = 0, S_V = 1, S_KK = 2, S_G = 3, S_LD0 = 4, S_LD1 = 5, S_B0 = 6, S_B1 = 7, S_KD0 = 8, S_KD1 = 9;
constexpr size_t L1_QN  = 0;
constexpr size_t L1_KN  = L1_QN + (size_t)TL * 512 * 2;
constexpr size_t L1_VT  = L1_KN + (size_t)TT * 512 * 2;
constexpr size_t L1_VCT = L1_VT + (size_t)4 * 512 * 8192 * 2;
constexpr size_t L1_HVT = L1_VCT + (size_t)4 * 512 * 256 * 2;
constexpr size_t L1_HYT = L1_HVT + (size_t)3 * 4 * 512 * 8192 * 2;
constexpr size_t L1_ZT  = L1_HYT + (size_t)4 * 512 * 8192 * 2;
static_assert(L1_ZT + (size_t)4 * 512 * 8192 * 4 <= R1_BYTES, "layer-1 buffers fit region 1");

constexpr int LDS_BYTES = 155648;
constexpr int LDS_MISC = 151552;

DI float bf2f(bf16_t b) { return __uint_as_float(((unsigned)b) << 16); }
typedef __bf16 bf16x2_t __attribute__((ext_vector_type(2)));
DI unsigned pack2(float lo, float hi) { const f32x2 v = (f32x2){lo, hi}; return __builtin_bit_cast(unsigned, __builtin_convertvector(v, bf16x2_t)); }
DI bf16_t f2bf(float f) { return (bf16_t)(pack2(f, 0.0f) & 0xFFFFu); }
DI float lo2f(unsigned w) { return __uint_as_float(w << 16); }
DI float hi2f(unsigned w) { return __uint_as_float(w & 0xFFFF0000u); }
DI float sigmoidf_(float x) { return 1.0f / (1.0f + __expf(-x)); }
DI float siluf_(float x) { return x / (1.0f + __expf(-x)); }
DI void load8bf(const bf16_t* p, float (&x)[8]) { const u32x4 w = *(const u32x4*)p; x[0] = lo2f(w.x); x[1] = hi2f(w.x); x[2] = lo2f(w.y); x[3] = hi2f(w.y); x[4] = lo2f(w.z); x[5] = hi2f(w.z); x[6] = lo2f(w.w); x[7] = hi2f(w.w); }
DI void store8bf(bf16_t* p, const float (&x)[8]) { u32x4 w; w.x = pack2(x[0], x[1]); w.y = pack2(x[2], x[3]); w.z = pack2(x[4], x[5]); w.w = pack2(x[6], x[7]); *(u32x4*)p = w; }
DI void load8f(const float* p, float (&x)[8]) { const f32x4 a = *(const f32x4*)p, b = *(const f32x4*)(p + 4); x[0] = a[0]; x[1] = a[1]; x[2] = a[2]; x[3] = a[3]; x[4] = b[0]; x[5] = b[1]; x[6] = b[2]; x[7] = b[3]; }
DI float wave_sum(float v) {
#pragma unroll
    for (int m = 32; m >= 1; m >>= 1) v += __shfl_xor(v, m, 64);
    return v;
}
template <int CTRL> DI float dppmov(float x) { return __builtin_bit_cast(float, __builtin_amdgcn_update_dpp(0, __builtin_bit_cast(int, x), CTRL, 0xF, 0xF, true)); }
DI float rowsum16(float x) { x += dppmov<0xB1>(x); x += dppmov<0x4E>(x); x += dppmov<0x141>(x); x += dppmov<0x140>(x); return x; }
DI float rowmax16(float x) { x = fmaxf(x, dppmov<0xB1>(x)); x = fmaxf(x, dppmov<0x4E>(x)); x = fmaxf(x, dppmov<0x141>(x)); x = fmaxf(x, dppmov<0x140>(x)); return x; }
DI float sum8(float x) { x += dppmov<0xB1>(x); x += dppmov<0x4E>(x); x += dppmov<0x141>(x); return x; }

#define XB_TMO      128
#define XB_XCNT(j)  (256  + 64 * (j))
#define XB_XSUB(j)  (1280 + 64 * (j))
#define XB_XGEN(j)  (2304 + 64 * (j))
#define XB_TOP      3328
#define XB_TOPGEN   3392
#define XCD_BAR_WORDS 3456
#define XB_SPIN_CAP (1u << 18)
DI unsigned xb_ld(unsigned* p)              { return __hip_atomic_load(p, __ATOMIC_RELAXED, __HIP_MEMORY_SCOPE_AGENT); }
DI unsigned xb_add(unsigned* p, unsigned v) { return __hip_atomic_fetch_add(p, v, __ATOMIC_RELAXED, __HIP_MEMORY_SCOPE_AGENT); }
DI unsigned xb_xcc_id() { return (unsigned)__builtin_amdgcn_s_getreg((3 << 11) | 20) & 0xFu; }
#define XB_SPIN(cond, bar) do { unsigned _sp = 0; while (cond) { __builtin_amdgcn_s_sleep(1); \
    if ((++_sp & 255u) == 0u) { if (xb_ld(&(bar)[XB_TMO])) break; if (_sp > XB_SPIN_CAP) { atomicAdd(&(bar)[XB_TMO], 1u); break; } } } } while (0)
struct XcdBarrier { unsigned* bar; unsigned x; volatile LAS unsigned* st; };
DI XcdBarrier xcd_barrier_post(unsigned* bar, volatile LAS unsigned* st) {
    XcdBarrier b; b.bar = bar; b.x = xb_xcc_id(); b.st = st;
    if (threadIdx.x == 0) (void)xb_add(&bar[XB_XCNT(b.x)], 1u);
    return b;
}
DI void xcd_barrier_complete(unsigned* bar, unsigned x, unsigned& nloc, unsigned& nx) {
    const unsigned G = gridDim.x * gridDim.y * gridDim.z;
    unsigned sum, cnt, mine, sp = 0u;
    for (;;) {
        sum = 0u; cnt = 0u; mine = 0u;
#pragma unroll
        for (unsigned j = 0; j < 16; ++j) { const unsigned c = xb_ld(&bar[XB_XCNT(j)]); sum += c; cnt += (c > 0u) ? 1u : 0u; mine = (j == x) ? c : mine; }
        if (sum == G) break;
        __builtin_amdgcn_s_sleep(1);
        if ((++sp & 255u) == 0u) { if (xb_ld(&bar[XB_TMO])) break; if (sp > XB_SPIN_CAP) { atomicAdd(&bar[XB_TMO], 1u); break; } }
    }
    nloc = mine > 0u ? mine : 1u; nx = cnt > 0u ? cnt : 1u;
}
DI void xcd_barrier(const XcdBarrier& b) {
    asm volatile("s_waitcnt vmcnt(0)" ::: "memory");
    __syncthreads();
    if (threadIdx.x == 0) {
        unsigned* bar = b.bar;
        __builtin_amdgcn_s_waitcnt(0);
        unsigned nloc = b.st[0], nx = b.st[1];
        if (nloc == 0u) { xcd_barrier_complete(bar, b.x, nloc, nx); b.st[0] = nloc; b.st[1] = nx; }
        const unsigned old = xb_add(&bar[XB_XSUB(b.x)], 1u);
        const unsigned gen = old / nloc;
        if (old + 1u == (gen + 1u) * nloc) {
            __builtin_amdgcn_fence(__ATOMIC_RELEASE, "agent");
            asm volatile("s_waitcnt vmcnt(0)" ::: "memory");
            const unsigned og = xb_add(&bar[XB_TOP], 1u);
            const unsigned tg = og / nx;
            if (og + 1u == (tg + 1u) * nx) xb_add(&bar[XB_TOPGEN], 1u);
            else XB_SPIN(xb_ld(&bar[XB_TOPGEN]) == tg, bar);
            __builtin_amdgcn_fence(__ATOMIC_ACQUIRE, "agent");
            xb_add(&bar[XB_XGEN(b.x)], 1u);
            asm volatile("s_waitcnt vmcnt(0)" ::: "memory");
        } else {
            XB_SPIN(xb_ld(&bar[XB_XGEN(b.x)]) == gen, bar);
            __builtin_amdgcn_fence(__ATOMIC_ACQUIRE, "agent");
            asm volatile("s_waitcnt vmcnt(0)" ::: "memory");
        }
    }
    __syncthreads();
}

DI void lds_barrier() { asm volatile("s_waitcnt lgkmcnt(0)" ::: "memory"); __builtin_amdgcn_s_barrier(); asm volatile("" ::: "memory"); }

struct Args {
    const float* in[41];
    float* out; unsigned char* ws;
    int ph_lo, ph_hi;
};
struct Frame {
    LAS unsigned char* lds;
    unsigned char* ws;
    int tid, lane, wave, G, bid;
};
struct KArgs { unsigned long long kp; unsigned char* ws; float* out; };
template <int OFF> DI unsigned long long kload(unsigned long long kp) { unsigned long long v; asm("s_load_dwordx2 %0, %1, %2\n\ts_waitcnt lgkmcnt(0)" : "=s"(v) : "s"(kp), "n"(OFF)); return v; }
#define GAS __attribute__((address_space(1)))
#define KIN(a, N) ((const float*)(GAS const float*)kload<(N) * 8>((a).kp))
typedef int i32x8 __attribute__((ext_vector_type(8)));
typedef int i32x4v __attribute__((ext_vector_type(4)));
DI unsigned pack4_fp8(float a, float b, float c, float d) { int w = __builtin_amdgcn_cvt_pk_fp8_f32(a, b, 0, false); w = __builtin_amdgcn_cvt_pk_fp8_f32(c, d, w, true); return (unsigned)w; }
DI float clamp8(float x) { return __builtin_fminf(__builtin_fmaxf(x, -448.f), 448.f); }
constexpr float Q8_W = 64.f, Q8_H = 4.f, Q8_Y = 16.f;
namespace pg8 {
constexpr int BM = 256, BK = 64, HALF = 128, HTB = HALF * BK * 2, STAGE_BYTES = 8 * HTB, NXCD = 8, WGM = 8, KD = 1024;
DI int lds_byte(int r, int c) { const int st = (r >> 4) * 2 + (c >> 5), rr = r & 15, cc = c & 31, ob = rr * 64 + cc * 2; return st * 1024 + (ob ^ (((ob >> 9) & 1) << 5)); }
DI void stage_rc(int b, int& R, int& C) { const int st = b / 1024, sb = b % 1024, swz = sb ^ (((sb >> 9) & 1) << 5); R = (st >> 1) * 16 + swz / 64; C = (st & 1) * 32 + (swz % 64) / 2; }
DI int perm32(int rho) { const int n = rho >> 4, i = rho & 15; return 8 * (i >> 2) + 4 * n + (i & 3); }
DI unsigned cvt_pk_bf16(float lo, float hi) { return pack2(lo, hi); }

struct Unit { int pm, pn, e, nvalid, slot0; };
template <bool PERM, bool FP8> DI void lane_rc(int (&Rr)[2], int (&Rb)[2], int (&Cc)[2]) {
    int tid = threadIdx.x; asm volatile("" : "+v"(tid));
#pragma unroll
    for (int i = 0; i < 2; ++i) { int R, C; stage_rc(tid * 16 + i * 8192, R, C); Rr[i] = R; Cc[i] = C * 2; Rb[i] = PERM ? ((R & ~31) + perm32(R & 31)) : R; }
}
template <int CM> DI int brow(int h, int rb) { return CM == 0 ? h * HALF + rb : (rb >> 5) * 64 + ((rb & 31) >> 3) * 16 + h * 8 + (rb & 7); }
constexpr int PRM_BASE = STAGE_BYTES, PRM_BYTES = 4096, PRM_VEC = 0, PRM_AID = 1024, PRM_GATE = 2048, PRM_NIDX = 3072;
DI void dma1k(const void* base, unsigned byte_off, unsigned lds_addr) {
    GAS const char* g = (GAS const char*)base + __builtin_amdgcn_readfirstlane(byte_off);
    const unsigned lo = ((unsigned)threadIdx.x & 63u) * 16u;
    asm volatile("s_mov_b32 m0, %2\n\ts_nop 0\n\tglobal_load_lds_dwordx4 %0, %1" :: "v"(lo), "s"(g), "s"(__builtin_amdgcn_readfirstlane(lds_addr)) : "memory", "m0");
}
struct PlainOrder {
    int nM, nN, nwg, G, c;
    DI void init(int M, int N, int G_, int c_) { nM = M / BM; nN = N / BM; nwg = nM * nN; G = G_; c = c_; }
    DI bool next(int i, Unit& u) const {
        const long L = (long)i * G + c; if (L >= nwg) return false;
        int wgid = (int)L; { const int q = nwg / NXCD, r = nwg % NXCD, xcd = wgid % NXCD, off = wgid / NXCD; wgid = (xcd < r ? xcd * (q + 1) : r * (q + 1) + (xcd - r) * q) + off; }
        const int nig = WGM * nN, gid = wgid / nig, fm = gid * WGM, gsz = (nM - fm) < WGM ? (nM - fm) : WGM;
        u.pm = fm + ((wgid % nig) % gsz); u.pn = (wgid % nig) / gsz; u.e = 0; u.nvalid = 256; u.slot0 = 0; return true;
    }
    DI void prefetch(const Unit&, unsigned, int) const {}
    template <bool PERM, bool FP8, int CM> DI void finish(const Unit& u, const LAS int*, unsigned (&va)[2][2], unsigned (&vb)[2][2]) const { offsets<PERM, FP8, CM>(u, va, vb); }
    template <bool PERM, bool FP8, int CM> DI void offsets(const Unit& u, unsigned (&va)[2][2], unsigned (&vb)[2][2]) const {
        int R[2], Rb[2], C[2]; lane_rc<PERM, FP8>(R, Rb, C);
        constexpr int ROWB = FP8 ? KD : KD * 2;
#pragma unroll
        for (int h = 0; h < 2; ++h)
#pragma unroll
            for (int i = 0; i < 2; ++i) {
                va[h][i] = (unsigned)((u.pm * BM + h * HALF + R[i]) * ROWB + C[i]);
                vb[h][i] = (unsigned)((u.pn * BM + brow<CM>(h, Rb[i])) * ROWB + C[i]);
            }
    }
};

struct MoeOrder {
    const LAS int* tstart; const LAS int* cnt; const LAS int* tile_e; const int* list;
    int NT, G, c; bool gather;
    DI bool next(int i, Unit& u) const {
        const int total = tstart[32] * NT;
        long L = (long)i * G + c;
        if (G == 256) L = ((long)i * 8 + (c & 7)) * 32 + (c >> 3);
        if (L >= total) return false;
        const int mt = (int)(L / NT); u.pn = (int)(L % NT);
        const int e = tile_e[mt];
        u.e = e; u.pm = mt - tstart[e]; const int rem = cnt[e] - u.pm * BM; u.nvalid = rem < BM ? rem : BM; u.slot0 = mt * BM; return true;
    }
    DI void prefetch(const Unit& n, unsigned prm, int wid) const {
        if (gather && wid == 3) dma1k(list, (unsigned)(((size_t)n.e * TT + n.pm * BM) * 4), prm + PRM_NIDX);
    }
    template <bool PERM, bool FP8, int CM> DI void finish(const Unit& u, const LAS int* nidx, unsigned (&va)[2][2], unsigned (&vb)[2][2]) const {
        int R[2], Rb[2], C[2]; lane_rc<PERM, FP8>(R, Rb, C);
        const int ncols = NT * BM;
        constexpr int ROWB = FP8 ? KD : KD * 2;
#pragma unroll
        for (int h = 0; h < 2; ++h)
#pragma unroll
            for (int i = 0; i < 2; ++i) {
                const int rl = h * HALF + R[i];
                int arow;
                if (gather) { const int idx = rl < u.nvalid ? rl : 0; arow = nidx[idx] >> 2; }
                else arow = u.slot0 + rl;
                va[h][i] = (unsigned)(arow * ROWB + C[i]);
                vb[h][i] = (unsigned)(((u.e * ncols) + u.pn * BM + brow<CM>(h, Rb[i])) * ROWB + C[i]);
            }
    }
    template <bool PERM, bool FP8, int CM> DI void offsets(const Unit& u, unsigned (&va)[2][2], unsigned (&vb)[2][2]) const {
        int R[2], Rb[2], C[2]; lane_rc<PERM, FP8>(R, Rb, C);
        const int ncols = NT * BM;
        constexpr int ROWB = FP8 ? KD : KD * 2;
#pragma unroll
        for (int h = 0; h < 2; ++h)
#pragma unroll
            for (int i = 0; i < 2; ++i) {
                const int rl = h * HALF + R[i];
                int arow;
                if (gather) { const int idx = rl < u.nvalid ? rl : 0; arow = list[(size_t)u.e * TT + u.pm * BM + idx] >> 2; }
                else arow = u.slot0 + rl;
                va[h][i] = (unsigned)(arow * ROWB + C[i]);
                vb[h][i] = (unsigned)(((u.e * ncols) + u.pn * BM + brow<CM>(h, Rb[i])) * ROWB + C[i]);
            }
    }
};
DI i32x8 cat8(bf16x8 lo, bf16x8 hi) { const i32x4v a = __builtin_bit_cast(i32x4v, lo), b = __builtin_bit_cast(i32x4v, hi); return __builtin_shufflevector(a, b, 0, 1, 2, 3, 4, 5, 6, 7); }

template <int SLP = 0, class Epi, class Sched>
DI void gemm_phase(LAS unsigned char* lds, const bf16_t* Abase, const bf16_t* Bbase, const Sched& S, const Epi& E) {
    const int tid = threadIdx.x, wid = __builtin_amdgcn_readfirstlane(tid >> 6), lane = tid & 63, wr = wid >> 2, wc = wid & 3, fr = lane & 15, fq = lane >> 4;
    constexpr bool FP8 = Epi::FP8;
    constexpr int nt = FP8 ? KD / (2 * BK) : KD / BK;
    constexpr size_t kstep = (size_t)(BK * 2);
    const unsigned ldsw = (unsigned)wid * 1024u;
    const unsigned ldsb = (unsigned)(size_t)lds + ldsw;
    const int aoff = lds_byte(wr * 64 + fr, fq * 8), boff = lds_byte(wc * 32 + fr, fq * 8);
    const char* const Ab = (const char*)Abase; const char* const Bb = (const char*)Bbase;
#define PG8_SA(b, h) (((b) * 2 + (h)) * HTB)
#define PG8_SB(b, h) ((4 + (b) * 2 + (h)) * HTB)
#define PG8_STAGE(bufoff, gbase, voff) do { GAS const char* g_ = (GAS const char*)(gbase); _Pragma("unroll") for (int _i = 0; _i < 2; ++_i) \
        asm volatile("s_mov_b32 m0, %2\n\ts_nop 0\n\tglobal_load_lds_dwordx4 %0, %1" :: "v"((voff)[_i]), "s"(g_), "s"(ldsb + (unsigned)((bufoff) + _i * 8192)) : "memory", "m0"); } while (0)
#define PG8_LDA(dst, b, h) do { _Pragma("unroll") for (int m = 0; m < 4; ++m) _Pragma("unroll") for (int k = 0; k < 2; ++k) dst[m][k] = *(const LAS bf16x8*)(lds + PG8_SA(b, h) + aoff + m * 2048 + k * 1024); } while (0)
#define PG8_LDB(dst, b, h) do { _Pragma("unroll") for (int n = 0; n < 2; ++n) _Pragma("unroll") for (int k = 0; k < 2; ++k) dst[n][k] = *(const LAS bf16x8*)(lds + PG8_SB(b, h) + boff + n * 2048 + k * 1024); } while (0)
#define PG8_LDA8(dst, b, h) do { _Pragma("unroll") for (int m = 0; m < 4; ++m) { const i32x4v lo_ = *(const LAS i32x4v*)(lds + PG8_SA(b, h) + aoff + m * 2048), hi_ = *(const LAS i32x4v*)(lds + PG8_SA(b, h) + aoff + m * 2048 + 1024); \
        dst[m] = __builtin_shufflevector(lo_, hi_, 0, 1, 2, 3, 4, 5, 6, 7); } } while (0)
#define PG8_LDB8(dst, b, h) do { _Pragma("unroll") for (int n = 0; n < 2; ++n) { const i32x4v lo_ = *(const LAS i32x4v*)(lds + PG8_SB(b, h) + boff + n * 2048), hi_ = *(const LAS i32x4v*)(lds + PG8_SB(b, h) + boff + n * 2048 + 1024); \
        dst[n] = __builtin_shufflevector(lo_, hi_, 0, 1, 2, 3, 4, 5, 6, 7); } } while (0)
#define PG8_MMA(ai, bj, At, Bt) do { __builtin_amdgcn_s_setprio(1); _Pragma("unroll") for (int k = 0; k < 2; ++k) _Pragma("unroll") for (int m = 0; m < 4; ++m) _Pragma("unroll") for (int n = 0; n < 2; ++n) \
        asm volatile("v_mfma_f32_16x16x32_bf16 %0, %1, %2, %0" : "+v"(acc[ai][bj][m][n]) : "v"(Bt[n][k]), "v"(At[m][k])); __builtin_amdgcn_s_setprio(0); } while (0)
#define PG8_MMA8(ai, bj, At, Bt) do { __builtin_amdgcn_s_setprio(1); _Pragma("unroll") for (int m = 0; m < 4; ++m) _Pragma("unroll") for (int n = 0; n < 2; ++n) \
        asm volatile("v_mfma_f32_16x16x128_f8f6f4 %0, %1, %2, %0" : "+v"(acc[ai][bj][m][n]) : "v"(Bt[n]), "v"(At[m])); __builtin_amdgcn_s_setprio(0); } while (0)
#define PG8_MMA_I(ai, bj, At, Bt) do { __builtin_amdgcn_s_setprio(1); _Pragma("unroll") for (int m = 0; m < 4; ++m) _Pragma("unroll") for (int n = 0; n < 2; ++n) \
        asm volatile("v_mfma_f32_16x16x32_bf16 %0, %1, %2, 0" : "=v"(acc[ai][bj][m][n]) : "v"(Bt[n][0]), "v"(At[m][0])); \
        _Pragma("unroll") for (int m = 0; m < 4; ++m) _Pragma("unroll") for (int n = 0; n < 2; ++n) \
        asm volatile("v_mfma_f32_16x16x32_bf16 %0, %1, %2, %0" : "+v"(acc[ai][bj][m][n]) : "v"(Bt[n][1]), "v"(At[m][1])); __builtin_amdgcn_s_setprio(0); } while (0)
#define PG8_MMA8_I(ai, bj, At, Bt) do { __builtin_amdgcn_s_setprio(1); _Pragma("unroll") for (int m = 0; m < 4; ++m) _Pragma("unroll") for (int n = 0; n < 2; ++n) \
        asm volatile("v_mfma_f32_16x16x128_f8f6f4 %0, %1, %2, 0" : "=v"(acc[ai][bj][m][n]) : "v"(Bt[n]), "v"(At[m])); __builtin_amdgcn_s_setprio(0); } while (0)
#define PG8_MM_I(ai, bj, AtX, BtX) do { if constexpr (FP8) PG8_MMA8_I(ai, bj, AtX##8, BtX##8); else PG8_MMA_I(ai, bj, AtX, BtX); } while (0)
#define PG8_MM(ai, bj, AtX, BtX) do { if constexpr (FP8) PG8_MMA8(ai, bj, AtX##8, BtX##8); else PG8_MMA(ai, bj, AtX, BtX); } while (0)
#define PG8_LA(AtX, b, h) do { if constexpr (FP8) PG8_LDA8(AtX##8, b, h); else PG8_LDA(AtX, b, h); } while (0)
#define PG8_LB(BtX, b, h) do { if constexpr (FP8) PG8_LDB8(BtX##8, b, h); else PG8_LDB(BtX, b, h); } while (0)
#define PG8_WAIT_V(n) asm volatile("s_waitcnt vmcnt(" #n ")" ::: "memory")
#define PG8_WAIT_L(n) asm volatile("s_waitcnt lgkmcnt(" #n ")" ::: "memory")
#define PG8_BAR __builtin_amdgcn_s_barrier()
#define PG8_SCHED __builtin_amdgcn_sched_barrier(0)
    Unit cur, nxt; int ui = 0;
    if (!S.next(0, cur)) return;
    if constexpr (SLP > 0) { const int slot = (blockIdx.x >> 3) & 31;
#pragma unroll 1
        for (int i = 0; i < slot; ++i) __builtin_amdgcn_s_sleep(SLP); }
    f32x4 acc[2][2][4][2];
    bf16x8 At[4][2], B0[2][2], B1[2][2];
    i32x8 At8[4], B08[2], B18[2];
    unsigned vaC[2][2], vbC[2][2], vaN[2][2], vbN[2][2];
    S.template offsets<Epi::PERM, FP8, Epi::CM>(cur, vaC, vbC);
    PG8_STAGE(PG8_SB(0, 0), Bb, vbC[0]); PG8_STAGE(PG8_SA(0, 0), Ab, vaC[0]); PG8_STAGE(PG8_SB(0, 1), Bb, vbC[1]); PG8_STAGE(PG8_SA(0, 1), Ab, vaC[1]);
    if (wr == 1) PG8_BAR;
    PG8_WAIT_V(4); PG8_BAR;
    PG8_STAGE(PG8_SB(1, 0), Bb + kstep, vbC[0]); PG8_STAGE(PG8_SA(1, 0), Ab + kstep, vaC[0]); PG8_STAGE(PG8_SB(1, 1), Bb + kstep, vbC[1]);
    PG8_WAIT_V(6); PG8_BAR;
    for (;;) {
        const bool has_next = S.next(ui + 1, nxt);
        const unsigned prm = (unsigned)(size_t)lds + (unsigned)(PRM_BASE + (ui & 1) * PRM_BYTES);
        const LAS unsigned char* const prmp = lds + PRM_BASE + (ui & 1) * PRM_BYTES;
        E.prefetch(cur, prm, wid);
        if (has_next) S.prefetch(nxt, prm, wid);
#define PG8_KBODY(K1, K2, K3, VA2, VB2, MMF) do { \
              \
            PG8_LB(B0, 0, 0); PG8_SCHED; PG8_LA(At, 0, 0); PG8_STAGE(PG8_SA(1, 1), Ab + (K1), vaC[1]); \
            PG8_WAIT_L(8); PG8_BAR; PG8_WAIT_L(0); MMF(0, 0, At, B0); PG8_BAR; PG8_SCHED; \
              \
            PG8_LB(B1, 0, 1); PG8_STAGE(PG8_SB(0, 0), Bb + (K2), VB2[0]); \
            PG8_BAR; PG8_WAIT_L(0); MMF(0, 1, At, B1); PG8_BAR; \
              \
            PG8_LA(At, 0, 1); PG8_STAGE(PG8_SA(0, 0), Ab + (K2), VA2[0]); \
            PG8_BAR; PG8_WAIT_L(0); MMF(1, 0, At, B0); PG8_BAR; PG8_SCHED; \
              \
            PG8_STAGE(PG8_SB(0, 1), Bb + (K2), VB2[1]); \
            PG8_WAIT_V(6); PG8_BAR; MMF(1, 1, At, B1); PG8_BAR; \
              \
            PG8_LB(B0, 1, 0); PG8_SCHED; PG8_LA(At, 1, 0); PG8_STAGE(PG8_SA(0, 1), Ab + (K2), VA2[1]); \
            PG8_WAIT_L(8); PG8_BAR; PG8_WAIT_L(0); PG8_MM(0, 0, At, B0); PG8_BAR; PG8_SCHED; \
              \
            PG8_LB(B1, 1, 1); PG8_STAGE(PG8_SB(1, 0), Bb + (K3), VB2[0]); \
            PG8_BAR; PG8_WAIT_L(0); PG8_MM(0, 1, At, B1); PG8_BAR; \
              \
            PG8_LA(At, 1, 1); PG8_STAGE(PG8_SA(1, 0), Ab + (K3), VA2[0]); \
            PG8_BAR; PG8_WAIT_L(0); PG8_MM(1, 0, At, B0); PG8_BAR; PG8_SCHED; \
              \
            PG8_STAGE(PG8_SB(1, 1), Bb + (K3), VB2[1]); \
            PG8_WAIT_V(6); PG8_BAR; PG8_MM(1, 1, At, B1); PG8_BAR; } while (0)
        PG8_KBODY(kstep, 2 * kstep, 3 * kstep, vaC, vbC, PG8_MM_I);
#pragma unroll 1
        for (int t = 2; t < nt - 2; t += 2) {
            const size_t k1 = (size_t)(t + 1) * kstep, k2 = (size_t)(t + 2) * kstep, k3 = k2 + kstep;
            PG8_KBODY(k1, k2, k3, vaC, vbC, PG8_MM);
        }
        if (has_next) S.template finish<Epi::PERM, FP8, Epi::CM>(nxt, (const LAS int*)(prmp + PRM_NIDX), vaN, vbN);
        else {
#pragma unroll
            for (int h = 0; h < 2; ++h)
#pragma unroll
                for (int i = 0; i < 2; ++i) { vaN[h][i] = vaC[h][i]; vbN[h][i] = vbC[h][i]; }
        }
        PG8_KBODY((size_t)(nt - 1) * kstep, (size_t)0, kstep, vaN, vbN, PG8_MM);
        asm volatile("s_nop 15\n\ts_nop 15" ::: "memory");
        E(acc, cur, wr, wc, fr, fq, prmp);
        if (!has_next) break;
        cur = nxt; ++ui;
#pragma unroll
        for (int h = 0; h < 2; ++h)
#pragma unroll
            for (int i = 0; i < 2; ++i) { vaC[h][i] = vaN[h][i]; vbC[h][i] = vbN[h][i]; }
    }
    PG8_WAIT_V(0);
    if (wr == 0) PG8_BAR;
    PG8_BAR;
#undef PG8_KBODY
#undef PG8_SA
#undef PG8_SB
#undef PG8_STAGE
#undef PG8_LDA
#undef PG8_LDB
#undef PG8_MMA
#undef PG8_MMA8
#undef PG8_LDA8
#undef PG8_LDB8
#undef PG8_LA
#undef PG8_LB
#undef PG8_MM
#undef PG8_MM_I
#undef PG8_MMA_I
#undef PG8_MMA8_I
#undef PG8_WAIT_V
#undef PG8_WAIT_L
#undef PG8_BAR
#undef PG8_SCHED
}

struct EpiBf16 {
    static constexpr bool PERM = true, FP8 = false; static constexpr int CM = 0;
    bf16_t* O; int ldc;
    DI void prefetch(const Unit&, unsigned, int) const {}
    DI void operator()(const f32x4 (&acc)[2][2][4][2], const Unit& u, int wr, int wc, int fr, int fq, const LAS unsigned char*) const {
        const int row0 = u.pm * BM + wr * 64 + fr, col0 = u.pn * BM + wc * 32 + 8 * fq;
#pragma unroll
        for (int ai = 0; ai < 2; ++ai)
#pragma unroll
            for (int m = 0; m < 4; ++m) { bf16_t* rowp = O + (size_t)(row0 + ai * HALF + m * 16) * ldc + col0;
#pragma unroll
                for (int bj = 0; bj < 2; ++bj) { const f32x4 v0 = acc[ai][bj][m][0], v1 = acc[ai][bj][m][1];
                    u32x4 w; w.x = cvt_pk_bf16(v0[0], v0[1]); w.y = cvt_pk_bf16(v0[2], v0[3]); w.z = cvt_pk_bf16(v1[0], v1[1]); w.w = cvt_pk_bf16(v1[2], v1[3]);
                    *(u32x4*)(rowp + bj * HALF) = w; } }
    }
};
template <bool SRCBF> struct EpiResid {
    static constexpr bool PERM = true, FP8 = false; static constexpr int CM = 0;
    const void* src0; const void* src1; bf16_t* dst; const float* gate;
    DI void prefetch(const Unit& u, unsigned prm, int wid) const {
        const int tile_row = u.pm * BM, sel = tile_row < TL ? tile_row / SEQ : 4;
        if (wid == 0) dma1k(gate, (unsigned)((sel * 6144 + u.pn * BM) * 4), prm + PRM_VEC);
    }
    DI void operator()(const f32x4 (&acc)[2][2][4][2], const Unit& u, int wr, int wc, int fr, int fq, const LAS unsigned char* prmp) const {
        const int row0 = u.pm * BM + wr * 64 + fr, cl0 = wc * 32 + 8 * fq, col0 = u.pn * BM + cl0;
        const int tile_row = u.pm * BM;
        const size_t soff = tile_row < TL ? (size_t)0 : (size_t)TL * DM;
        const void* sbase = tile_row < TL ? src0 : src1;
        f32x4 gv[2][2];
#pragma unroll
        for (int bj = 0; bj < 2; ++bj)
#pragma unroll
            for (int n = 0; n < 2; ++n) gv[bj][n] = *(const LAS f32x4*)(prmp + PRM_VEC + (cl0 + bj * HALF + 4 * n) * 4);
#pragma unroll
        for (int ai = 0; ai < 2; ++ai)
#pragma unroll
            for (int m = 0; m < 4; ++m) { const size_t ro = (size_t)(row0 + ai * HALF + m * 16) * DM + col0;
#pragma unroll
                for (int bj = 0; bj < 2; ++bj) { f32x4 x0, x1;
                    if constexpr (SRCBF) { const u32x4 q = *(const u32x4*)((const bf16_t*)sbase + (ro - soff) + bj * HALF);
                        x0 = (f32x4){lo2f(q.x), hi2f(q.x), lo2f(q.y), hi2f(q.y)}; x1 = (f32x4){lo2f(q.z), hi2f(q.z), lo2f(q.w), hi2f(q.w)}; }
                    else { const float* sp = (const float*)sbase + (ro - soff) + bj * HALF; x0 = *(const f32x4*)sp; x1 = *(const f32x4*)(sp + 4); }
                    const f32x4 r0 = x0 + gv[bj][0] * acc[ai][bj][m][0], r1 = x1 + gv[bj][1] * acc[ai][bj][m][1];
                    u32x4 w; w.x = cvt_pk_bf16(r0[0], r0[1]); w.y = cvt_pk_bf16(r0[2], r0[3]); w.z = cvt_pk_bf16(r1[0], r1[1]); w.w = cvt_pk_bf16(r1[2], r1[3]);
                    *(u32x4*)(dst + ro + bj * HALF) = w; } }
    }
};
DI float swiglu1(float glu, float lin) {
    glu = fminf(glu, 7.0f); lin = fminf(fmaxf(lin, -7.0f), 7.0f);
    return glu * __builtin_amdgcn_rcpf(1.0f + __builtin_amdgcn_exp2f(-1.702f * 1.44269504f * glu)) * (lin * Q8_H + Q8_H);
}
struct EpiSwiglu {
    static constexpr bool PERM = true, FP8 = true; static constexpr int CM = 0;
    unsigned char* H; const float* b1;
    DI void prefetch(const Unit& u, unsigned prm, int wid) const { if (wid == 0) dma1k(b1, (unsigned)((u.e * 2048 + u.pn * BM) * 4), prm + PRM_VEC); }
    DI void operator()(const f32x4 (&acc)[2][2][4][2], const Unit& u, int wr, int wc, int fr, int fq, const LAS unsigned char* prmp) const {
        const int row0 = u.slot0 + wr * 64 + fr, colh = u.pn * 128 + wc * 32 + 8 * fq;
        f32x4 bv[2][2];
#pragma unroll
        for (int bj = 0; bj < 2; ++bj)
#pragma unroll
            for (int n = 0; n < 2; ++n) bv[bj][n] = *(const LAS f32x4*)(prmp + PRM_VEC + (wc * 64 + 16 * fq + 8 * bj + 4 * n) * 4);
        constexpr float ds = 1.0f / Q8_W;
#pragma unroll
        for (int ai = 0; ai < 2; ++ai)
#pragma unroll
            for (int m = 0; m < 4; ++m) { unsigned char* rowp = H + (size_t)(row0 + ai * HALF + m * 16) * 1024 + colh;
                u32x2 w;
#pragma unroll
                for (int bj = 0; bj < 2; ++bj) { const f32x4 v0 = acc[ai][bj][m][0] * ds + bv[bj][0], v1 = acc[ai][bj][m][1] * ds + bv[bj][1];
                    const unsigned p = pack4_fp8(swiglu1(v0[0], v0[1]), swiglu1(v0[2], v0[3]), swiglu1(v1[0], v1[1]), swiglu1(v1[2], v1[3]));
                    if (bj == 0) w.x = p; else w.y = p; }
                *(u32x2*)rowp = w; }
    }
};
struct EpiMoeOut {
    static constexpr bool PERM = true, FP8 = true; static constexpr int CM = 2;
    unsigned char* Y; const float* b2; const int* list; const float* sgate;
    DI void prefetch(const Unit& u, unsigned prm, int wid) const {
        const unsigned lo = (unsigned)(((size_t)u.e * TT + u.pm * BM) * 4);
        if (wid == 0) dma1k(b2, (unsigned)((u.e * 1024 + u.pn * BM) * 4), prm + PRM_VEC);
        if (wid == 1) dma1k(list, lo, prm + PRM_AID);
        if (wid == 2) dma1k(sgate, lo, prm + PRM_GATE);
    }
    DI void operator()(const f32x4 (&acc)[2][2][4][2], const Unit& u, int wr, int wc, int fr, int fq, const LAS unsigned char* prmp) const {
        const int rl0 = wr * 64 + fr, cl0 = wc * 64 + 16 * fq;
        constexpr float ds = 1.0f / (Q8_W * Q8_H);
        f32x4 bv[2][2];
#pragma unroll
        for (int bj = 0; bj < 2; ++bj)
#pragma unroll
            for (int n = 0; n < 2; ++n) bv[bj][n] = *(const LAS f32x4*)(prmp + PRM_VEC + (cl0 + bj * 8 + 4 * n) * 4);
#pragma unroll
        for (int ai = 0; ai < 2; ++ai)
#pragma unroll
            for (int m = 0; m < 4; ++m) { const int rl = rl0 + ai * HALF + m * 16;
                if (rl < u.nvalid) {
                    const int aid = *(const LAS int*)(prmp + PRM_AID + rl * 4); const float gt = *(const LAS float*)(prmp + PRM_GATE + rl * 4) * Q8_Y;
                    u32x4 w;
#pragma unroll
                    for (int bj = 0; bj < 2; ++bj) { const f32x4 v0 = (acc[ai][bj][m][0] * ds + bv[bj][0]) * gt, v1 = (acc[ai][bj][m][1] * ds + bv[bj][1]) * gt;
                        const unsigned p0 = pack4_fp8(clamp8(v0[0]), clamp8(v0[1]), clamp8(v0[2]), clamp8(v0[3])), p1 = pack4_fp8(clamp8(v1[0]), clamp8(v1[1]), clamp8(v1[2]), clamp8(v1[3]));
                        if (bj == 0) { w.x = p0; w.y = p1; } else { w.z = p0; w.w = p1; } }
                    *(u32x4*)(Y + (size_t)aid * 1024 + u.pn * BM + cl0) = w; } }
    }
};
}
constexpr int TR_W1 = 0, TR_W2 = 8192, TR_WIN0 = 12288, TR_WOUT0 = 12576, TR_WIN1 = 12640, TR_WOUT1 = 12832, TR_SW2 = 12896, TR_SA2 = 12900, TR_SG2 = 12904, NTR = 12908;
constexpr int P0_MOD = NTR, P0_FIL = NTR + 384, P0_ROPE = P0_FIL + 256, P0_UNITS = P0_ROPE + 1;

struct TrJob { const float* src; bf16_t* dst; int K, N, Npad, kt, nt, q8; };
DI TrJob tr_job(const KArgs& a, int u) {
    TrJob j; unsigned char* ws = a.ws; j.q8 = 0;
    if (u < TR_W2) { const int m = u / 128, r = u % 128; j.src = KIN(a, 8) + (size_t)m * 1024 * 2048; j.dst = (bf16_t*)(ws + WS_W1T + (size_t)m * 2048 * 1024); j.q8 = 2; j.K = 1024; j.N = 2048; j.Npad = 2048; j.kt = r / 8; j.nt = r % 8; }
    else if (u < TR_WIN0) { const int v = u - TR_W2, m = v / 64, r = v % 64; j.src = KIN(a, 10) + (size_t)m * 1024 * 1024; j.dst = (bf16_t*)(ws + WS_W2TM + (size_t)m * 1024 * 1024); j.q8 = 1; j.K = 1024; j.N = 1024; j.Npad = 1024; j.kt = r / 4; j.nt = r % 4; }
    else if (u < TR_WOUT0) { const int r = u - TR_WIN0; j.src = KIN(a, 12); j.dst = (bf16_t*)(ws + WS_WIN0); j.K = 1024; j.N = ABCOLS; j.Npad = ABPAD; j.kt = r / 18; j.nt = r % 18; }
    else if (u < TR_WIN1) { const int r = u - TR_WOUT0; j.src = KIN(a, 13); j.dst = (bf16_t*)(ws + WS_WOUT0); j.K = 1024; j.N = 1024; j.Npad = 1024; j.kt = r / 4; j.nt = r % 4; }
    else if (u < TR_WOUT1) { const int r = u - TR_WIN1; j.src = KIN(a, 27); j.dst = (bf16_t*)(ws + WS_WIN1); j.K = 1024; j.N = CDCOLS; j.Npad = CDCOLS; j.kt = r / 12; j.nt = r % 12; }
    else if (u < TR_SW2) { const int r = u - TR_WOUT1; j.src = KIN(a, 28); j.dst = (bf16_t*)(ws + WS_WOUT1); j.K = 1024; j.N = 1024; j.Npad = 1024; j.kt = r / 4; j.nt = r % 4; }
    else if (u < TR_SA2) { const int r = u - TR_SW2, m = r / 2; j.src = KIN(a, 16) + (size_t)m * 64 * 512; j.dst = (bf16_t*)(ws + WS_W2T) + (size_t)m * 512 * 64; j.K = 64; j.N = 512; j.Npad = 512; j.kt = 0; j.nt = r % 2; }
    else if (u < TR_SG2) { const int r = u - TR_SA2, m = r / 2; j.src = KIN(a, 18) + (size_t)m * 64 * 512; j.dst = (bf16_t*)(ws + WS_A2T) + (size_t)m * 512 * 64; j.K = 64; j.N = 512; j.Npad = 512; j.kt = 0; j.nt = r % 2; }
    else { const int r = u - TR_SG2; j.src = KIN(a, 19); j.dst = (bf16_t*)(ws + WS_G2T); j.K = 128; j.N = 512; j.Npad = 512; j.kt = r / 2; j.nt = r % 2; }
    return j;
}
DI void tr_load(const TrJob& j, int tid, f32x4 (&v)[8]) {
    const int c4 = tid & 63, r0 = tid >> 6, n = j.nt * 256 + c4 * 4;
#pragma unroll
    for (int p = 0; p < 8; ++p) {
        const int k = j.kt * 64 + p * 8 + r0;
        v[p] = (n < j.N) ? *(const f32x4*)(j.src + (size_t)k * j.N + n) : (f32x4){0.f, 0.f, 0.f, 0.f};
    }
}
DI void tr_step(LAS float* sT, const KArgs& a, TrJob& j, f32x4 (&v)[8], int tid, int un, int uend) {
    const int c4 = tid & 63, r0 = tid >> 6;
#pragma unroll
    for (int p = 0; p < 8; ++p) { LAS float* d = sT + (p * 8 + r0) * 257 + c4 * 4; d[0] = v[p][0]; d[1] = v[p][1]; d[2] = v[p][2]; d[3] = v[p][3]; }
    __syncthreads();
    const TrJob jo = j;
    if (un < uend) { j = tr_job(a, un); tr_load(j, tid, v); }
    const int k8 = tid & 7;
#pragma unroll
    for (int q = 0; q < 4; ++q) {
        const int nl = q * 64 + (tid >> 3), n = jo.nt * 256 + nl;
        float x[8];
#pragma unroll
        for (int e = 0; e < 8; ++e) x[e] = sT[(k8 * 8 + e) * 257 + nl];
        if (jo.q8) {
            const int g = jo.q8 == 2 ? ((((nl >> 3) & 1) << 7) | (((nl >> 6) & 3) << 5) | (((nl >> 4) & 3) << 3) | (nl & 7)) : nl;
            u32x2 w; w.x = pack4_fp8(clamp8(x[0] * Q8_W), clamp8(x[1] * Q8_W), clamp8(x[2] * Q8_W), clamp8(x[3] * Q8_W)); w.y = pack4_fp8(clamp8(x[4] * Q8_W), clamp8(x[5] * Q8_W), clamp8(x[6] * Q8_W), clamp8(x[7] * Q8_W));
            *(u32x2*)((unsigned char*)jo.dst + (size_t)(jo.nt * 256 + g) * 1024 + jo.kt * 64 + k8 * 8) = w;
        } else if (n < jo.Npad) { u32x4 w; w.x = pack2(x[0], x[1]); w.y = pack2(x[2], x[3]); w.z = pack2(x[4], x[5]); w.w = pack2(x[6], x[7]);
            *(u32x4*)(jo.dst + (size_t)n * jo.K + jo.kt * 64 + k8 * 8) = w; }
    }
    __syncthreads();
}
struct Tr8Job { const float* src; unsigned char* dst; int N, kt, nt, w1; };
DI Tr8Job tr8_job(const KArgs& a, int u) {
    Tr8Job j; unsigned char* ws = a.ws;
    if (u < TR_W2) { const int m = u / 128, r = u % 128; j.src = KIN(a, 8) + (size_t)m * 1024 * 2048; j.dst = ws + WS_W1T + (size_t)m * 2048 * 1024; j.N = 2048; j.kt = r / 16; j.nt = r % 16; j.w1 = 1; }
    else { const int v = u - TR_W2, m = v / 64, r = v % 64; j.src = KIN(a, 10) + (size_t)m * 1024 * 1024; j.dst = ws + WS_W2TM + (size_t)m * 1024 * 1024; j.N = 1024; j.kt = r / 8; j.nt = r % 8; j.w1 = 0; }
    return j;
}
DI void tr8_load(const Tr8Job& j, int tid, f32x4 (&v)[8]) {
    const int c4 = tid & 31, r0 = tid >> 5;
    const float* p = j.src + (size_t)(j.kt * 128 + r0 * 8) * j.N + j.nt * 128 + c4 * 4;
#pragma unroll
    for (int q = 0; q < 8; ++q) v[q] = *(const f32x4*)(p + (size_t)q * j.N);
}
DI void tr8_step(LAS unsigned char* img, const KArgs& a, Tr8Job& j, f32x4 (&v)[8], int tid, int un, int uend) {
    const int c4 = tid & 31, r0 = tid >> 5;
#pragma unroll
    for (int e = 0; e < 4; ++e) { const int n = c4 * 4 + e;
        u32x2 w; w.x = pack4_fp8(clamp8(v[0][e] * Q8_W), clamp8(v[1][e] * Q8_W), clamp8(v[2][e] * Q8_W), clamp8(v[3][e] * Q8_W)); w.y = pack4_fp8(clamp8(v[4][e] * Q8_W), clamp8(v[5][e] * Q8_W), clamp8(v[6][e] * Q8_W), clamp8(v[7][e] * Q8_W));
        *(LAS u32x2*)(img + n * 128 + ((r0 ^ (c4 & 15)) * 8)) = w; }
    __syncthreads();
    const Tr8Job jo = j;
    if (un < uend) { j = tr8_job(a, un); tr8_load(j, tid, v); }
#pragma unroll
    for (int q = 0; q < 2; ++q) { const int idx = tid + q * NTHR, n = idx >> 3, g = idx & 7, s = (n >> 2) & 15;
        u32x4 w = *(const LAS u32x4*)(img + n * 128 + ((g ^ (s >> 1)) * 16));
        if (s & 1) { const unsigned t0 = w.x, t1 = w.y; w.x = w.z; w.y = w.w; w.z = t0; w.w = t1; }
        const int nn = jo.nt * 128 + n;
        const int nl = nn & 255, row = jo.w1 ? ((nn & ~255) | (((nl >> 3) & 1) << 7) | (((nl >> 6) & 3) << 5) | (((nl >> 4) & 3) << 3) | (nl & 7)) : nn;
        *(u32x4*)(jo.dst + (size_t)row * 1024 + jo.kt * 128 + g * 16) = w; }
}
DI void tr8_range(LAS unsigned char* lds, const KArgs& a, int tid, int u0, int uend, int stride) {
    int u = u0, par = 0; f32x4 vA[8], vB[8]; Tr8Job jA{}, jB{};
    if (u < uend) { jA = tr8_job(a, u); tr8_load(jA, tid, vA); }
    if (u + stride < uend) { jB = tr8_job(a, u + stride); tr8_load(jB, tid, vB); }
    while (u < uend) {
        tr8_step(lds + par * 16384, a, jA, vA, tid, u + 2 * stride, uend); par ^= 1;
        u += stride; if (u >= uend) break;
        tr8_step(lds + par * 16384, a, jB, vB, tid, u + 2 * stride, uend); par ^= 1;
        u += stride;
    }
    __syncthreads();
}
DI void tr_range(LAS float* sT, const KArgs& a, int tid, int u0, int uend, int stride) {
    int u = u0; f32x4 vA[8], vB[8]; TrJob jA{}, jB{};
    if (u < uend) { jA = tr_job(a, u); tr_load(jA, tid, vA); }
    if (u + stride < uend) { jB = tr_job(a, u + stride); tr_load(jB, tid, vB); }
    while (u < uend) {
        tr_step(sT, a, jA, vA, tid, u + 2 * stride, uend);
        u += stride; if (u >= uend) break;
        tr_step(sT, a, jB, vB, tid, u + 2 * stride, uend);
        u += stride;
    }
}
DI void p0_prologue(const Frame& F, const KArgs& a) {
    LAS float* sT = (LAS float*)F.lds;
    const int tid = F.tid;
    tr8_range(F.lds, a, tid, F.bid, TR_WIN0, F.G);
    tr_range(sT, a, tid, TR_WIN0 + F.bid, NTR, F.G);
    {
        LAS float* sc = (LAS float*)F.lds;
        LAS float* red = sc + 5 * 1024;
        bool staged = false;
        for (int u = P0_MOD + F.bid; u < P0_FIL; u += F.G) {
            if (!staged) {
                for (int i = tid; i < 5 * 1024; i += NTHR) { const float cv = (i < 4096) ? KIN(a, 1)[i] : KIN(a, 3)[i - 4096]; sc[i] = siluf_(cv); }
                staged = true; __syncthreads();
            }
            const int v = u - P0_MOD, l = v / 192, n0 = (v % 192) * 32;
            const int cg = tid & 7, ks = tid >> 3;
            const float* W = KIN(a, 4) + (size_t)l * 1024 * 6144 + n0 + cg * 4;
            f32x4 wv4[16];
#pragma unroll
            for (int kk = 0; kk < 16; ++kk) wv4[kk] = *(const f32x4*)(W + (size_t)(kk * 64 + ks) * 6144);
            f32x4 acc[5];
#pragma unroll
            for (int b = 0; b < 5; ++b) acc[b] = (f32x4){0.f, 0.f, 0.f, 0.f};
#pragma unroll
            for (int kk = 0; kk < 16; ++kk)
#pragma unroll
                for (int b = 0; b < 5; ++b) acc[b] += wv4[kk] * sc[b * 1024 + kk * 64 + ks];
#pragma unroll
            for (int b = 0; b < 5; ++b) *(LAS f32x4*)(red + (ks * 5 + b) * 32 + cg * 4) = acc[b];
            __syncthreads();
            if (tid < 160) { const int b = tid >> 5, c = tid & 31; float s = KIN(a, 5)[(size_t)l * 6144 + n0 + c];
#pragma unroll 8
                for (int k2 = 0; k2 < 64; ++k2) s += red[(k2 * 5 + b) * 32 + c];
                ((float*)(a.ws + WS_MOD))[((size_t)l * 5 + b) * 6144 + n0 + c] = s; }
            __syncthreads();
        }
    }
    {
        LAS float* z = (LAS float*)F.lds;
        LAS float* h1 = z + 32 * 36;
        LAS float* h2T = h1 + 32 * 64;
        LAS float* w1s = h2T + 64 * 32;
        LAS float* w2s = w1s + 33 * 64;
        const float* w1 = KIN(a, 33); const float* b1 = KIN(a, 34); const float* fr1 = KIN(a, 35);
        const float* w2 = KIN(a, 36); const float* b2 = KIN(a, 37); const float* fr2 = KIN(a, 38); const float* w3 = KIN(a, 39);
        bool wst = false;
        for (int u = P0_FIL + F.bid; u < P0_ROPE; u += F.G) {
            const int p0 = (u - P0_FIL) * 32;
            if (!wst) { for (int i = tid; i < 33 * 64; i += NTHR) w1s[i] = w1[i];
                for (int i = tid; i < 64 * 64; i += NTHR) w2s[i] = w2[i];
                wst = true; }
            { const int p = tid >> 4, f = tid & 15; const int pos = p0 + p;
              const float freq = 1e-4f + (float)f * ((15.0f - 1e-4f) / 15.0f);
              const float ang = (6.283185307179586f / 8192.0f) * (float)pos * freq;
              float sn, cs; __sincosf(ang, &sn, &cs);
              z[p * 36 + 1 + f] = cs; z[p * 36 + 17 + f] = -sn;
              if (f == 0) z[p * 36] = (float)pos * (1.0f / 8191.0f); }
            __syncthreads();
#pragma unroll
            for (int q = 0; q < 4; ++q) { const int o = tid + q * NTHR, p = o >> 6, jn = o & 63; float s = b1[jn];
#pragma unroll
                for (int i = 0; i < 33; ++i) s += z[p * 36 + i] * w1s[i * 64 + jn];
                h1[p * 64 + jn] = __sinf(fr1[jn] * s); }
            __syncthreads();
#pragma unroll
            for (int q = 0; q < 4; ++q) { const int o = tid + q * NTHR, p = o >> 6, jn = o & 63; float s = b2[jn];
#pragma unroll
                for (int i = 0; i < 64; ++i) s += h1[p * 64 + i] * w2s[i * 64 + jn];
                h2T[jn * 32 + p] = __sinf(fr2[jn] * s); }
            __syncthreads();
#pragma unroll 1
            for (int q = 0; q < 4; ++q) {
                const int n = tid + q * NTHR;
                f32x4 acc[8];
#pragma unroll
                for (int p = 0; p < 8; ++p) acc[p] = (f32x4){0.f, 0.f, 0.f, 0.f};
#pragma unroll 1
                for (int i0 = 0; i0 < 64; i0 += 16) { float w[16];
#pragma unroll
                    for (int i = 0; i < 16; ++i) w[i] = w3[(i0 + i) * 2048 + n];
#pragma unroll
                    for (int i = 0; i < 16; ++i)
#pragma unroll
                        for (int p4 = 0; p4 < 8; ++p4) { const f32x4 hv = *(const LAS f32x4*)(h2T + (i0 + i) * 32 + p4 * 4); acc[p4] += hv * w[i]; } }
                const int c = n & 511;
                const float dlo = -3.0701134573253946f, dhi = -15.350567286626973f;
                const float delta = fabsf(dlo + (dhi - dlo) * ((float)c / 511.0f));
                float* dst = (float*)(a.ws + WS_HYF) + (size_t)n * 8192 + p0;
#pragma unroll
                for (int p4 = 0; p4 < 8; ++p4) { f32x4 o4;
#pragma unroll
                    for (int e = 0; e < 4; ++e) { const float tn = (float)(p0 + p4 * 4 + e) * (1.0f / 8191.0f); o4[e] = acc[p4][e] * __expf(-tn * delta); }
                    *(f32x4*)(dst + p4 * 4) = o4; }
            }
            __syncthreads();
        }
    }
    for (int u = P0_ROPE + F.bid; u < P0_UNITS; u += F.G) {
        for (int i = tid; i < 2048; i += NTHR) { const int pos = i >> 4, k = i & 15; const float inv = powf(10000.0f, -(float)k / 16.0f);
            float sn, cs; sincosf((float)pos * inv, &sn, &cs); ((f32x2*)(a.ws + WS_ROPE))[i] = (f32x2){cs, sn}; }
    }
}

DI void row_load16_bf(const bf16_t* src, int lane, f32x4 (&v)[4]) {
#pragma unroll
    for (int i = 0; i < 4; ++i) { const u32x2 q = *(const u32x2*)(src + i * 256 + lane * 4); v[i] = (f32x4){lo2f(q.x), hi2f(q.x), lo2f(q.y), hi2f(q.y)}; }
}
DI void row_load16(const float* src, int lane, f32x4 (&v)[4]) {
#pragma unroll
    for (int i = 0; i < 4; ++i) v[i] = *(const f32x4*)(src + i * 256 + lane * 4);
}
DI void row_modulate(f32x4 (&v)[4], const float* sh, const float* scl, int lane) {
    float ss = 0.f;
#pragma unroll
    for (int i = 0; i < 4; ++i) ss += v[i][0] * v[i][0] + v[i][1] * v[i][1] + v[i][2] * v[i][2] + v[i][3] * v[i][3];
    ss = wave_sum(ss);
    const float inv = rsqrtf(ss * (1.0f / 1024.0f) + 1e-6f);
#pragma unroll
    for (int i = 0; i < 4; ++i) { const f32x4 s4 = *(const f32x4*)(sh + i * 256 + lane * 4), c4 = *(const f32x4*)(scl + i * 256 + lane * 4);
        v[i] = v[i] * inv * (c4 + 1.0f) + s4; }
}
DI void row_store_bf16(bf16_t* dst, int lane, const f32x4 (&v)[4]) {
#pragma unroll
    for (int i = 0; i < 4; ++i) { u32x2 w; w.x = pack2(v[i][0], v[i][1]); w.y = pack2(v[i][2], v[i][3]); *(u32x2*)(dst + i * 256 + lane * 4) = w; }
}
DI int row_sel(int row) { return row < TL ? row / SEQ : 4; }
DI void p_modulate_in(const Frame& F, const KArgs& a) {
    const float* mod = (const float*)(a.ws + WS_MOD);
    bf16_t* hA = (bf16_t*)(a.ws + WS_HA);
    for (int row = F.bid * 8 + F.wave; row < TT; row += F.G * 8) {
        const float* src = row < TL ? KIN(a, 0) + (size_t)row * DM : KIN(a, 2) + (size_t)(row - TL) * DM;
        f32x4 v[4]; row_load16(src, F.lane, v);
        const float* m = mod + (size_t)row_sel(row) * 6144;
        row_modulate(v, m, m + 1024, F.lane);
        row_store_bf16(hA + (size_t)row * DM, F.lane, v);
    }
}
constexpr int ST_TOK = 32, ST_UNITS = TL / 32 + TC / 16, APITCH = 136, NSTEP = CL + SEQ;
constexpr int NCHUNK = NSTEP / 16, CBR = 12288, CBH = 7168;
constexpr size_t RW_OFF = 0, RW_BYTES = (size_t)64 * NCHUNK * CBR, HG_OFF = RW_OFF + RW_BYTES, HG_BYTES = (size_t)64 * NCHUNK * CBH, G_OFF = HG_OFF + HG_BYTES,
                 VTOK_OFF = G_OFF + (size_t)TT * 512 * 2, CBON_OFF = VTOK_OFF + (size_t)TT * 512 * 2;
static_assert(CBON_OFF + (size_t)2 * TT * 8 * 4 <= R1_BYTES, "layer-0 streams fit region 1");
DI size_t hg_elem(int chain, int s) { return ((size_t)chain * NCHUNK + (s >> 4)) * (CBH / 2) + (s & 15) * 192; }
DI float fast_rcp(float x) { return __builtin_amdgcn_rcpf(x); }
DI float fsigmoid(float x) { return fast_rcp(1.0f + __expf(-x)); }
DI float fsilu(float x) { return x * fast_rcp(1.0f + __expf(-x)); }
DI float ftanh(float x) { return 1.0f - 2.0f * fast_rcp(1.0f + __expf(2.0f * x)); }
DI int step_of(int row, int d) {
    if (row < TL) { const int t = row & (SEQ - 1); return CL + (d ? SEQ - 1 - t : t); }
    const int t = (row - TL) & (CL - 1); return d ? CL - 1 - t : t;
}
DI int batch_of(int row) { return row < TL ? row / SEQ : (row - TL) / CL; }
DI int scan_row(int b, int d, int s) {
    if (s < CL) return TL + b * CL + (d ? CL - 1 - s : s);
    const int t = s - CL; return b * SEQ + (d ? SEQ - 1 - t : t);
}
DI void p_streams(const Frame& F, const KArgs& a) {
    const bf16_t* U = (const bf16_t*)(a.ws + WS_U);
    bf16_t* RW = (bf16_t*)(a.ws + WS_R1 + RW_OFF); bf16_t* HG = (bf16_t*)(a.ws + WS_R1 + HG_OFF); bf16_t* G = (bf16_t*)(a.ws + WS_R1 + G_OFF); bf16_t* VTOK = (bf16_t*)(a.ws + WS_R1 + VTOK_OFF);
    LAS bf16_t* Ks  = (LAS bf16_t*)F.lds;
    LAS bf16_t* KKs = Ks + 32 * 512;
    LAS bf16_t* Alw = KKs + 32 * 512;
    LAS bf16_t* Aad = Alw + 32 * APITCH;
    LAS bf16_t* Asg = Aad + 32 * APITCH;
    const float* shiftw = KIN(a, 14);
    const bf16_t* w2t = (const bf16_t*)(a.ws + WS_W2T);
    const bf16_t* a2t = (const bf16_t*)(a.ws + WS_A2T);
    const bf16_t* g2t = (const bf16_t*)(a.ws + WS_G2T);
    const float* w0p = KIN(a, 15); const float* a0p = KIN(a, 17); const float* kap = KIN(a, 21); const float* kkp = KIN(a, 20); const float* lbl = KIN(a, 25);
    const int tid = F.tid, lane = F.lane, wv = F.wave;
    for (int u = F.bid; u < ST_UNITS; u += F.G) {
        const int row0 = u < TL / 32 ? u * 32 : TL + (u - TL / 32) * 16, ntok = u < TL / 32 ? 32 : 16;
        const int seq_start = row0 < TL ? (row0 / SEQ) * SEQ : TL + ((row0 - TL) / CL) * CL;
        const int seq_end = row0 < TL ? seq_start + SEQ : seq_start + CL;
        const int bb = batch_of(row0);
        const int s0f = step_of(row0, 0), s0b = step_of(row0, 1);
        if (tid < 480) {
            const int col = tid * 4;
            float t0[4], t1[4], t2[4];
#pragma unroll
            for (int e = 0; e < 4; ++e) { t0[e] = shiftw[col + e]; t1[e] = shiftw[1920 + col + e]; t2[e] = shiftw[3840 + col + e]; }
            float kk_k[4] = {0.f, 0.f, 0.f, 0.f};
            if (col >= 512 && col < 1024) {
#pragma unroll
                for (int e = 0; e < 4; ++e) kk_k[e] = kkp[col - 512 + e];
            }
            const int vsel = col < 512 ? 0 : (col < 1024 ? 2 : 1), hcol = col & 511, hh = hcol >> 6, hc = hcol & 63;
            bf16_t* dF = RW + ((size_t)((bb * 8 + hh) * 2 + 0) * NSTEP + s0f) * 384 + vsel * 64 + hc;
            bf16_t* dB = RW + ((size_t)((bb * 8 + hh) * 2 + 1) * NSTEP + s0b) * 384 + vsel * 64 + hc;
            const u32x2 zero2 = (u32x2){0u, 0u};
#pragma unroll 1
            for (int hf = 0; hf < ntok / 16; ++hf) {
            u32x2 rws[18];
#pragma unroll
            for (int i = 0; i < 18; ++i) { const int rr_ = row0 + hf * 16 - 1 + i; rws[i] = (rr_ >= seq_start && rr_ < seq_end) ? *(const u32x2*)(U + (size_t)rr_ * ABPAD + col) : zero2; }
#pragma unroll
            for (int tt = 0; tt < 16; ++tt) {
                const int t = hf * 16 + tt, row = row0 + t;
                const u32x2 prv = rws[tt], cur = rws[tt + 1], nxt = rws[tt + 2];
                float x[4];
                x[0] = lo2f(prv.x) * t0[0] + lo2f(cur.x) * t1[0] + lo2f(nxt.x) * t2[0];
                x[1] = hi2f(prv.x) * t0[1] + hi2f(cur.x) * t1[1] + hi2f(nxt.x) * t2[1];
                x[2] = lo2f(prv.y) * t0[2] + lo2f(cur.y) * t1[2] + lo2f(nxt.y) * t2[2];
                x[3] = hi2f(prv.y) * t0[3] + hi2f(cur.y) * t1[3] + hi2f(nxt.y) * t2[3];
                if (col < 512 || (col >= 1024 && col < 1536)) {
                    u32x2 w; w.x = pack2(x[0], x[1]); w.y = pack2(x[2], x[3]);
                    *(u32x2*)(dF + (size_t)t * 384) = w; *(u32x2*)(dB - (size_t)t * 384) = w;
                    if (col >= 1024) *(u32x2*)(VTOK + (size_t)row * 512 + (col - 1024)) = w;
                } else if (col < 1024) {
                    const int kc = col - 512;
                    u32x2 w; w.x = pack2(x[0], x[1]); w.y = pack2(x[2], x[3]);
                    *(LAS u32x2*)(Ks + t * 512 + kc) = w;
                    float q[4]; float ss = 0.f;
#pragma unroll
                    for (int e = 0; e < 4; ++e) { q[e] = x[e] * kk_k[e]; ss += q[e] * q[e]; }
                    ss = rowsum16(ss);
                    const float inv = 1.0f / fmaxf(sqrtf(ss), 1e-12f);
                    u32x2 w2; w2.x = pack2(q[0] * inv, q[1] * inv); w2.y = pack2(q[2] * inv, q[3] * inv);
                    *(LAS u32x2*)(KKs + t * 512 + kc) = w2;
                    *(u32x2*)(dF + (size_t)t * 384) = w2; *(u32x2*)(dB - (size_t)t * 384) = w2;
                } else if (col < 1664) {
                    u32x2 w; w.x = pack2(ftanh(x[0]), ftanh(x[1])); w.y = pack2(ftanh(x[2]), ftanh(x[3]));
                    *(LAS u32x2*)(Alw + t * APITCH + (col - 1536)) = w;
                } else if (col < 1792) {
                    u32x2 w; w.x = pack2(x[0], x[1]); w.y = pack2(x[2], x[3]);
                    *(LAS u32x2*)(Aad + t * APITCH + (col - 1664)) = w;
                } else {
                    u32x2 w; w.x = pack2(fsigmoid(x[0]), fsigmoid(x[1])); w.y = pack2(fsigmoid(x[2]), fsigmoid(x[3]));
                    *(LAS u32x2*)(Asg + t * APITCH + (col - 1792)) = w;
                }
            }
            }
        }
        {
#pragma unroll 4
            for (int it = 0; it < ntok / 2; ++it) {
                const int idx = tid + it * NTHR, t = idx >> 8, rem = idx & 255, vec = rem >> 6, pc = rem & 63, hh = pc >> 3, hc = (pc & 7) * 8;
                float x[8]; load8bf(U + (size_t)(row0 + t) * ABPAD + ACOLS + vec * 512 + pc * 8, x);
                bf16_t* cF = HG + hg_elem((bb * 8 + hh) * 2 + 0, s0f + t) + hc;
                bf16_t* cB = HG + hg_elem((bb * 8 + hh) * 2 + 1, s0b - t) + hc;
                if (vec == 0) {
#pragma unroll
                    for (int e = 0; e < 8; ++e) x[e] = fsilu(x[e]);
                    store8bf(cF, x); store8bf(cB, x);
                } else if (vec == 3) { store8bf(cF + 128, x); store8bf(cB + 128, x); }
                else {
                    float l0[8], l1[8]; load8f(lbl + pc * 8, l0); load8f(lbl + 512 + pc * 8, l1);
#pragma unroll
                    for (int e = 0; e < 8; ++e) { const float lb = fast_rcp(1.0f + __expf(l1[e] - l0[e])); x[e] = (1.0f - lb) * (1.0f - fsigmoid(x[e])); }
                    store8bf((vec == 1 ? cF : cB) + 64, x);
                }
            }
        }
        __syncthreads();
        {
            const int fr = lane & 15, fq = lane >> 4;
            bf16_t* eF = RW + ((size_t)((bb * 8 + wv) * 2 + 0) * NSTEP + s0f) * 384;
            bf16_t* eB = RW + ((size_t)((bb * 8 + wv) * 2 + 1) * NSTEP + s0b) * 384;
#pragma unroll 1
            for (int nt = 0; nt < 2; ++nt) {
                const int cb = wv * 64 + nt * 32;
                f32x4 accW[2][2][2], accA[2][2][2], accG[2][2];
#pragma unroll
                for (int m = 0; m < 2; ++m)
#pragma unroll
                    for (int n = 0; n < 2; ++n) { accG[m][n] = (f32x4){0.f, 0.f, 0.f, 0.f};
#pragma unroll
                        for (int d = 0; d < 2; ++d) { accW[d][m][n] = (f32x4){0.f, 0.f, 0.f, 0.f}; accA[d][m][n] = (f32x4){0.f, 0.f, 0.f, 0.f}; } }
#pragma unroll
                for (int n = 0; n < 2; ++n) {
                    const int c = cb + 8 * (fr >> 2) + 4 * n + (fr & 3);
#pragma unroll
                    for (int d = 0; d < 2; ++d)
#pragma unroll
                        for (int ks = 0; ks < 2; ++ks) {
                            const bf16x8 bw = *(const bf16x8*)(w2t + ((size_t)d * 512 + c) * 64 + ks * 32 + fq * 8);
                            const bf16x8 ba = *(const bf16x8*)(a2t + ((size_t)d * 512 + c) * 64 + ks * 32 + fq * 8);
#pragma unroll
                            for (int m = 0; m < 2; ++m) {
                                const bf16x8 aw = *(const LAS bf16x8*)(Alw + (m * 16 + fr) * APITCH + d * 64 + ks * 32 + fq * 8);
                                const bf16x8 aa = *(const LAS bf16x8*)(Aad + (m * 16 + fr) * APITCH + d * 64 + ks * 32 + fq * 8);
                                accW[d][m][n] = __builtin_amdgcn_mfma_f32_16x16x32_bf16(bw, aw, accW[d][m][n], 0, 0, 0);
                                accA[d][m][n] = __builtin_amdgcn_mfma_f32_16x16x32_bf16(ba, aa, accA[d][m][n], 0, 0, 0);
                            }
                        }
#pragma unroll
                    for (int ks = 0; ks < 4; ++ks) {
                        const bf16x8 bg = *(const bf16x8*)(g2t + (size_t)c * 128 + ks * 32 + fq * 8);
#pragma unroll
                        for (int m = 0; m < 2; ++m) {
                            const bf16x8 ag = *(const LAS bf16x8*)(Asg + (m * 16 + fr) * APITCH + ks * 32 + fq * 8);
                            accG[m][n] = __builtin_amdgcn_mfma_f32_16x16x32_bf16(bg, ag, accG[m][n], 0, 0, 0);
                        }
                    }
                }
                const int c8 = cb + fq * 8, hc8 = nt * 32 + fq * 8;
                f32x4 ka[2];
#pragma unroll
                for (int n = 0; n < 2; ++n) ka[n] = *(const f32x4*)(kap + c8 + 4 * n);
#pragma unroll
                for (int m = 0; m < 2; ++m) {
                    __builtin_amdgcn_sched_barrier(0);
                    const int tt = m * 16 + fr;
                    if (tt >= ntok) continue;
                    const u32x4 kw = *(const LAS u32x4*)(Ks + tt * 512 + c8), kkw = *(const LAS u32x4*)(KKs + tt * 512 + c8);
                    float kv[8], kkv[8];
                    kv[0] = lo2f(kw.x); kv[1] = hi2f(kw.x); kv[2] = lo2f(kw.y); kv[3] = hi2f(kw.y); kv[4] = lo2f(kw.z); kv[5] = hi2f(kw.z); kv[6] = lo2f(kw.w); kv[7] = hi2f(kw.w);
                    kkv[0] = lo2f(kkw.x); kkv[1] = hi2f(kkw.x); kkv[2] = lo2f(kkw.y); kkv[3] = hi2f(kkw.y); kkv[4] = lo2f(kkw.z); kkv[5] = hi2f(kkw.z); kkv[6] = lo2f(kkw.w); kkv[7] = hi2f(kkw.w);
#pragma unroll
                    for (int d = 0; d < 2; ++d) {
                        float mm[8], bq[8], kq[8];
                        f32x4 w0d[2], a0d[2];
#pragma unroll
                        for (int n = 0; n < 2; ++n) { w0d[n] = *(const f32x4*)(w0p + d * 512 + c8 + 4 * n); a0d[n] = *(const f32x4*)(a0p + d * 512 + c8 + 4 * n); }
#pragma unroll
                        for (int n = 0; n < 2; ++n)
#pragma unroll
                            for (int j = 0; j < 4; ++j) { const int e = n * 4 + j;
                                const float xw = -(w0d[n][j] + accW[d][m][n][j]);
                                mm[e] = 1.0f - __expf(-0.60653066f * fast_rcp(1.0f + __expf(xw)));
                                const float av = fsigmoid(a0d[n][j] + accA[d][m][n][j]);
                                bq[e] = kkv[e] * av; kq[e] = kv[e] * (1.0f + (av - 1.0f) * ka[n][j]); }
                        bf16_t* dp = (d ? eB - (size_t)tt * 384 : eF + (size_t)tt * 384) + hc8;
                        store8bf(dp + 192, mm); store8bf(dp + 256, bq); store8bf(dp + 320, kq);
                    }
                    { float gg8[8];
#pragma unroll
                      for (int n = 0; n < 2; ++n)
#pragma unroll
                          for (int j = 0; j < 4; ++j) gg8[n * 4 + j] = accG[m][n][j];
                      store8bf(G + (size_t)(row0 + tt) * 512 + c8, gg8); }
                }
            }
        }
        __syncthreads();
    }
}
constexpr int RB_KT = 0, RB_RT = 2048, RB_KO = 4096, RB_BO = 6144, RB_VT = 8192, RB_NKT = 10240, RB_MK = 10752, RB_MB = 11264, RB_G = 11776;
constexpr int HB_QT = 0, HB_KO = 2048, HB_VT = 4096, HB_MK = 6144, HB_G = 6656;
constexpr int GP = 72;
DI int kperm(int k) { const int kk = k & 31, hi = kk >> 4, q = (kk & 15) >> 2, e = kk & 3; return (k & 32) + q * 8 + hi * 4 + e; }
DI f32x4 gram16(const LAS bf16_t* X, const LAS bf16_t* Y, int fr, int fq) {
    f32x4 acc = (f32x4){0.f, 0.f, 0.f, 0.f};
#pragma unroll
    for (int ks = 0; ks < 2; ++ks) { const bf16x8 af = *(const LAS bf16x8*)(X + fr * GP + ks * 32 + fq * 8), bfr = *(const LAS bf16x8*)(Y + fr * GP + ks * 32 + fq * 8);
        acc = __builtin_amdgcn_mfma_f32_16x16x32_bf16(af, bfr, acc, 0, 0, 0); }
    return acc;
}
DI void store16bf(bf16_t* p, const float (&x)[16]) {
    u32x4 w0, w1; w0.x = pack2(x[0], x[1]); w0.y = pack2(x[2], x[3]); w0.z = pack2(x[4], x[5]); w0.w = pack2(x[6], x[7]);
    w1.x = pack2(x[8], x[9]); w1.y = pack2(x[10], x[11]); w1.z = pack2(x[12], x[13]); w1.w = pack2(x[14], x[15]);
    *(u32x4*)p = w0; *(u32x4*)(p + 8) = w1;
}
DI void tri_solve16(float (&x)[16], const LAS float* NBc) {
#pragma unroll
    for (int tp = 1; tp < 16; ++tp) {
        float acc = x[tp];
#pragma unroll
        for (int t4 = 0; t4 < (tp + 3) / 4; ++t4) { const f32x4 nb = *(const LAS f32x4*)(NBc + tp * 16 + t4 * 4);
#pragma unroll
            for (int e = 0; e < 4; ++e) if (t4 * 4 + e < tp) acc -= x[t4 * 4 + e] * nb[e]; }
        x[tp] = acc;
    }
}
DI void p_prep(const Frame& F, const KArgs& a) {
    unsigned char* RWB = a.ws + WS_R1 + RW_OFF; unsigned char* HGB = a.ws + WS_R1 + HG_OFF;
    float* CBON = (float*)(a.ws + WS_R1 + CBON_OFF);
    const float* rkp = KIN(a, 22);
    const int lane = F.lane, wv = F.wave, fr = lane & 15, fq = lane >> 4;
    LAS unsigned char* wl = F.lds + wv * 16384;
    LAS bf16_t* M0 = (LAS bf16_t*)wl; LAS bf16_t* M1 = M0 + 16 * GP; LAS bf16_t* M2 = M1 + 16 * GP; LAS bf16_t* M3 = M2 + 16 * GP;
    LAS float* NBc = (LAS float*)(wl + 9216); LAS float* NKr = NBc + 256;
    const int pk = kperm(lane);
    const int NU = 64 * NCHUNK;
    for (int u = F.bid * 8 + wv; u < 2 * NU; u += F.G * 8) {
        if (u < NU) {
            const int chain = u / NCHUNK, chunk = u - chain * NCHUNK, b = chain >> 4, h = (chain >> 1) & 7, d = chain & 1;
            bf16_t* blk = (bf16_t*)(RWB + (size_t)u * CBR);
            const float rkv = rkp[h * 64 + lane];
            float kt[16], rt[16], kh[16], bh[16], vv[16], cbp[16];
            float g = 1.0f;
#pragma unroll
            for (int t = 0; t < 16; ++t) {
                const bf16_t* sp = blk + t * 384 + lane;
                const float rr = bf2f(sp[0]), v_ = bf2f(sp[64]), kk = bf2f(sp[128]), mm = bf2f(sp[192]), bb = bf2f(sp[256]), kd = bf2f(sp[320]);
                kt[t] = g * kk; g *= (1.0f - mm); rt[t] = g * rr;
                const float ig = fast_rcp(g); kh[t] = kd * ig; bh[t] = bb * ig; vv[t] = v_; cbp[t] = rr * kd * rkv;
            }
            const float g15 = g;
#pragma unroll
            for (int t = 0; t < 16; ++t) { M0[t * GP + lane] = f2bf(kt[t]); M1[t * GP + lane] = f2bf(rt[t]); M2[t * GP + lane] = f2bf(kh[t]); M3[t * GP + lane] = f2bf(bh[t]); }
#pragma unroll
            for (int t = 0; t < 16; ++t) { const float s = wave_sum(cbp[t]); if (lane == t) CBON[((size_t)d * TT + scan_row(b, d, chunk * 16 + t)) * 8 + h] = s; }
            asm volatile("s_waitcnt vmcnt(0) lgkmcnt(0)" ::: "memory");
            __builtin_amdgcn_wave_barrier();
            f32x4 nk = gram16(M2, M0, fr, fq), nb = gram16(M3, M0, fr, fq), mk = gram16(M2, M1, fr, fq), mb = gram16(M3, M1, fr, fq);
#pragma unroll
            for (int j = 0; j < 4; ++j) { const int i = fq * 4 + j;
                nk[j] = i < fr ? nk[j] : 0.f; nb[j] = i < fr ? nb[j] : 0.f; mk[j] = i <= fr ? mk[j] : 0.f; mb[j] = i <= fr ? mb[j] : 0.f;
                NBc[fr * 16 + i] = nb[j]; NKr[i * 16 + fr] = nk[j]; }
            { u32x2 w; w.x = pack2(mk[0], mk[1]); w.y = pack2(mk[2], mk[3]); *(u32x2*)((unsigned char*)blk + RB_MK + (fr * 16 + fq * 4) * 2) = w;
              w.x = pack2(mb[0], mb[1]); w.y = pack2(mb[2], mb[3]); *(u32x2*)((unsigned char*)blk + RB_MB + (fr * 16 + fq * 4) * 2) = w; }
            asm volatile("s_waitcnt lgkmcnt(0)" ::: "memory");
            __builtin_amdgcn_wave_barrier();
            tri_solve16(kt, NBc);
            bf16_t* kto = (bf16_t*)((unsigned char*)blk + RB_KT) + pk; bf16_t* rto = (bf16_t*)((unsigned char*)blk + RB_RT) + pk;
#pragma unroll
            for (int t = 0; t < 16; ++t) { kto[t * 64] = f2bf(kt[t]); rto[t * 64] = f2bf(rt[t]); }
            { float x2[16];
#pragma unroll
              for (int t4 = 0; t4 < 4; ++t4) { const f32x4 q = *(const LAS f32x4*)(NKr + fr * 16 + t4 * 4); x2[t4 * 4] = q[0]; x2[t4 * 4 + 1] = q[1]; x2[t4 * 4 + 2] = q[2]; x2[t4 * 4 + 3] = q[3]; }
              tri_solve16(x2, NBc);
              if (lane < 16) { bf16_t* no = (bf16_t*)((unsigned char*)blk + RB_NKT) + lane;
#pragma unroll
                  for (int t = 0; t < 16; ++t) no[t * 16] = f2bf(x2[t]); } }
#pragma unroll
            for (int t = 0; t < 16; ++t) { kh[t] *= g15; bh[t] *= g15; }
            store16bf((bf16_t*)((unsigned char*)blk + RB_KO) + lane * 16, kh);
            store16bf((bf16_t*)((unsigned char*)blk + RB_BO) + lane * 16, bh);
            store16bf((bf16_t*)((unsigned char*)blk + RB_VT) + lane * 16, vv);
            ((float*)((unsigned char*)blk + RB_G))[lane] = g15;
            __builtin_amdgcn_wave_barrier();
        } else {
            const int uu = u - NU;
            bf16_t* blk = (bf16_t*)(HGB + (size_t)uu * CBH);
            float qt[16], kh[16], vv[16];
            float g = 1.0f;
#pragma unroll
            for (int t = 0; t < 16; ++t) {
                const bf16_t* sp = blk + t * 192 + lane;
                const float qq = bf2f(sp[0]), kk = bf2f(sp[64]), ii = bf2f(sp[128]);
                g *= (1.0f - kk); qt[t] = g * qq; kh[t] = kk * fast_rcp(g); vv[t] = ii;
            }
            const float g15 = g;
#pragma unroll
            for (int t = 0; t < 16; ++t) { M0[t * GP + lane] = f2bf(qt[t]); M2[t * GP + lane] = f2bf(kh[t]); }
            asm volatile("s_waitcnt vmcnt(0) lgkmcnt(0)" ::: "memory");
            __builtin_amdgcn_wave_barrier();
            f32x4 mk = gram16(M2, M0, fr, fq);
#pragma unroll
            for (int j = 0; j < 4; ++j) mk[j] = (fq * 4 + j) <= fr ? mk[j] : 0.f;
            { u32x2 w; w.x = pack2(mk[0], mk[1]); w.y = pack2(mk[2], mk[3]); *(u32x2*)((unsigned char*)blk + HB_MK + (fr * 16 + fq * 4) * 2) = w; }
            bf16_t* qto = (bf16_t*)((unsigned char*)blk + HB_QT) + pk;
#pragma unroll
            for (int t = 0; t < 16; ++t) { qto[t * 64] = f2bf(qt[t]); kh[t] *= g15; }
            store16bf((bf16_t*)((unsigned char*)blk + HB_KO) + lane * 16, kh);
            store16bf((bf16_t*)((unsigned char*)blk + HB_VT) + lane * 16, vv);
            ((float*)((unsigned char*)blk + HB_G))[lane] = g15;
            asm volatile("s_waitcnt lgkmcnt(0)" ::: "memory");
            __builtin_amdgcn_wave_barrier();
        }
    }
}
constexpr int SCD = 11;
DI bf16x8 pk8(const f32x4 lo, const f32x4 hi) {
    u32x4 w; w.x = pg8::cvt_pk_bf16(lo[0], lo[1]); w.y = pg8::cvt_pk_bf16(lo[2], lo[3]); w.z = pg8::cvt_pk_bf16(hi[0], hi[1]); w.w = pg8::cvt_pk_bf16(hi[2], hi[3]);
    return __builtin_bit_cast(bf16x8, w);
}
DI bf16x8 ld_tok(const LAS unsigned char* p) { const u32x2 w = *(const LAS u32x2*)p; u32x4 q; q.x = w.x; q.y = w.y; q.z = 0u; q.w = 0u; return __builtin_bit_cast(bf16x8, q); }
DI void p_scan(const Frame& F, const KArgs& a) {
    bf16_t* YO = (bf16_t*)(a.ws + WS_R2);
    const int lane = F.lane, wv = F.wave, fr = lane & 15, fq = lane >> 4;
    LAS unsigned char* ring = F.lds;
    LAS unsigned char* dummy = F.lds + SCD * CBR;
    LAS unsigned char* xb = dummy + 1024;
    for (int su = F.bid; su < 256; su += F.G) {
        const bool is_rw = su < 128;
        const int cu = su & 127, chain = cu >> 1, half = cu & 1, b = chain >> 4, d = chain & 1, h = (chain >> 1) & 7;
        const int bsz = is_rw ? CBR : CBH, nkb = is_rw ? 12 : 7;
        const unsigned char* src = a.ws + WS_R1 + (is_rw ? RW_OFF : HG_OFF) + (size_t)chain * NCHUNK * bsz;
        const bool stager = wv >= 4;
        const int d0 = (wv - 4) * 3;
#define SC_DMA(c_) do { if (stager) { const int cc_ = (c_) < NCHUNK ? (c_) : NCHUNK - 1; const unsigned char* bs_ = src + (size_t)cc_ * bsz; LAS unsigned char* sl_ = ring + ((c_) % SCD) * CBR; \
        _Pragma("unroll") for (int i_ = 0; i_ < 3; ++i_) { const int dd_ = d0 + i_; const bool ok_ = dd_ < nkb; \
            __builtin_amdgcn_global_load_lds((const unsigned*)(bs_ + (ok_ ? dd_ * 1024 : 0) + lane * 16), (LAS unsigned*)(ok_ ? sl_ + dd_ * 1024 : dummy), 16, 0, 16); } } } while (0)
#pragma unroll 1
        for (int c = 0; c < SCD - 2; ++c) SC_DMA(c);
        if (stager) asm volatile("s_waitcnt vmcnt(24)" ::: "memory");
        asm volatile("" ::: "memory"); __builtin_amdgcn_s_barrier(); asm volatile("" ::: "memory");
        f32x4 ST[4];
#pragma unroll
        for (int n = 0; n < 4; ++n) ST[n] = (f32x4){0.f, 0.f, 0.f, 0.f};
        const int qw = wv & 1;
        const int vbase = (half * 2 + qw) * 16;
        bf16_t* yout = YO + ((size_t)(is_rw ? 0 : 2) + d) * TT * 512 + h * 64 + vbase + (fr & ~1);
        int yoff[4];
#pragma unroll
        for (int j = 0; j < 4; ++j) yoff[j] = (d ? -(fq * 4 + j) : (fq * 4 + j)) * 512;
        const f32x4 z4 = (f32x4){0.f, 0.f, 0.f, 0.f};
#pragma unroll 1
        for (int c = 0; c <= NCHUNK; ++c) {
            SC_DMA(c + SCD - 2);
            if (wv < 2 && c < NCHUNK) {
                const LAS unsigned char* blk = ring + (c % SCD) * CBR;
                const bf16x8 Sb0 = pk8(ST[0], ST[1]), Sb1 = pk8(ST[2], ST[3]);
                LAS unsigned char* xo = xb + (((c & 1) * 2 + qw) * 64 + lane) * 48;
                if (is_rw) {
                    const bf16x8 kt0 = *(const LAS bf16x8*)(blk + RB_KT + (fr * 64 + fq * 8) * 2), kt1 = *(const LAS bf16x8*)(blk + RB_KT + (fr * 64 + 32 + fq * 8) * 2);
                    const bf16x8 nkt = ld_tok(blk + RB_NKT + (fr * 16 + fq * 4) * 2);
                    const bf16x8 Vb = ld_tok(blk + RB_VT + ((vbase + fr) * 16 + fq * 4) * 2);
                    f32x4 gg[4]; bf16x8 ko[4], bo[4];
#pragma unroll
                    for (int n = 0; n < 4; ++n) { gg[n] = *(const LAS f32x4*)(blk + RB_G + (n * 16 + fq * 4) * 4);
                        ko[n] = ld_tok(blk + RB_KO + ((n * 16 + fr) * 16 + fq * 4) * 2); bo[n] = ld_tok(blk + RB_BO + ((n * 16 + fr) * 16 + fq * 4) * 2); }
                    __builtin_amdgcn_sched_barrier(0);
                    f32x4 UTa = __builtin_amdgcn_mfma_f32_16x16x32_bf16(kt0, Sb0, z4, 0, 0, 0);
                    f32x4 UTb = __builtin_amdgcn_mfma_f32_16x16x32_bf16(kt1, Sb1, z4, 0, 0, 0);
                    UTb = __builtin_amdgcn_mfma_f32_16x16x32_bf16(nkt, Vb, UTb, 0, 0, 0);
#pragma unroll
                    for (int n = 0; n < 4; ++n) ST[n] = __builtin_amdgcn_mfma_f32_16x16x32_bf16(ko[n], Vb, ST[n] * gg[n], 0, 0, 0);
                    const f32x4 UT = UTa + UTb;
                    u32x4 un; un.x = pack2(UT[0], UT[1]) ^ 0x80008000u; un.y = pack2(UT[2], UT[3]) ^ 0x80008000u; un.z = 0u; un.w = 0u;
                    const bf16x8 Un = __builtin_bit_cast(bf16x8, un);
                    *(LAS bf16x8*)xo = Sb0; *(LAS bf16x8*)(xo + 16) = Sb1; *(LAS u32x2*)(xo + 32) = (u32x2){un.x, un.y};
#pragma unroll
                    for (int n = 0; n < 4; ++n) ST[n] = __builtin_amdgcn_mfma_f32_16x16x32_bf16(bo[n], Un, ST[n], 0, 0, 0);
                } else {
                    const bf16x8 Vb = ld_tok(blk + HB_VT + ((vbase + fr) * 16 + fq * 4) * 2);
                    f32x4 gg[4]; bf16x8 ko[4];
#pragma unroll
                    for (int n = 0; n < 4; ++n) { gg[n] = *(const LAS f32x4*)(blk + HB_G + (n * 16 + fq * 4) * 4); ko[n] = ld_tok(blk + HB_KO + ((n * 16 + fr) * 16 + fq * 4) * 2); }
                    *(LAS bf16x8*)xo = Sb0; *(LAS bf16x8*)(xo + 16) = Sb1;
#pragma unroll
                    for (int n = 0; n < 4; ++n) ST[n] = __builtin_amdgcn_mfma_f32_16x16x32_bf16(ko[n], Vb, ST[n] * gg[n], 0, 0, 0);
                }
            } else if (wv >= 2 && wv < 4 && c > 0) {
                const int cp = c - 1;
                const LAS unsigned char* blk = ring + (cp % SCD) * CBR;
                const LAS unsigned char* xi = xb + (((cp & 1) * 2 + qw) * 64 + lane) * 48;
                const bf16x8 Sb0 = *(const LAS bf16x8*)xi, Sb1 = *(const LAS bf16x8*)(xi + 16);
                f32x4 YT, YTa;
                if (is_rw) {
                    const bf16x8 rt0 = *(const LAS bf16x8*)(blk + RB_RT + (fr * 64 + fq * 8) * 2), rt1 = *(const LAS bf16x8*)(blk + RB_RT + (fr * 64 + 32 + fq * 8) * 2);
                    const bf16x8 mkt = ld_tok(blk + RB_MK + (fr * 16 + fq * 4) * 2), mbt = ld_tok(blk + RB_MB + (fr * 16 + fq * 4) * 2);
                    const bf16x8 Vb = ld_tok(blk + RB_VT + ((vbase + fr) * 16 + fq * 4) * 2);
                    const bf16x8 Un = ld_tok(xi + 32);
                    YTa = __builtin_amdgcn_mfma_f32_16x16x32_bf16(rt0, Sb0, z4, 0, 0, 0);
                    YT = __builtin_amdgcn_mfma_f32_16x16x32_bf16(rt1, Sb1, z4, 0, 0, 0);
                    YTa = __builtin_amdgcn_mfma_f32_16x16x32_bf16(mkt, Vb, YTa, 0, 0, 0);
                    YT = __builtin_amdgcn_mfma_f32_16x16x32_bf16(mbt, Un, YT, 0, 0, 0);
                } else {
                    const bf16x8 qt0 = *(const LAS bf16x8*)(blk + HB_QT + (fr * 64 + fq * 8) * 2), qt1 = *(const LAS bf16x8*)(blk + HB_QT + (fr * 64 + 32 + fq * 8) * 2);
                    const bf16x8 mkt = ld_tok(blk + HB_MK + (fr * 16 + fq * 4) * 2);
                    const bf16x8 Vb = ld_tok(blk + HB_VT + ((vbase + fr) * 16 + fq * 4) * 2);
                    YTa = __builtin_amdgcn_mfma_f32_16x16x32_bf16(qt0, Sb0, z4, 0, 0, 0);
                    YT = __builtin_amdgcn_mfma_f32_16x16x32_bf16(qt1, Sb1, z4, 0, 0, 0);
                    YTa = __builtin_amdgcn_mfma_f32_16x16x32_bf16(mkt, Vb, YTa, 0, 0, 0);
                }
                YT = YT + YTa;
                { const int r0 = __builtin_amdgcn_readfirstlane(scan_row(b, d, cp * 16)); bf16_t* yb = yout + (size_t)r0 * 512;
                  f32x4 YP;
#pragma unroll
                  for (int j = 0; j < 4; ++j) YP[j] = dppmov<0xB1>(YT[j]);
                  if (!(fr & 1)) {
#pragma unroll
                      for (int j = 0; j < 4; ++j) *(unsigned*)(yb + yoff[j]) = pack2(YT[j], YP[j]); } }
            }
            if (stager) asm volatile("s_waitcnt vmcnt(24)" ::: "memory");
            asm volatile("s_waitcnt lgkmcnt(0)" ::: "memory"); __builtin_amdgcn_s_barrier(); asm volatile("" ::: "memory");
        }
        asm volatile("s_waitcnt vmcnt(0)" ::: "memory");
        __syncthreads();
#undef SC_DMA
    }
}

DI void p_readout(const Frame& F, const KArgs& a) {
    const bf16_t* U = (const bf16_t*)(a.ws + WS_U);
    const bf16_t* G = (const bf16_t*)(a.ws + WS_R1 + G_OFF); const bf16_t* VTOK = (const bf16_t*)(a.ws + WS_R1 + VTOK_OFF);
    const float* CBON = (const float*)(a.ws + WS_R1 + CBON_OFF);
    const bf16_t* YO = (const bf16_t*)(a.ws + WS_R2);
    bf16_t* MIX = (bf16_t*)(a.ws + WS_MIX);
    const int lane = F.lane, c0 = lane * 8, hh = lane >> 3;
    float lnw[8], lnb[8], nw[8];
    load8f(KIN(a, 23) + c0, lnw); load8f(KIN(a, 24) + c0, lnb); load8f(KIN(a, 26) + (c0 & 63), nw);
    for (int row = F.bid * 8 + F.wave; row < TT; row += F.G * 8) {
        const size_t o = (size_t)row * 512 + c0;
        float y0[8], y1[8], y[8], v[8], g[8], out[8];
        load8bf(YO + o, y0); load8bf(YO + (size_t)TT * 512 + o, y1);
        load8bf(VTOK + o, v); load8bf(G + o, g);
        const float cb = CBON[(size_t)row * 8 + hh] + CBON[((size_t)TT + row) * 8 + hh];
        float s = 0.f;
#pragma unroll
        for (int e = 0; e < 8; ++e) { y[e] = y0[e] + y1[e]; s += y[e]; }
        s = sum8(s);
        const float mu = s * (1.0f / 64.0f);
        float vs = 0.f;
#pragma unroll
        for (int e = 0; e < 8; ++e) { const float dlt = y[e] - mu; vs += dlt * dlt; }
        vs = sum8(vs);
        const float inv = rsqrtf(vs * (1.0f / 64.0f) + 64e-5f);
#pragma unroll
        for (int e = 0; e < 8; ++e) out[e] = ((y[e] - mu) * inv * lnw[e] + lnb[e] + cb * v[e]) * g[e];
        store8bf(MIX + (size_t)row * DM + c0, out);
        float og[8];
        load8bf(YO + (size_t)2 * TT * 512 + o, y0); load8bf(YO + (size_t)3 * TT * 512 + o, y1);
        load8bf(U + (size_t)row * ABPAD + ACOLS + 2048 + c0, og);
        float ms = 0.f;
#pragma unroll
        for (int e = 0; e < 8; ++e) { y[e] = y0[e] + y1[e]; ms += y[e] * y[e]; }
        ms = sum8(ms);
        const float inv2 = rsqrtf(ms * (1.0f / 64.0f) + 1e-6f);
#pragma unroll
        for (int e = 0; e < 8; ++e) out[e] = y[e] * inv2 * nw[e] * fsilu(og[e]);
        store8bf(MIX + (size_t)row * DM + 512 + c0, out);
    }
}
constexpr int RT_TOK = 16;
DI void p_route(const Frame& F, const KArgs& a, int layer, int nrows) {
    const float* mod = (const float*)(a.ws + WS_MOD) + (size_t)layer * 5 * 6144;
    const bf16_t* X = (const bf16_t*)(a.ws + WS_XRES);
    bf16_t* hA = (bf16_t*)(a.ws + WS_HA);
    const float* rw = KIN(a, 6) + (size_t)layer * 1024 * 32; const float* rb = KIN(a, 7) + layer * 32;
    int* cnt = (int*)(a.ws + WS_CTL + CW_CNT) + layer * 32;
    int* list = (int*)(a.ws + WS_LIST); float* sgate = (float*)(a.ws + WS_SGATE);
    constexpr int HP = 1026;
    LAS float* h2 = (LAS float*)F.lds;
    LAS float* part = h2 + 16 * HP;
    LAS float* lg = part + 8 * 512;
    LAS int* lcnt = (LAS int*)(lg + 16 * 32);
    LAS int* lbase = lcnt + 32;
    LAS float* selv = (LAS float*)(lbase + 32);
    const int tid = F.tid, lane = F.lane, wv = F.wave;
    const int fr = lane & 15, kq = lane >> 4;
    float bw[32][2];
#pragma unroll
    for (int s = 0; s < 32; ++s)
#pragma unroll
        for (int n = 0; n < 2; ++n) bw[s][n] = rw[(size_t)(wv * 128 + s * 4 + kq) * 32 + n * 16 + fr];
    const int nun = nrows / RT_TOK;
    u32x2 pre[2][4];
    if (F.bid < nun) {
#pragma unroll
        for (int k = 0; k < 2; ++k)
#pragma unroll
            for (int i = 0; i < 4; ++i) pre[k][i] = *(const u32x2*)(X + (size_t)(F.bid * RT_TOK + wv * 2 + k) * DM + i * 256 + lane * 4);
    }
    const int tk = tid >> 5, ex = tid & 31;
    int prank = 4, ptrk = 0, prow0 = -1, pend = 0; float pgt = 0.f;
    for (int u = F.bid; u < nun; u += F.G) {
        const int row0 = u * RT_TOK;
        if (tid < 32) lcnt[tid] = 0;
#pragma unroll
        for (int k = 0; k < 2; ++k) {
            const int ti = wv * 2 + k, row = row0 + ti;
            f32x4 v[4];
#pragma unroll
            for (int i = 0; i < 4; ++i) { const u32x2 q = pre[k][i]; v[i] = (f32x4){lo2f(q.x), hi2f(q.x), lo2f(q.y), hi2f(q.y)}; }
            const float* m = mod + (size_t)row_sel(row) * 6144;
            row_modulate(v, m + 3072, m + 4096, lane);
#pragma unroll
            for (int i = 0; i < 4; ++i) *(unsigned*)((unsigned char*)hA + (size_t)row * DM + i * 256 + lane * 4) = pack4_fp8(clamp8(v[i][0]), clamp8(v[i][1]), clamp8(v[i][2]), clamp8(v[i][3]));
#pragma unroll
            for (int i = 0; i < 4; ++i) { LAS float* d = h2 + ti * HP + i * 256 + lane * 4; *(LAS f32x2*)d = (f32x2){v[i][0], v[i][1]}; *(LAS f32x2*)(d + 2) = (f32x2){v[i][2], v[i][3]}; }
        }
        if (u + F.G < nun) {
#pragma unroll
            for (int k = 0; k < 2; ++k)
#pragma unroll
                for (int i = 0; i < 4; ++i) pre[k][i] = *(const u32x2*)(X + (size_t)((u + F.G) * RT_TOK + wv * 2 + k) * DM + i * 256 + lane * 4);
        }
        lds_barrier();
        {
            f32x4 acc0 = (f32x4){0.f, 0.f, 0.f, 0.f}, acc1 = acc0;
            const LAS float* hp = h2 + fr * HP + wv * 128 + kq;
#pragma unroll
            for (int s = 0; s < 32; ++s) { const float av = hp[s * 4];
                acc0 = __builtin_amdgcn_mfma_f32_16x16x4f32(av, bw[s][0], acc0, 0, 0, 0);
                acc1 = __builtin_amdgcn_mfma_f32_16x16x4f32(av, bw[s][1], acc1, 0, 0, 0); }
#pragma unroll
            for (int j = 0; j < 4; ++j) { part[wv * 512 + (kq * 4 + j) * 32 + fr] = acc0[j]; part[wv * 512 + (kq * 4 + j) * 32 + 16 + fr] = acc1[j]; }
        }
        lds_barrier();
        float myl;
        {
            float s = rb[tid & 31];
#pragma unroll
            for (int w = 0; w < 8; ++w) s += part[w * 512 + tid];
            lg[tid] = s; myl = s;
        }
        lds_barrier();
        int rank = 0;
#pragma unroll 2
        for (int e4 = 0; e4 < 8; ++e4) { const f32x4 q = *(const LAS f32x4*)(lg + tk * 32 + e4 * 4);
#pragma unroll
            for (int j = 0; j < 4; ++j) { const int e2 = e4 * 4 + j; rank += (q[j] > myl || (q[j] == myl && e2 < ex)) ? 1 : 0; } }
        const bool sel = rank < 4;
        int trk = 0;
        if (sel) { selv[tk * 4 + rank] = myl; trk = atomicAdd((int*)&lcnt[ex], 1); }
        if (tid < 32 && prow0 >= 0) lbase[tid] = pend;
        lds_barrier();
        float gt = 0.f;
        if (sel) { const f32x4 sv = *(const LAS f32x4*)(selv + tk * 4);
            const float den = 1.0f + __expf(sv[1] - sv[0]) + __expf(sv[2] - sv[0]) + __expf(sv[3] - sv[0]);
            gt = __expf(myl - sv[0]) / den; }
        if (tid < 32) { const int n = lcnt[tid]; pend = n > 0 ? atomicAdd(&cnt[tid], n) : 0; }
        if (prow0 >= 0 && prank < 4) { const int pos = lbase[ex] + ptrk; list[(size_t)ex * TT + pos] = (prow0 + tk) * 4 + prank; sgate[(size_t)ex * TT + pos] = pgt; }
        prank = rank; ptrk = trk; pgt = gt; prow0 = row0;
        lds_barrier();
    }
    if (prow0 >= 0) {
        if (tid < 32) lbase[tid] = pend;
        lds_barrier();
        if (prank < 4) { const int pos = lbase[ex] + ptrk; list[(size_t)ex * TT + pos] = (prow0 + tk) * 4 + prank; sgate[(size_t)ex * TT + pos] = pgt; }
    }
    lds_barrier();
}
DI void moe_tables(const Frame& F, const KArgs& a, int layer, LAS int* tstart, LAS int* lc) {
    const int* cnt = (const int*)(a.ws + WS_CTL + CW_CNT) + layer * 32;
    if (F.tid == 0) { int acc = 0;
        for (int e = 0; e < 32; ++e) { const int n = cnt[e]; lc[e] = n; tstart[e] = acc; acc += (n + 255) >> 8; }
        tstart[32] = acc; }
    __syncthreads();
    LAS int* tile_e = tstart + 224;
    for (int mt = F.tid; mt < tstart[32]; mt += NTHR) { int e = 0;
        for (int k = 1; k < 32; ++k) e = (tstart[k] <= mt) ? k : e;
        tile_e[mt] = e; }
    __syncthreads();
}
DI void comb_load(const bf16_t* X, const unsigned char* Y, int row, int lane, f32x4 (&v)[4], unsigned (&y)[4][4]) {
    row_load16_bf(X + (size_t)row * DM, lane, v);
#pragma unroll
    for (int k = 0; k < 4; ++k)
#pragma unroll
        for (int i = 0; i < 4; ++i) y[k][i] = *(const unsigned*)(Y + (size_t)(row * 4 + k) * DM + i * 256 + lane * 4);
}
DI void comb_finish(const KArgs& a, const float* mod, bf16_t* X, bf16_t* hA, int layer, int row, int lane, f32x4 (&v)[4], const unsigned (&y)[4][4]) {
    const float* m = mod + (size_t)row_sel(row) * 6144;
#pragma unroll
    for (int i = 0; i < 4; ++i) { f32x4 acc = (f32x4){0.f, 0.f, 0.f, 0.f};
#pragma unroll
        for (int k = 0; k < 4; ++k) { const f32x2 lo = __builtin_amdgcn_cvt_pk_f32_fp8((int)y[k][i], false), hi = __builtin_amdgcn_cvt_pk_f32_fp8((int)y[k][i], true);
            acc[0] += lo[0]; acc[1] += lo[1]; acc[2] += hi[0]; acc[3] += hi[1]; }
        const f32x4 g4 = *(const f32x4*)(m + 5120 + i * 256 + lane * 4); v[i] = v[i] + g4 * acc * (1.0f / Q8_Y); }
    if (layer == 0) {
        row_store_bf16(X + (size_t)row * DM, lane, v);
        const float* m1 = mod + (size_t)5 * 6144 + (size_t)row_sel(row) * 6144;
        row_modulate(v, m1, m1 + 1024, lane);
        row_store_bf16(hA + (size_t)row * DM, lane, v);
    } else {
#pragma unroll
        for (int i = 0; i < 4; ++i) *(f32x4*)(a.out + (size_t)row * DM + i * 256 + lane * 4) = v[i];
    }
}
DI void p_combine(const Frame& F, const KArgs& a, int layer, int nrows) {
    const float* mod = (const float*)(a.ws + WS_MOD) + (size_t)layer * 5 * 6144;
    bf16_t* X = (bf16_t*)(a.ws + WS_XRES);
    const unsigned char* Y = a.ws + WS_R2;
    bf16_t* hA = (bf16_t*)(a.ws + WS_HA);
    const int lane = F.lane, stride = F.G * 8;
    int row = F.bid * 8 + F.wave;
    f32x4 vA[4], vB[4]; unsigned yA[4][4], yB[4][4];
    if (row < nrows) comb_load(X, Y, row, lane, vA, yA);
    while (row < nrows) {
        int r2 = row + stride;
        if (r2 < nrows) comb_load(X, Y, r2, lane, vB, yB);
        comb_finish(a, mod, X, hA, layer, row, lane, vA, yA);
        row = r2; if (row >= nrows) break;
        r2 = row + stride;
        if (r2 < nrows) comb_load(X, Y, r2, lane, vA, yA);
        comb_finish(a, mod, X, hA, layer, row, lane, vB, yB);
        row = r2;
    }
}
DI void p_prep1(const Frame& F, const KArgs& a) {
    const bf16_t* U = (const bf16_t*)(a.ws + WS_U);
    unsigned char* R1 = a.ws + WS_R1;
    bf16_t* QN = (bf16_t*)(R1 + L1_QN); bf16_t* KN = (bf16_t*)(R1 + L1_KN);
    const f32x2* rope = (const f32x2*)(a.ws + WS_ROPE);
    const int lane = F.lane, tid = F.tid;
    {
        const int d0 = (lane & 7) * 8;
        float qn[8], kn[8]; load8f(KIN(a, 29) + d0, qn); load8f(KIN(a, 30) + d0, kn);
        const int l8 = lane & 7, ax = l8 >> 2, ph = (l8 >> 1) & 1, i0 = (l8 & 1) * 8;
        for (int row = F.bid * 8 + F.wave; row < TT; row += F.G * 8) {
            const bool lat = row < TL;
            const int t = row & (SEQ - 1), pos = ax ? (t & 63) : (t >> 6);
#pragma unroll
            for (int which = 0; which < 2; ++which) {
                if (which == 0 && !lat) continue;
                float x[8]; load8bf(U + (size_t)row * CDCOLS + which * 512 + lane * 8, x);
                float ss = 0.f;
#pragma unroll
                for (int e = 0; e < 8; ++e) ss += x[e] * x[e];
                ss = sum8(ss);
                const float inv = rsqrtf(ss * (1.0f / 64.0f) + 1e-6f);
#pragma unroll
                for (int e = 0; e < 8; ++e) x[e] = x[e] * inv * (which ? kn[e] : qn[e]);
                float o[8];
#pragma unroll
                for (int e = 0; e < 8; ++e) {
                    const float xp = dppmov<0x4E>(x[e]);
                    const f32x2 cs = rope[pos * 16 + i0 + e];
                    const float rot = ph ? (xp * cs[1] + x[e] * cs[0]) : (x[e] * cs[0] - xp * cs[1]);
                    o[e] = lat ? rot : x[e];
                }
                if (which == 0) {
#pragma unroll
                    for (int e = 0; e < 8; ++e) o[e] *= 0.125f;
                    store8bf(QN + (size_t)row * 512 + lane * 8, o);
                } else store8bf(KN + (size_t)row * 512 + lane * 8, o);
            }
        }
    }
    {
        LAS unsigned char* Tb = F.lds;
        bf16_t* VT = (bf16_t*)(R1 + L1_VT); bf16_t* VCT = (bf16_t*)(R1 + L1_VCT); bf16_t* HVT = (bf16_t*)(R1 + L1_HVT);
        const float* hs = KIN(a, 32);
        int par = 0;
        for (int u = F.bid; u < (TT / 64) * 8; u += F.G) {
            const int tile = u >> 3, ch = u & 7, row0 = tile * 64;
            const bool lat = row0 < TL;
            if (!lat && ch >= 2) continue;
            const int seq_start = lat ? (row0 / SEQ) * SEQ : TL + ((row0 - TL) / CL) * CL;
            const int seq_end = lat ? seq_start + SEQ : seq_start + CL;
            const int col8 = tid & 31, tr = tid >> 5;
            const int scol = 1024 + ch * 256 + col8 * 8;
            const int r0 = row0 + tr * 4;
            LAS unsigned char* img = Tb + par * 32768; par ^= 1;
            float y[4][8];
            if (ch >= 2) {
                float w0[8], w1[8], w2[8];
                load8f(hs + (scol - 1536), w0); load8f(hs + 1536 + (scol - 1536), w1); load8f(hs + 3072 + (scol - 1536), w2);
                float x[6][8];
#pragma unroll
                for (int r = 0; r < 6; ++r) { const int row = r0 - 1 + r;
                    if (row >= seq_start && row < seq_end) load8bf(U + (size_t)row * CDCOLS + scol, x[r]); else {
#pragma unroll
                        for (int e = 0; e < 8; ++e) x[r][e] = 0.f; } }
#pragma unroll
                for (int t = 0; t < 4; ++t)
#pragma unroll
                    for (int e = 0; e < 8; ++e) y[t][e] = x[t][e] * w0[e] + x[t + 1][e] * w1[e] + x[t + 2][e] * w2[e];
            } else {
#pragma unroll
                for (int t = 0; t < 4; ++t) load8bf(U + (size_t)(r0 + t) * CDCOLS + scol, y[t]);
            }
#pragma unroll
            for (int e = 0; e < 8; ++e) { u32x2 w; w.x = pack2(y[0][e], y[1][e]); w.y = pack2(y[2][e], y[3][e]);
                *(LAS u32x2*)(img + (col8 * 8 + e) * 128 + ((tr ^ (col8 & 15)) * 8)) = w; }
            __syncthreads();
#pragma unroll
            for (int q = 0; q < 4; ++q) {
                const int idx = tid + q * NTHR, cl = idx >> 3, pc = idx & 7, sw = (cl >> 3) & 15;
                u32x4 w = *(const LAS u32x4*)(img + cl * 128 + ((pc ^ (sw >> 1)) * 16));
                if (sw & 1) { const unsigned t0 = w.x, t1 = w.y; w.x = w.z; w.y = w.w; w.z = t0; w.w = t1; }
                const int cg = ch * 256 + cl;
                bf16_t* dst;
                if (cg < 512) {
                    if (lat) { const int b = row0 / SEQ, t0 = row0 - b * SEQ; dst = VT + ((size_t)b * 512 + cg) * SEQ + t0 + pc * 8; }
                    else { const int b = (row0 - TL) / CL, t0 = (row0 - TL) - b * CL; dst = VCT + ((size_t)b * 512 + cg) * CL + t0 + pc * 8; }
                } else { const int hc = cg - 512, st = hc >> 9, c = hc & 511, b = row0 / SEQ, t0 = row0 - b * SEQ;
                    dst = HVT + (((size_t)st * 4 + b) * 512 + c) * SEQ + t0 + pc * 8; }
                *(u32x4*)dst = w;
            }
        }
        __syncthreads();
    }
}
DI void p_hy_back(const Frame& F, const KArgs& a) {
    const bf16_t* HYT = (const bf16_t*)(a.ws + WS_R1 + L1_HYT);
    bf16_t* MIX = (bf16_t*)(a.ws + WS_MIX);
    const int tid = F.tid, pc = tid & 7, c4 = tid >> 3;
    int par = 0;
    for (int u = F.bid; u < (TL / 64) * 2; u += F.G) {
        const int tile = u >> 1, ch = u & 1, row0 = tile * 64, b = row0 / SEQ, t0 = row0 - b * SEQ;
        LAS unsigned char* img = F.lds + par * 32768; par ^= 1;
        u32x4 x[4];
#pragma unroll
        for (int i = 0; i < 4; ++i) x[i] = *(const u32x4*)(HYT + ((size_t)b * 512 + ch * 256 + c4 * 4 + i) * SEQ + t0 + pc * 8);
#pragma unroll
        for (int e = 0; e < 8; ++e) {
            const int sh = (e & 1) * 16; unsigned v[4];
#pragma unroll
            for (int i = 0; i < 4; ++i) v[i] = (x[i][e >> 1] >> sh) & 0xFFFFu;
            u32x2 w; w.x = v[0] | (v[1] << 16); w.y = v[2] | (v[3] << 16);
            *(LAS u32x2*)(img + (pc * 8 + e) * 512 + ((c4 ^ (pc << 3)) * 8)) = w;
        }
        __syncthreads();
#pragma unroll
        for (int q = 0; q < 4; ++q) {
            const int idx = tid + q * NTHR, tt = idx >> 5, c8 = idx & 31;
            const u32x4 w = *(const LAS u32x4*)(img + tt * 512 + ((c8 ^ ((tt >> 3) << 2)) * 16));
            *(u32x4*)(MIX + (size_t)(row0 + tt) * DM + 512 + ch * 256 + c8 * 8) = w;
        }
    }
    __syncthreads();
}
constexpr int NA_UNITS = NB * 8 * 64, KPB = 144, NA_KROWS = 9 * 64 + 256, VPB = NA_KROWS * 2 + 16;
DI void na_unit(const Frame& F, const KArgs& a, int u) {
    unsigned char* R1 = a.ws + WS_R1;
    const bf16_t* QN = (const bf16_t*)(R1 + L1_QN); const bf16_t* KN = (const bf16_t*)(R1 + L1_KN);
    const bf16_t* VT = (const bf16_t*)(R1 + L1_VT); const bf16_t* VCT = (const bf16_t*)(R1 + L1_VCT);
    bf16_t* MIX = (bf16_t*)(a.ws + WS_MIX);
    const int tid = F.tid, lane = F.lane, wv = F.wave, fr = lane & 15, fq = lane >> 4;
    const int b = u >> 9, h = (u >> 6) & 7, rb = u & 63;
    const int rsA = min(max(2 * rb - 4, 0), 120);
    LAS unsigned char* Ksm = F.lds;
    LAS float* Bsm = (LAS float*)(F.lds + NA_KROWS * KPB);
#pragma unroll
    for (int i = 0; i < 13; ++i) {
        const int p = tid + i * NTHR, kx = p >> 3, pc = p & 7;
        const size_t tok = kx < 576 ? (size_t)b * SEQ + min(rsA + (kx >> 6), 127) * 64 + (kx & 63) : (size_t)TL + b * CL + (kx - 576);
        *(LAS u32x4*)(Ksm + kx * KPB + pc * 16) = *(const u32x4*)(KN + tok * 512 + h * 64 + pc * 8);
    }
    if (tid < 465) Bsm[tid] = KIN(a, 31)[h * 465 + tid];
    const int r = 2 * rb + (wv >> 2), c0 = 16 * (wv & 3);
    const int rs = min(max(r - 4, 0), 120), kc0 = min(max(c0 - 8, 0), 32);
    const int cq = c0 + fr, cs = min(max(cq - 8, 0), 48);
    bf16x8 qf[2];
    { const bf16_t* qp = QN + ((size_t)b * SEQ + r * 64 + cq) * 512 + h * 64 + fq * 8; qf[0] = *(const bf16x8*)qp; qf[1] = *(const bf16x8*)(qp + 32); }
    __syncthreads();
    float lsum = 0.f;
    const int prow = (fr >> 2) * 8 + (fr & 3);
    u32x4 PF[16];
#pragma unroll
    for (int g = 0; g < 4; ++g) {
#pragma unroll
        for (int s4 = 0; s4 < 4; ++s4) {
            const int kx0 = (g < 2) ? (rs - rsA + g * 4 + s4) * 64 + kc0 : 576 + (g - 2) * 128 + s4 * 32;
            f32x4 P2[2];
#pragma unroll
            for (int hh = 0; hh < 2; ++hh) {
                const LAS unsigned char* kp = Ksm + (kx0 + prow + hh * 4) * KPB + fq * 16;
                const bf16x8 k0 = *(const LAS bf16x8*)kp, k1 = *(const LAS bf16x8*)(kp + 64);
                f32x4 acc = (f32x4){0.f, 0.f, 0.f, 0.f};
                acc = __builtin_amdgcn_mfma_f32_16x16x32_bf16(k0, qf[0], acc, 0, 0, 0);
                acc = __builtin_amdgcn_mfma_f32_16x16x32_bf16(k1, qf[1], acc, 0, 0, 0);
#pragma unroll
                for (int j = 0; j < 4; ++j) {
                    float sv = acc[j];
                    if (g < 2) { const int kr = rs + g * 4 + s4, kc = kc0 + fq * 8 + hh * 4 + j; const bool ok = kc >= cs && kc < cs + 16;
                        sv = ok ? sv + Bsm[(kr - r + 7) * 31 + (kc - cq + 15)] : -1.0e30f; }
                    const float pv = __expf(fminf(sv, 80.0f)); acc[j] = pv; lsum += pv;
                }
                P2[hh] = acc;
            }
            u32x4 pw; pw.x = pack2(P2[0][0], P2[0][1]); pw.y = pack2(P2[0][2], P2[0][3]); pw.z = pack2(P2[1][0], P2[1][1]); pw.w = pack2(P2[1][2], P2[1][3]);
            PF[g * 4 + s4] = pw;
        }
    }
    __syncthreads();
#pragma unroll
    for (int i = 0; i < 13; ++i) {
        const int p = tid + i * NTHR;
        int dim, kx; const bf16_t* src;
        if (p < 4608) { dim = p / 72; const int rem = p - dim * 72, rw_ = rem >> 3, pc = rem & 7; kx = rw_ * 64 + pc * 8;
            src = VT + ((size_t)b * 512 + h * 64 + dim) * SEQ + min(rsA + rw_, 127) * 64 + pc * 8; }
        else { const int q = p - 4608; dim = q >> 5; const int pc = q & 31; kx = 576 + pc * 8; src = VCT + ((size_t)b * 512 + h * 64 + dim) * CL + pc * 8; }
        *(LAS u32x4*)(Ksm + dim * VPB + kx * 2) = *(const u32x4*)src;
    }
    __syncthreads();
    f32x4 O[4];
#pragma unroll
    for (int n = 0; n < 4; ++n) O[n] = (f32x4){0.f, 0.f, 0.f, 0.f};
#pragma unroll
    for (int ks = 0; ks < 16; ++ks) {
        const int g = ks >> 2, s4 = ks & 3;
        const int kx0 = (g < 2) ? (rs - rsA + g * 4 + s4) * 64 + kc0 : 576 + (g - 2) * 128 + s4 * 32;
        const bf16x8 pf = __builtin_bit_cast(bf16x8, PF[ks]);
#pragma unroll
        for (int n = 0; n < 4; ++n) { const bf16x8 vf = *(const LAS bf16x8*)(Ksm + (n * 16 + fr) * VPB + (kx0 + fq * 8) * 2);
            O[n] = __builtin_amdgcn_mfma_f32_16x16x32_bf16(pf, vf, O[n], 0, 0, 0); }
    }
    lsum += __builtin_bit_cast(float, __builtin_amdgcn_ds_bpermute((lane ^ 16) << 2, __builtin_bit_cast(int, lsum)));
    lsum += __builtin_bit_cast(float, __builtin_amdgcn_ds_bpermute((lane ^ 32) << 2, __builtin_bit_cast(int, lsum)));
    const float rl = 1.0f / lsum;
    float rq[4];
#pragma unroll
    for (int j = 0; j < 4; ++j) rq[j] = __builtin_bit_cast(float, __builtin_amdgcn_ds_bpermute((fq * 4 + j) << 2, __builtin_bit_cast(int, rl)));
#pragma unroll
    for (int n = 0; n < 4; ++n)
#pragma unroll
        for (int j = 0; j < 4; ++j)
            MIX[((size_t)b * SEQ + r * 64 + c0 + fq * 4 + j) * DM + h * 64 + n * 16 + fr] = f2bf(O[n][j] * rq[j]);
}

constexpr int FN = 16384;
DI f32x2 cmul(f32x2 a, f32x2 b) {
    f32x2 t, r;
    asm("v_pk_mul_f32 %0, %1, %2 op_sel:[0,0] op_sel_hi:[0,1]" : "=v"(t) : "v"(a), "v"(b));
    asm("v_pk_fma_f32 %0, %1, %2, %3 op_sel:[1,1,0] op_sel_hi:[1,0,1] neg_lo:[0,1,0]" : "=v"(r) : "v"(a), "v"(b), "v"(t));
    return r;
}
DI f32x2 cmulc(f32x2 a, f32x2 b) {
    f32x2 t, r;
    asm("v_pk_mul_f32 %0, %1, %2 op_sel:[0,0] op_sel_hi:[1,0]" : "=v"(t) : "v"(a), "v"(b));
    asm("v_pk_fma_f32 %0, %1, %2, %3 op_sel:[1,1,0] op_sel_hi:[0,1,1] neg_hi:[0,1,0]" : "=v"(r) : "v"(a), "v"(b), "v"(t));
    return r;
}
DI f32x2 add_mi(f32x2 a, f32x2 d) { f32x2 r; asm("v_pk_add_f32 %0, %1, %2 op_sel:[0,1] op_sel_hi:[1,0] neg_hi:[0,1]" : "=v"(r) : "v"(a), "v"(d)); return r; }
DI f32x2 add_pi(f32x2 a, f32x2 d) { f32x2 r; asm("v_pk_add_f32 %0, %1, %2 op_sel:[0,1] op_sel_hi:[1,0] neg_lo:[0,1]" : "=v"(r) : "v"(a), "v"(d)); return r; }
DI f32x2 tw_get(const LAS f32x2* Thi, const LAS f32x2* Tlo, int e) { return cmul(Thi[e >> 7], Tlo[e & 127]); }
DI int PX(int i) { return i + ((i >> 4) << 1); }
DI void r4_fwd(f32x2& x0, f32x2& x1, f32x2& x2, f32x2& x3) {
    const f32x2 a0 = x0 + x2, a1 = x0 - x2, a2 = x1 + x3, d = x1 - x3;
    x0 = a0 + a2; x1 = add_mi(a1, d); x2 = a0 - a2; x3 = add_pi(a1, d);
}
DI void r4_inv(f32x2& z0, f32x2& z1, f32x2& z2, f32x2& z3) {
    const f32x2 a0 = z0 + z2, a1 = z0 - z2, a2 = z1 + z3, d = z1 - z3;
    z0 = a0 + a2; z1 = add_pi(a1, d); z2 = a0 - a2; z3 = add_mi(a1, d);
}
template <int LS>
DI void sp_fwd_compute(const LAS f32x2* Thi, const LAS f32x2* Tlo, int offp, f32x2 (&x)[16]) {
    constexpr int sp = 1 << (LS - 2);
#pragma unroll
    for (int b = 0; b < 4; ++b) {
        if (b == 2) __builtin_amdgcn_sched_barrier(0);
        r4_fwd(x[b], x[4 + b], x[8 + b], x[12 + b]);
        const int e1 = (b * sp + offp) << (12 - LS);
        if (!(LS == 2 && b == 0)) { const f32x2 w1 = tw_get(Thi, Tlo, e1), w2 = cmul(w1, w1), w3 = cmul(w2, w1);
            x[4 + b] = cmul(x[4 + b], w1); x[8 + b] = cmul(x[8 + b], w2); x[12 + b] = cmul(x[12 + b], w3); }
    }
    f32x2 w1 = (f32x2){1.f, 0.f}, w2 = w1, w3 = w1;
    if (LS > 2) { w1 = tw_get(Thi, Tlo, offp << (14 - LS)); w2 = cmul(w1, w1); w3 = cmul(w2, w1); }
#pragma unroll
    for (int m = 0; m < 4; ++m) {
        r4_fwd(x[4 * m], x[4 * m + 1], x[4 * m + 2], x[4 * m + 3]);
        if (LS > 2) { x[4 * m + 1] = cmul(x[4 * m + 1], w1); x[4 * m + 2] = cmul(x[4 * m + 2], w2); x[4 * m + 3] = cmul(x[4 * m + 3], w3); }
    }
}
template <int LS>
DI void sp_inv_compute(const LAS f32x2* Thi, const LAS f32x2* Tlo, int offp, f32x2 (&x)[16]) {
    constexpr int sp = 1 << (LS - 2);
    f32x2 w1 = (f32x2){1.f, 0.f}, w2 = w1, w3 = w1;
    if (LS > 2) { w1 = tw_get(Thi, Tlo, offp << (14 - LS)); w2 = cmul(w1, w1); w3 = cmul(w2, w1); }
#pragma unroll
    for (int m = 0; m < 4; ++m) {
        if (LS > 2) { x[4 * m + 1] = cmulc(x[4 * m + 1], w1); x[4 * m + 2] = cmulc(x[4 * m + 2], w2); x[4 * m + 3] = cmulc(x[4 * m + 3], w3); }
        r4_inv(x[4 * m], x[4 * m + 1], x[4 * m + 2], x[4 * m + 3]);
    }
#pragma unroll
    for (int b = 0; b < 4; ++b) {
        if (b == 2) __builtin_amdgcn_sched_barrier(0);
        const int e1 = (b * sp + offp) << (12 - LS);
        if (!(LS == 2 && b == 0)) { const f32x2 v1 = tw_get(Thi, Tlo, e1), v2 = cmul(v1, v1), v3 = cmul(v2, v1);
            x[4 + b] = cmulc(x[4 + b], v1); x[8 + b] = cmulc(x[8 + b], v2); x[12 + b] = cmulc(x[12 + b], v3); }
        r4_inv(x[b], x[4 + b], x[8 + b], x[12 + b]);
    }
}
template <int LS> DI int sp_base(int g, int& offp) { constexpr int sp = 1 << (LS - 2); offp = g & (sp - 1); return ((g >> (LS - 2)) << (LS + 2)) + offp; }
template <int LS> DI void sp_load(const LAS f32x2* X, int base, f32x2 (&x)[16]) {
    constexpr int s = 1 << LS, sp = 1 << (LS - 2);
#pragma unroll
    for (int a = 0; a < 4; ++a)
#pragma unroll
        for (int b = 0; b < 4; ++b) x[a * 4 + b] = X[PX(base + a * s + b * sp)];
}
template <int LS> DI void sp_store(LAS f32x2* X, int base, const f32x2 (&x)[16]) {
    constexpr int s = 1 << LS, sp = 1 << (LS - 2);
#pragma unroll
    for (int a = 0; a < 4; ++a)
#pragma unroll
        for (int b = 0; b < 4; ++b) X[PX(base + a * s + b * sp)] = x[a * 4 + b];
}

DI void r4pass_fwd(LAS f32x2* X, const LAS f32x2* Thi, const LAS f32x2* Tlo, int tid) {
#pragma unroll 4
    for (int bq = 0; bq < 8; ++bq) { const int k = tid + 512 * bq, off = k & 15, base = ((k >> 4) << 6) + off;
        f32x2 x0 = X[PX(base)], x1 = X[PX(base + 16)], x2 = X[PX(base + 32)], x3 = X[PX(base + 48)];
        r4_fwd(x0, x1, x2, x3);
        const f32x2 w1 = tw_get(Thi, Tlo, off << 8), w2 = cmul(w1, w1), w3 = cmul(w2, w1);
        X[PX(base)] = x0; X[PX(base + 16)] = cmul(x1, w1); X[PX(base + 32)] = cmul(x2, w2); X[PX(base + 48)] = cmul(x3, w3); }
    __syncthreads();
}
DI void r4pass_inv(LAS f32x2* X, const LAS f32x2* Thi, const LAS f32x2* Tlo, int tid) {
#pragma unroll 4
    for (int bq = 0; bq < 8; ++bq) { const int k = tid + 512 * bq, off = k & 15, base = ((k >> 4) << 6) + off;
        f32x2 x0 = X[PX(base)], x1 = X[PX(base + 16)], x2 = X[PX(base + 32)], x3 = X[PX(base + 48)];
        const f32x2 w1 = tw_get(Thi, Tlo, off << 8), w2 = cmul(w1, w1), w3 = cmul(w2, w1);
        x1 = cmulc(x1, w1); x2 = cmulc(x2, w2); x3 = cmulc(x3, w3);
        r4_inv(x0, x1, x2, x3);
        X[PX(base)] = x0; X[PX(base + 16)] = x1; X[PX(base + 32)] = x2; X[PX(base + 48)] = x3; }
    __syncthreads();
}
template <int LS, int MODE>
DI void sp_fwd_pass(LAS f32x2* X, const LAS f32x2* Thi, const LAS f32x2* Tlo, int tid, f32x2 (&Kr)[2][16]) {
#pragma unroll
    for (int i = 0; i < 2; ++i) { __builtin_amdgcn_sched_barrier(0); int offp; const int base = sp_base<LS>(tid + 512 * i, offp); f32x2 x[16];
        sp_load<LS>(X, base, x); sp_fwd_compute<LS>(Thi, Tlo, offp, x);
        if (MODE == 1) {
#pragma unroll
            for (int e = 0; e < 16; ++e) Kr[i][e] = x[e]; }
        else { if (MODE == 2) {
#pragma unroll
                for (int e = 0; e < 16; ++e) x[e] = cmul(x[e], Kr[i][e]); }
            sp_store<LS>(X, base, x); } }
    __syncthreads();
}
template <int LS>
DI void sp_inv_pass(LAS f32x2* X, const LAS f32x2* Thi, const LAS f32x2* Tlo, int tid) {
#pragma unroll
    for (int i = 0; i < 2; ++i) { __builtin_amdgcn_sched_barrier(0); int offp; const int base = sp_base<LS>(tid + 512 * i, offp); f32x2 x[16];
        sp_load<LS>(X, base, x); sp_inv_compute<LS>(Thi, Tlo, offp, x); sp_store<LS>(X, base, x); }
    __syncthreads();
}
template <int MODE>
DI void fft_forward(LAS f32x2* X, const LAS f32x2* Thi, const LAS f32x2* Tlo, int tid, f32x2 (&Kr)[2][16]) {
    sp_fwd_pass<12, 0>(X, Thi, Tlo, tid, Kr); sp_fwd_pass<8, 0>(X, Thi, Tlo, tid, Kr); r4pass_fwd(X, Thi, Tlo, tid); sp_fwd_pass<2, MODE>(X, Thi, Tlo, tid, Kr);
}
DI void fft_inverse(LAS f32x2* X, const LAS f32x2* Thi, const LAS f32x2* Tlo, int tid) {
    sp_inv_pass<2>(X, Thi, Tlo, tid); r4pass_inv(X, Thi, Tlo, tid); sp_inv_pass<8>(X, Thi, Tlo, tid); sp_inv_pass<12>(X, Thi, Tlo, tid);
}
DI void hy_load_filter(const Frame& F, const KArgs& a, LAS f32x2* X, int o, int c) {
    const float* HYF = (const float*)(a.ws + WS_HYF);
    const float* hf = HYF + ((size_t)(o * 2 + 0) * 512 + c) * SEQ; const float* hb = HYF + ((size_t)(o * 2 + 1) * 512 + c) * SEQ;
    const float g0 = hf[0] + hb[0] + KIN(a, 40)[o * 512 + c];
    for (int n = F.tid; n < FN; n += NTHR) {
        float g;
        if (n == 0) g = g0; else if (n < SEQ) g = hf[n]; else if (n == SEQ) g = 0.f; else g = hb[FN - n];
        X[PX(n)] = (f32x2){g, 0.f};
    }
    __syncthreads();
}
DI void hyena_unit(const Frame& F, const KArgs& a, int c) {
    unsigned char* R1 = a.ws + WS_R1;
    const bf16_t* HVT = (const bf16_t*)(R1 + L1_HVT); bf16_t* HYT = (bf16_t*)(R1 + L1_HYT);
    float* ZT = (float*)(R1 + L1_ZT);
    LAS f32x2* X = (LAS f32x2*)F.lds;
    LAS f32x2* Thi = (LAS f32x2*)(F.lds + LDS_MISC + 512); LAS f32x2* Tlo = Thi + 128;
    const int tid = F.tid;
    const float rn = 1.0f / (float)FN;
    f32x2 Kr[2][16];
    hy_load_filter(F, a, X, 0, c);
    fft_forward<1>(X, Thi, Tlo, tid, Kr);
#pragma unroll 1
    for (int p = 0; p < 2; ++p) {
        const size_t r0 = ((size_t)(2 * p) * 512 + c) * SEQ, r1 = ((size_t)(2 * p + 1) * 512 + c) * SEQ;
        const bf16_t* v0 = HVT + r0; const bf16_t* v1 = HVT + r1;
        const bf16_t* x10 = HVT + (size_t)4 * 512 * SEQ + r0; const bf16_t* x11 = HVT + (size_t)4 * 512 * SEQ + r1;
#pragma unroll
        for (int i = 0; i < 2; ++i) { const int t = (tid + NTHR * i) * 8; float xa[8], xb[8]; load8bf(v0 + t, xa); load8bf(v1 + t, xb);
#pragma unroll
            for (int e = 0; e < 8; ++e) { X[PX(t + e)] = (f32x2){xa[e], xb[e]}; X[PX(SEQ + t + e)] = (f32x2){0.f, 0.f}; } }
        __syncthreads();
        fft_forward<2>(X, Thi, Tlo, tid, Kr);
        fft_inverse(X, Thi, Tlo, tid);
#pragma unroll
        for (int i = 0; i < 2; ++i) { const int t = (tid + NTHR * i) * 8; float xa[8], xb[8]; load8bf(x10 + t, xa); load8bf(x11 + t, xb);
#pragma unroll
            for (int e4 = 0; e4 < 2; ++e4) { f32x4 za, zb;
#pragma unroll
                for (int e = 0; e < 4; ++e) { const f32x2 y = X[PX(t + e4 * 4 + e)]; za[e] = xa[e4 * 4 + e] * y[0] * rn; zb[e] = xb[e4 * 4 + e] * y[1] * rn; }
                *(f32x4*)(ZT + r0 + t + e4 * 4) = za; *(f32x4*)(ZT + r1 + t + e4 * 4) = zb; } }
        __syncthreads();
    }
    hy_load_filter(F, a, X, 1, c);
    fft_forward<1>(X, Thi, Tlo, tid, Kr);
#pragma unroll 1
    for (int p = 0; p < 2; ++p) {
        const size_t r0 = ((size_t)(2 * p) * 512 + c) * SEQ, r1 = ((size_t)(2 * p + 1) * 512 + c) * SEQ;
        const bf16_t* x20 = HVT + (size_t)8 * 512 * SEQ + r0; const bf16_t* x21 = HVT + (size_t)8 * 512 * SEQ + r1;
#pragma unroll
        for (int i = 0; i < 2; ++i) { const int t = (tid + NTHR * i) * 8;
#pragma unroll
            for (int e4 = 0; e4 < 2; ++e4) { const f32x4 za = *(const f32x4*)(ZT + r0 + t + e4 * 4), zb = *(const f32x4*)(ZT + r1 + t + e4 * 4);
#pragma unroll
                for (int e = 0; e < 4; ++e) { X[PX(t + e4 * 4 + e)] = (f32x2){za[e], zb[e]}; X[PX(SEQ + t + e4 * 4 + e)] = (f32x2){0.f, 0.f}; } } }
        __syncthreads();
        fft_forward<2>(X, Thi, Tlo, tid, Kr);
        fft_inverse(X, Thi, Tlo, tid);
#pragma unroll
        for (int i = 0; i < 2; ++i) { const int t = (tid + NTHR * i) * 8; float xa[8], xb[8], oa[8], ob[8]; load8bf(x20 + t, xa); load8bf(x21 + t, xb);
#pragma unroll
            for (int e = 0; e < 8; ++e) { const f32x2 y = X[PX(t + e)]; oa[e] = xa[e] * y[0] * rn; ob[e] = xb[e] * y[1] * rn; }
            store8bf(HYT + r0 + t, oa); store8bf(HYT + r1 + t, ob); }
        __syncthreads();
    }
}
DI void p_na_hyena(const Frame& F, const KArgs& a) {
    unsigned* head = (unsigned*)(a.ws + WS_CTL + CW_Q);
    volatile LAS int* slot = (volatile LAS int*)(F.lds + LDS_MISC + 64);
    { LAS f32x2* Thi = (LAS f32x2*)(F.lds + LDS_MISC + 512); LAS f32x2* Tlo = Thi + 128; const int tid = F.tid;
      if (tid < 256) { const int i = tid & 127; const float ang = -6.283185307179586f * (float)((tid < 128) ? i * 128 : i) / (float)FN;
          float sn, cs; sincosf(ang, &sn, &cs); (tid < 128 ? Thi : Tlo)[i] = (f32x2){cs, sn}; } }
    if (threadIdx.x == 0) *slot = (int)__hip_atomic_fetch_add(head, 1u, __ATOMIC_RELAXED, __HIP_MEMORY_SCOPE_AGENT);
    for (;;) {
        __syncthreads();
        const int u = *slot;
        if (u >= 512 + NA_UNITS) break;
        int nxt = 0;
        if (threadIdx.x == 0) nxt = (int)__hip_atomic_fetch_add(head, 1u, __ATOMIC_RELAXED, __HIP_MEMORY_SCOPE_AGENT);
        Frame Fu = F; { int t_ = threadIdx.x; asm volatile("" : "+v"(t_)); Fu.tid = t_; Fu.lane = t_ & 63; }
        if (u < 512) hyena_unit(Fu, a, u); else na_unit(Fu, a, u - 512);
        if (threadIdx.x == 0) *slot = nxt;
    }
}
constexpr int NPHASE = 21;
__global__ void __launch_bounds__(NTHR, 2) fwd_kernel(Args kargs) {
    extern __shared__ __attribute__((aligned(16))) unsigned char lds_raw[];
    LAS unsigned char* const lds0 = (LAS unsigned char*)lds_raw;
#define MKF() Frame F; KArgs args; { int t_ = threadIdx.x; asm volatile("" : "+v"(t_)); unsigned long long kp_ = (unsigned long long)__builtin_amdgcn_kernarg_segment_ptr(); asm volatile("" : "+s"(kp_)); \
    args.kp = kp_; args.ws = (unsigned char*)(GAS unsigned char*)kload<336>(kp_); args.out = (float*)(GAS float*)kload<328>(kp_); \
    F.lds = lds0; F.ws = args.ws; F.tid = t_; F.lane = t_ & 63; F.wave = __builtin_amdgcn_readfirstlane(t_ >> 6); F.G = gridDim.x; F.bid = blockIdx.x; } \
    unsigned char* const ws = args.ws; const float* const mod = (const float*)(ws + WS_MOD); (void)mod
    volatile LAS unsigned* misc = (volatile LAS unsigned*)(lds0 + LDS_MISC);
    if (threadIdx.x < 4) misc[threadIdx.x] = 0u;
    __syncthreads();
    const int lo = kargs.ph_lo, hi = kargs.ph_hi;
    const bool use_bar = (hi - lo) > 1;
    XcdBarrier bar; bar.bar = (unsigned*)(kargs.ws + WS_CTL); bar.x = 0; bar.st = misc;
    if (use_bar) bar = xcd_barrier_post((unsigned*)(kargs.ws + WS_CTL), misc);
#ifndef PHMASK
#define PHMASK 0xFFFFFFFu
#endif
#define IN(k) ((((PHMASK) >> (k)) & 1u) && lo <= (k) && (k) < hi)
#define SEAM(k) do { if (IN(k) && IN((k) + 1)) xcd_barrier(bar); } while (0)
#ifndef REPK
#define REPK (-1)
#endif
#ifndef REP_NOSTORE
#define REP_NOSTORE 0
#endif
#define PHASE(k, ...) if (IN(k)) { { constexpr bool REPFLAG = false; (void)REPFLAG; __VA_ARGS__ } if (REPK == (k)) { xcd_barrier(bar); { constexpr bool REPFLAG = REP_NOSTORE != 0; (void)REPFLAG; __VA_ARGS__ } } } SEAM(k)
    LAS int* tstart = (LAS int*)(lds0 + LDS_MISC + 128); LAS int* lcnt = (LAS int*)(lds0 + LDS_MISC + 384);

    PHASE(0,  MKF(); p0_prologue(F, args););
    PHASE(1,  MKF(); p_modulate_in(F, args););
    PHASE(2,  MKF();
        pg8::PlainOrder S; S.init(TT, ABPAD, F.G, F.bid); pg8::EpiBf16 E{(bf16_t*)(ws + WS_U), ABPAD};
        pg8::gemm_phase(F.lds, (const bf16_t*)(ws + WS_HA), (const bf16_t*)(ws + WS_WIN0), S, E););
    PHASE(3,  MKF(); p_streams(F, args););
    PHASE(4,  MKF(); p_prep(F, args););
    PHASE(5,  MKF(); p_scan(F, args););
    PHASE(6,  MKF(); p_readout(F, args););
    PHASE(7,  MKF();
        pg8::PlainOrder S; S.init(TT, DM, F.G, F.bid); pg8::EpiResid<false> E{KIN(args, 0), KIN(args, 2), (bf16_t*)(ws + WS_XRES), mod + 2048};
        pg8::gemm_phase(F.lds, (const bf16_t*)(ws + WS_MIX), (const bf16_t*)(ws + WS_WOUT0), S, E););
    PHASE(8,  MKF(); p_route(F, args, 0, TT););
    PHASE(9,  MKF();
        moe_tables(F, args, 0, tstart, lcnt);
        pg8::MoeOrder S{tstart, lcnt, tstart + 224, (const int*)(ws + WS_LIST), 8, F.G, F.bid, true}; pg8::EpiSwiglu E{ws + WS_R1, KIN(args, 9)};
        pg8::gemm_phase(F.lds, (const bf16_t*)(ws + WS_HA), (const bf16_t*)(ws + WS_W1T), S, E););
    PHASE(10,  MKF();
        moe_tables(F, args, 0, tstart, lcnt);
        pg8::MoeOrder S{tstart, lcnt, tstart + 224, (const int*)(ws + WS_LIST), 4, F.G, F.bid, false}; pg8::EpiMoeOut E{ws + WS_R2, KIN(args, 11), (const int*)(ws + WS_LIST), (const float*)(ws + WS_SGATE)};
        pg8::gemm_phase(F.lds, (const bf16_t*)(ws + WS_R1), (const bf16_t*)(ws + WS_W2TM), S, E););
    PHASE(11,  MKF(); p_combine(F, args, 0, TT););
    PHASE(12,  MKF();
        pg8::PlainOrder S; S.init(TT, CDCOLS, F.G, F.bid); pg8::EpiBf16 E{(bf16_t*)(ws + WS_U), CDCOLS};
        pg8::gemm_phase(F.lds, (const bf16_t*)(ws + WS_HA), (const bf16_t*)(ws + WS_WIN1), S, E););
    PHASE(13,  MKF(); p_prep1(F, args););
    PHASE(14,  MKF(); p_na_hyena(F, args););
    PHASE(15,  MKF(); p_hy_back(F, args););
    PHASE(16,  MKF();
        pg8::PlainOrder S; S.init(TL, DM, F.G, F.bid); pg8::EpiResid<true> E{ws + WS_XRES, ws + WS_XRES, (bf16_t*)(ws + WS_XRES), mod + 5 * 6144 + 2048};
        pg8::gemm_phase(F.lds, (const bf16_t*)(ws + WS_MIX), (const bf16_t*)(ws + WS_WOUT1), S, E););
    PHASE(17,  MKF(); p_route(F, args, 1, TL););
    PHASE(18,  MKF();
        moe_tables(F, args, 1, tstart, lcnt);
        pg8::MoeOrder S{tstart, lcnt, tstart + 224, (const int*)(ws + WS_LIST), 8, F.G, F.bid, true}; pg8::EpiSwiglu E{ws + WS_R1, KIN(args, 9) + 32 * 2048};
        pg8::gemm_phase(F.lds, (const bf16_t*)(ws + WS_HA), (const bf16_t*)(ws + WS_W1T + (size_t)32 * 2048 * 1024), S, E););
    PHASE(19,  MKF();
        moe_tables(F, args, 1, tstart, lcnt);
        pg8::MoeOrder S{tstart, lcnt, tstart + 224, (const int*)(ws + WS_LIST), 4, F.G, F.bid, false}; pg8::EpiMoeOut E{ws + WS_R2, KIN(args, 11) + 32 * 1024, (const int*)(ws + WS_LIST), (const float*)(ws + WS_SGATE)};
        pg8::gemm_phase(F.lds, (const bf16_t*)(ws + WS_R1), (const bf16_t*)(ws + WS_W2TM + (size_t)32 * 1024 * 1024), S, E););
    PHASE(20,  MKF(); p_combine(F, args, 1, TL); );
#undef IN
#undef SEAM
#undef PHASE
}

#ifndef N_LAUNCH_MODE
#define N_LAUNCH_MODE 1
#endif
extern "C" void kernel_launch(void* const* d_in, const int* in_sizes, int n_in, void* d_out, int out_size, void* d_ws, size_t ws_size, hipStream_t stream) {
    static int grid = 0;
    if (grid == 0) {
        if (n_in != 41 || out_size != TL * DM || ws_size < WS_END) { fprintf(stderr, "kernel_launch: unexpected shapes: n_in %d out %d ws %zu (need %zu)\n", n_in, out_size, ws_size, (size_t)WS_END); grid = -1; return; }
        int dev = 0, cus = 0, per_cu = 0;
        if (hipGetDevice(&dev) != hipSuccess || hipDeviceGetAttribute(&cus, hipDeviceAttributeMultiprocessorCount, dev) != hipSuccess) { grid = -1; return; }
        if (hipFuncSetAttribute((const void*)fwd_kernel, hipFuncAttributeMaxDynamicSharedMemorySize, LDS_BYTES) != hipSuccess) { fprintf(stderr, "kernel_launch: hipFuncSetAttribute failed\n"); grid = -1; return; }
        if (hipOccupancyMaxActiveBlocksPerMultiprocessor(&per_cu, (const void*)fwd_kernel, NTHR, LDS_BYTES) != hipSuccess || per_cu < 1) { fprintf(stderr, "kernel_launch: occupancy query says %d blocks per CU\n", per_cu); }
        (void)hipGetLastError();
        grid = cus;
    }
    if (grid < 0) return;
    (void)hipMemsetAsync((char*)d_ws + WS_CTL, 0, CTL_BYTES, stream);
    Args a{};
    for (int i = 0; i < 41; ++i) a.in[i] = (const float*)d_in[i];
    a.out = (float*)d_out; a.ws = (unsigned char*)d_ws;
#if N_LAUNCH_MODE == 1
    a.ph_lo = 0; a.ph_hi = NPHASE;
    hipLaunchKernelGGL(fwd_kernel, dim3(grid), dim3(NTHR), LDS_BYTES, stream, a);
#else
    for (int p = 0; p < NPHASE; ++p) { a.ph_lo = p; a.ph_hi = p + 1; hipLaunchKernelGGL(fwd_kernel, dim3(grid), dim3(NTHR), LDS_BYTES, stream, a);
#ifdef REP_PHASE
        if (p == REP_PHASE) { if (p == 8 || p == 14 || p == 17) (void)hipMemsetAsync((char*)d_ws + WS_CTL + CW_CNT, 0, 4096, stream); hipLaunchKernelGGL(fwd_kernel, dim3(grid), dim3(NTHR), LDS_BYTES, stream, a); }
#endif
    }
#endif
}
```
